# Optimizing an MI355X kernel written in HIP

```python
import math
import jax
import jax.numpy as jnp
from jax import lax
import numpy as np

D_MODEL = 2048
BATCH = 4
SEQ = 2048
DEPTH = 2

N_EVEN = (DEPTH + 1) // 2
N_ODD = DEPTH // 2
MIX_W = D_MODEL
NORM_EPS = 1e-6

RW_HEAD = 64
RW_W = MIX_W // 2
RW_H = RW_W // RW_HEAD
RW_DECAY_LORA = 96
RW_ICLR_LORA = 96
RW_GATE_LORA = 256
RW_IN = 3 * RW_W + RW_DECAY_LORA + RW_ICLR_LORA + RW_GATE_LORA
RW_LN_EPS = 64e-5
RW_DECAY_SCALE = math.exp(-0.5)

ML_W = MIX_W - RW_W
ML_H = 4
ML_DV = ML_W // ML_H
ML_DK = ML_DV // 2
ML_QK = ML_H * ML_DK
ML_CONV = 4
ML_CHUNK = 64
ML_IN = 2 * ML_QK + 2 * ML_W + 2 * ML_H
EV_IN = RW_IN + ML_IN

HG_W = MIX_W // 2
HG_HEAD = 128
HG_H = HG_W // HG_HEAD
HG_CHUNK = 64
HG_IN = 4 * HG_W

MB_W = MIX_W - HG_W
MB_HEAD = 64
MB_H = MB_W // MB_HEAD
MB_G = 4
MB_E = MB_H // MB_G
MB_N = 128
MB_CONV = 4
MB_CHUNK = 64
MB_CONV_W = MB_W + 2 * MB_G * MB_N
MB_IN = MB_W + MB_CONV_W + MB_H
OD_IN = HG_IN + MB_IN

FFN_DENSE = 5632
N_EXPERTS = 8
TOP_K = 2
FFN_EXPERT = 2816

kernel_name = 'hybrid_rwkv7_mlstm_hgrn2_mamba2_moe'


def rmsnorm(x, w, eps=NORM_EPS):
    xf = x.astype(jnp.float32)
    y = xf * lax.rsqrt(jnp.mean(xf * xf, axis=-1, keepdims=True) + eps)
    return (y * w.astype(jnp.float32)).astype(x.dtype)


def head_rmsnorm(x, w):
    H, d = x.shape[-2:]
    return rmsnorm(x, w.reshape(H, d))


def split_cols(u, sizes):
    out, off = [], 0
    for s in sizes:
        out.append(u[..., off:off + s])
        off += s
    return out


def token_shift(x):
    return jnp.pad(x, ((0, 0), (1, 0), (0, 0)))[:, :-1]


def causal_dwconv(x, w, b):
    K, C = w.shape
    y = lax.conv_general_dilated(x, w.astype(x.dtype)[:, None, :], window_strides=(1,),
                                 padding=[(K - 1, 0)], dimension_numbers=('NWC', 'WIO', 'NWC'),
                                 feature_group_count=C)
    return y + b.astype(x.dtype)


def segsum(a):
    L = a.shape[-1]
    xr = jnp.broadcast_to(a[..., :, None], a.shape + (L,))
    xr = jnp.where(jnp.tril(jnp.ones((L, L), bool), -1), xr, 0.0)
    xr = jnp.cumsum(xr, axis=-2)
    return jnp.where(jnp.tril(jnp.ones((L, L), bool)), xr, -jnp.inf)


def rwkv7_group(u, mu, w0, w2, a0, a2, g2, k_k, k_a, r_k, ln_w, ln_b):
    Bsz, T, _ = u.shape
    uf = u.astype(jnp.float32)
    uf = uf + (token_shift(uf) - uf) * mu
    r, k, v, dw, da, dg = split_cols(uf, [RW_W, RW_W, RW_W, RW_DECAY_LORA, RW_ICLR_LORA, RW_GATE_LORA])
    log_w = -RW_DECAY_SCALE * jax.nn.sigmoid(w0 + jnp.tanh(dw) @ w2)
    a = jax.nn.sigmoid(a0 + da @ a2)
    g = jax.nn.sigmoid(dg) @ g2
    hs = lambda t: t.reshape(Bsz, T, RW_H, RW_HEAD)
    kk = hs(k * k_k)
    kk = kk * lax.rsqrt(jnp.maximum(jnp.sum(kk * kk, -1, keepdims=True), 1e-12))
    k = k * (1.0 + (a - 1.0) * k_a)
    r_h, k_h, v_h, a_h, w_h = hs(r), hs(k), hs(v), hs(a), jnp.exp(hs(log_w))

    def step(S, inp):
        r_t, w_t, k_t, v_t, kk_t, a_t = inp
        sa = jnp.einsum('bhij,bhj->bhi', S, -kk_t)
        S = (S * w_t[:, :, None, :] + sa[..., None] * (kk_t * a_t)[:, :, None, :]
             + v_t[..., None] * k_t[:, :, None, :])
        return S, jnp.einsum('bhij,bhj->bhi', S, r_t)

    tm = lambda t: jnp.moveaxis(t, 1, 0)
    S0 = jnp.zeros((Bsz, RW_H, RW_HEAD, RW_HEAD), jnp.float32)
    _, y = lax.scan(step, S0, (tm(r_h), tm(w_h), tm(k_h), tm(v_h), tm(kk), tm(a_h)))
    y = jnp.moveaxis(y, 0, 1)
    mean = jnp.mean(y, -1, keepdims=True)
    var = jnp.mean(jnp.square(y - mean), -1, keepdims=True)
    y = (y - mean) * lax.rsqrt(var + RW_LN_EPS) * ln_w.reshape(RW_H, RW_HEAD) + ln_b.reshape(RW_H, RW_HEAD)
    y = y + jnp.sum(r_h * k_h * r_k, -1, keepdims=True) * v_h
    return (y.reshape(Bsz, T, RW_W) * g).astype(u.dtype)


def mlstm_chunkwise(q, k, v, i_log, f_log):
    Bsz, H, T, DK = q.shape
    DV = v.shape[-1]
    L = ML_CHUNK
    NC = T // L
    q = q.reshape(Bsz, H, NC, L, DK)
    k = k.reshape(Bsz, H, NC, L, DK)
    v = v.reshape(Bsz, H, NC, L, DV)
    i_log = i_log.reshape(Bsz, H, NC, L)
    b = jnp.cumsum(f_log.reshape(Bsz, H, NC, L), -1)
    g = b[..., -1]
    w_state = g[..., None] - b + i_log
    a_loc = jnp.max(w_state, -1)
    e = jnp.exp(w_state - a_loc[..., None])
    kv_loc = jnp.einsum('bhcl,bhclk,bhclv->bhckv', e, k, v)
    n_loc = jnp.einsum('bhcl,bhclk->bhck', e, k)

    def step(carry, inp):
        C, n, m = carry
        g_c, a_c, kv_c, n_c = inp
        m_new = jnp.maximum(g_c + m, a_c)
        s_old = jnp.exp(g_c + m - m_new)
        s_loc = jnp.exp(a_c - m_new)
        C_new = s_old[..., None, None] * C + s_loc[..., None, None] * kv_c
        n_new = s_old[..., None] * n + s_loc[..., None] * n_c
        return (C_new, n_new, m_new), (C, n, m)

    init = (jnp.zeros((Bsz, H, DK, DV), jnp.float32), jnp.zeros((Bsz, H, DK), jnp.float32),
            jnp.zeros((Bsz, H), jnp.float32))
    cm = lambda t: jnp.moveaxis(t, 2, 0)
    _, (C_prev, n_prev, m_prev) = lax.scan(step, init, (cm(g), cm(a_loc), cm(kv_loc), cm(n_loc)))
    C_prev = jnp.moveaxis(C_prev, 0, 2)
    n_prev = jnp.moveaxis(n_prev, 0, 2)
    m_prev = jnp.moveaxis(m_prev, 0, 2)
    causal = jnp.tril(jnp.ones((L, L), bool))
    D = jnp.where(causal, b[..., :, None] - b[..., None, :] + i_log[..., None, :], -jnp.inf)
    inter_log = b + m_prev[..., None]
    m_t = jnp.maximum(inter_log, jnp.max(D, -1))
    inter_s = jnp.exp(inter_log - m_t)
    qk = jnp.einsum('bhctk,bhcsk->bhcts', q, k) * jnp.exp(D - m_t[..., None])
    num = inter_s[..., None] * jnp.einsum('bhctk,bhckv->bhctv', q, C_prev) + jnp.einsum('bhcts,bhcsv->bhctv', qk, v)
    den = inter_s * jnp.einsum('bhctk,bhck->bhct', q, n_prev) + jnp.sum(qk, -1)
    h = num / jnp.maximum(jnp.abs(den), jnp.exp(-m_t))[..., None]
    return h.reshape(Bsz, H, T, DV)


def mlstm_group(u, conv_w, conv_b, i_b, f_b, norm_w):
    Bsz, T, _ = u.shape
    qk, v, o, i_pre, f_pre = split_cols(u, [2 * ML_QK, ML_W, ML_W, ML_H, ML_H])
    qk = jax.nn.silu(causal_dwconv(qk, conv_w, conv_b)).astype(jnp.float32)
    heads = lambda t, d: jnp.moveaxis(t.reshape(Bsz, T, ML_H, d), 2, 1)
    q = heads(qk[..., :ML_QK], ML_DK) * (ML_DK ** -0.5)
    k = heads(qk[..., ML_QK:], ML_DK)
    v = heads(v.astype(jnp.float32), ML_DV)
    i_log = jnp.moveaxis(i_pre.astype(jnp.float32) + i_b, 2, 1)
    f_log = jax.nn.log_sigmoid(jnp.moveaxis(f_pre.astype(jnp.float32) + f_b, 2, 1))
    h = mlstm_chunkwise(q, k, v, i_log, f_log)
    h = head_rmsnorm(jnp.moveaxis(h, 1, 2), norm_w).reshape(Bsz, T, ML_W)
    return (h * jax.nn.sigmoid(o.astype(jnp.float32))).astype(u.dtype)


def hgrn2_chunkwise(q, k, i, log_f):
    Bsz, H, T, DK = q.shape
    DV = i.shape[-1]
    L = HG_CHUNK
    NC = T // L
    to_chunks = lambda t: jnp.moveaxis(t.reshape(Bsz, H, NC, L, t.shape[-1]), 2, 0)
    causal = jnp.tril(jnp.ones((L, L), bool))[:, :, None]

    def step(S, inp):
        q_c, k_c, i_c, lf_c = inp
        bcum = jnp.cumsum(lf_c, axis=2)
        o_inter = jnp.einsum('bhtk,bhkv->bhtv', q_c * jnp.exp(bcum), S)
        diff = bcum[:, :, :, None, :] - bcum[:, :, None, :, :]
        decay = jnp.exp(jnp.where(causal, diff, -jnp.inf))
        attn = jnp.einsum('bhtk,bhsk,bhtsk->bhts', q_c, k_c, decay)
        o_intra = jnp.einsum('bhts,bhsv->bhtv', attn, i_c)
        b_last = bcum[:, :, -1, :]
        S_new = (jnp.exp(b_last)[..., None] * S
                 + jnp.einsum('bhsk,bhsv->bhkv', k_c * jnp.exp(b_last[:, :, None, :] - bcum), i_c))
        return S_new, o_inter + o_intra

    S0 = jnp.zeros((Bsz, H, DK, DV), jnp.float32)
    _, o = lax.scan(step, S0, (to_chunks(q), to_chunks(k), to_chunks(i), to_chunks(log_f)))
    return jnp.moveaxis(o, 0, 2).reshape(Bsz, H, T, DV)


def hgrn2_group(u, lb, norm_w):
    Bsz, T, _ = u.shape
    q, f_pre, i, g = split_cols(u.astype(jnp.float32), [HG_W, HG_W, HG_W, HG_W])
    q = jax.nn.silu(q)
    lb = lb.astype(jnp.float32)
    log_f = jnp.logaddexp(jnp.log(lb), jnp.log1p(-lb) + jax.nn.log_sigmoid(f_pre))
    k = (1.0 - lb) * jax.nn.sigmoid(-f_pre)
    heads = lambda t: jnp.moveaxis(t.reshape(Bsz, T, HG_H, HG_HEAD), 2, 1)
    o = hgrn2_chunkwise(heads(q), heads(k), heads(i), heads(log_f))
    o = head_rmsnorm(jnp.moveaxis(o, 1, 2), norm_w).reshape(Bsz, T, HG_W)
    return (o * jax.nn.silu(g)).astype(u.dtype)


def ssd_chunked(X, Adt, Bm, Cm):
    Bsz, T, G, E, P = X.shape
    N = Bm.shape[-1]
    L = MB_CHUNK
    NC = T // L
    X = X.reshape(Bsz, NC, L, G, E, P)
    Bm = Bm.reshape(Bsz, NC, L, G, N)
    Cm = Cm.reshape(Bsz, NC, L, G, N)
    Adt = jnp.moveaxis(Adt.reshape(Bsz, NC, L, G, E), (1, 2), (3, 4))
    A_cum = jnp.cumsum(Adt, -1)
    Lmat = jnp.exp(segsum(Adt))
    CB = jnp.einsum('bclgn,bcsgn->bgcls', Cm, Bm)
    Y_diag = jnp.einsum('bgecls,bcsgep->bclgep', CB[:, :, None] * Lmat, X)
    decay_states = jnp.exp(A_cum[..., -1:] - A_cum)
    states = jnp.einsum('bclgn,bgecl,bclgep->bcgepn', Bm, decay_states, X)
    states = jnp.concatenate([jnp.zeros_like(states[:, :1]), states], axis=1)
    decay_chunk = jnp.exp(segsum(jnp.pad(A_cum[..., -1], ((0, 0), (0, 0), (0, 0), (1, 0)))))
    states = jnp.einsum('bgezc,bcgepn->bzgepn', decay_chunk, states)[:, :-1]
    Y_off = jnp.einsum('bclgn,bcgepn,bgecl->bclgep', Cm, states, jnp.exp(A_cum))
    return (Y_diag + Y_off).reshape(Bsz, T, G, E, P)


def mamba2_group(u, conv_w, conv_b, dt_bias, A_log, D_skip, norm_w):
    Bsz, T, _ = u.shape
    z, xBC, dt = split_cols(u, [MB_W, MB_CONV_W, MB_H])
    xBC = jax.nn.silu(causal_dwconv(xBC, conv_w, conv_b)).astype(jnp.float32)
    xs, Bm, Cm = split_cols(xBC, [MB_W, MB_G * MB_N, MB_G * MB_N])
    dt = jax.nn.softplus(dt.astype(jnp.float32) + dt_bias)
    A = -jnp.exp(A_log.astype(jnp.float32))
    xh = xs.reshape(Bsz, T, MB_G, MB_E, MB_HEAD)
    dth = dt.reshape(Bsz, T, MB_G, MB_E)
    y = ssd_chunked(xh * dth[..., None], (dt * A).reshape(Bsz, T, MB_G, MB_E),
                    Bm.reshape(Bsz, T, MB_G, MB_N), Cm.reshape(Bsz, T, MB_G, MB_N))
    y = y + xh * D_skip.reshape(MB_G, MB_E)[..., None]
    y = y.reshape(Bsz, T, MB_W) * jax.nn.silu(z.astype(jnp.float32))
    y = rmsnorm(y.reshape(Bsz, T, MB_G, MB_W // MB_G), norm_w.reshape(MB_G, MB_W // MB_G))
    return y.reshape(Bsz, T, MB_W).astype(u.dtype)


def swiglu(h, w_gate, w_up, w_down):
    return (jax.nn.silu(h @ w_gate) * (h @ w_up)) @ w_down


def moe_swiglu(h, router, w_gate, w_up, w_down):
    logits = (h @ router).astype(jnp.float32)
    top_val, top_idx = lax.top_k(logits, TOP_K)
    top_p = jax.nn.softmax(top_val, axis=-1)
    gates = jnp.einsum('btk,btke->bte', top_p, jax.nn.one_hot(top_idx, N_EXPERTS, dtype=jnp.float32))
    out = jnp.zeros_like(h)
    for e in range(N_EXPERTS):
        out = out + gates[..., e:e + 1].astype(h.dtype) * swiglu(h, w_gate[e], w_up[e], w_down[e])
    return out


def setup_inputs(seed: int = 0) -> dict:
    key = jax.random.key(seed)
    ks = iter(jax.random.split(key, 64))
    nrm = lambda shape, scale: scale * jax.random.normal(next(ks), shape, jnp.float32)
    unif = lambda shape, lo, hi: jax.random.uniform(next(ks), shape, jnp.float32, lo, hi)
    gain = lambda shape: 1.0 + nrm(shape, 0.02)
    E, O = N_EVEN, N_ODD
    x = nrm((BATCH, SEQ, D_MODEL), 1.0)
    final_norm_w = gain((D_MODEL,))
    hg_lb_logits = nrm((DEPTH, HG_W), 0.3)
    ev_norm1_w = gain((E, D_MODEL))
    ev_w_in = nrm((E, D_MODEL, EV_IN), D_MODEL ** -0.5)
    ev_w_out = nrm((E, MIX_W, D_MODEL), MIX_W ** -0.5)
    rw_mu = unif((E, RW_IN), 0.0, 1.0)
    rw_w0 = jnp.linspace(-6.0, -0.5, RW_W)[None] + nrm((E, RW_W), 0.1)
    rw_w2 = nrm((E, RW_DECAY_LORA, RW_W), 0.5 * RW_DECAY_LORA ** -0.5)
    rw_a0 = nrm((E, RW_W), 0.1)
    rw_a2 = nrm((E, RW_ICLR_LORA, RW_W), RW_ICLR_LORA ** -0.5)
    rw_g2 = nrm((E, RW_GATE_LORA, RW_W), RW_GATE_LORA ** -0.5)
    rw_k_k = 0.85 + nrm((E, RW_W), 0.02)
    rw_k_a = 1.0 + nrm((E, RW_W), 0.02)
    rw_r_k = nrm((E, RW_H, RW_HEAD), 0.1)
    rw_ln_w = gain((E, RW_W))
    rw_ln_b = nrm((E, RW_W), 0.02)
    ml_conv_w = nrm((E, ML_CONV, 2 * ML_QK), 0.5)
    ml_conv_b = nrm((E, 2 * ML_QK), 0.02)
    ml_i_b = nrm((E, ML_H), 0.1)
    ml_f_b = jnp.linspace(3.0, 6.0, ML_H)[None] + nrm((E, ML_H), 0.1)
    ml_norm_w = gain((E, ML_W))
    ev_norm2_w = gain((E, D_MODEL))
    ffn_w_gate = nrm((E, D_MODEL, FFN_DENSE), D_MODEL ** -0.5)
    ffn_w_up = nrm((E, D_MODEL, FFN_DENSE), D_MODEL ** -0.5)
    ffn_w_down = nrm((E, FFN_DENSE, D_MODEL), FFN_DENSE ** -0.5)
    od_norm1_w = gain((O, D_MODEL))
    od_w_in = nrm((O, D_MODEL, OD_IN), D_MODEL ** -0.5)
    od_w_out = nrm((O, MIX_W, D_MODEL), MIX_W ** -0.5)
    hg_norm_w = gain((O, HG_W))
    mb_conv_w = nrm((O, MB_CONV, MB_CONV_W), 0.5)
    mb_conv_b = nrm((O, MB_CONV_W), 0.02)
    dt0 = jnp.exp(unif((O, MB_H), math.log(1e-3), math.log(1e-1)))
    mb_dt_bias = dt0 + jnp.log(-jnp.expm1(-dt0))
    mb_A_log = jnp.log(unif((O, MB_H), 1.0, 16.0))
    mb_D = gain((O, MB_H))
    mb_norm_w = gain((O, MB_W))
    od_norm2_w = gain((O, D_MODEL))
    moe_router = nrm((O, D_MODEL, N_EXPERTS), D_MODEL ** -0.5)
    moe_w_gate = nrm((O, N_EXPERTS, D_MODEL, FFN_EXPERT), D_MODEL ** -0.5)
    moe_w_up = nrm((O, N_EXPERTS, D_MODEL, FFN_EXPERT), D_MODEL ** -0.5)
    moe_w_down = nrm((O, N_EXPERTS, FFN_EXPERT, D_MODEL), FFN_EXPERT ** -0.5)
    return {'x': x, 'final_norm_w': final_norm_w, 'hg_lb_logits': hg_lb_logits,
            'ev_norm1_w': ev_norm1_w, 'ev_w_in': ev_w_in, 'ev_w_out': ev_w_out,
            'rw_mu': rw_mu, 'rw_w0': rw_w0, 'rw_w2': rw_w2, 'rw_a0': rw_a0, 'rw_a2': rw_a2,
            'rw_g2': rw_g2, 'rw_k_k': rw_k_k, 'rw_k_a': rw_k_a, 'rw_r_k': rw_r_k,
            'rw_ln_w': rw_ln_w, 'rw_ln_b': rw_ln_b,
            'ml_conv_w': ml_conv_w, 'ml_conv_b': ml_conv_b, 'ml_i_b': ml_i_b, 'ml_f_b': ml_f_b,
            'ml_norm_w': ml_norm_w,
            'ev_norm2_w': ev_norm2_w, 'ffn_w_gate': ffn_w_gate, 'ffn_w_up': ffn_w_up, 'ffn_w_down': ffn_w_down,
            'od_norm1_w': od_norm1_w, 'od_w_in': od_w_in, 'od_w_out': od_w_out,
            'hg_norm_w': hg_norm_w,
            'mb_conv_w': mb_conv_w, 'mb_conv_b': mb_conv_b, 'mb_dt_bias': mb_dt_bias,
            'mb_A_log': mb_A_log, 'mb_D': mb_D, 'mb_norm_w': mb_norm_w,
            'od_norm2_w': od_norm2_w, 'moe_router': moe_router, 'moe_w_gate': moe_w_gate,
            'moe_w_up': moe_w_up, 'moe_w_down': moe_w_down}


def reference(x, final_norm_w, hg_lb_logits,
              ev_norm1_w, ev_w_in, ev_w_out,
              rw_mu, rw_w0, rw_w2, rw_a0, rw_a2, rw_g2, rw_k_k, rw_k_a, rw_r_k, rw_ln_w, rw_ln_b,
              ml_conv_w, ml_conv_b, ml_i_b, ml_f_b, ml_norm_w,
              ev_norm2_w, ffn_w_gate, ffn_w_up, ffn_w_down,
              od_norm1_w, od_w_in, od_w_out,
              hg_norm_w,
              mb_conv_w, mb_conv_b, mb_dt_bias, mb_A_log, mb_D, mb_norm_w,
              od_norm2_w, moe_router, moe_w_gate, moe_w_up, moe_w_down):
    p = jax.nn.softmax(hg_lb_logits.astype(jnp.float32), axis=0)
    lower_bounds = jnp.cumsum(p, axis=0) - p[0]
    for layer in range(DEPTH):
        j = layer // 2
        if layer % 2 == 0:
            u = rmsnorm(x, ev_norm1_w[j]) @ ev_w_in[j]
            y_a = rwkv7_group(u[..., :RW_IN], rw_mu[j], rw_w0[j], rw_w2[j], rw_a0[j], rw_a2[j], rw_g2[j],
                              rw_k_k[j], rw_k_a[j], rw_r_k[j], rw_ln_w[j], rw_ln_b[j])
            y_b = mlstm_group(u[..., RW_IN:], ml_conv_w[j], ml_conv_b[j], ml_i_b[j], ml_f_b[j], ml_norm_w[j])
            x = x + jnp.concatenate([y_a, y_b], axis=-1) @ ev_w_out[j]
            x = x + swiglu(rmsnorm(x, ev_norm2_w[j]), ffn_w_gate[j], ffn_w_up[j], ffn_w_down[j])
        else:
            u = rmsnorm(x, od_norm1_w[j]) @ od_w_in[j]
            y_c = hgrn2_group(u[..., :HG_IN], lower_bounds[layer], hg_norm_w[j])
            y_d = mamba2_group(u[..., HG_IN:], mb_conv_w[j], mb_conv_b[j], mb_dt_bias[j], mb_A_log[j],
                               mb_D[j], mb_norm_w[j])
            x = x + jnp.concatenate([y_c, y_d], axis=-1) @ od_w_out[j]
            x = x + moe_swiglu(rmsnorm(x, od_norm2_w[j]), moe_router[j], moe_w_gate[j], moe_w_up[j], moe_w_down[j])
    return rmsnorm(x, final_norm_w)
```

```cpp
#include <hip/hip_runtime.h>
#include <cstdio>
#include <cstdint>

#ifndef MK_N_LAUNCHES
#define MK_N_LAUNCHES 21
#endif

#define GAS __attribute__((address_space(1)))
#define LAS __attribute__((address_space(3)))
typedef unsigned short bf16;
typedef unsigned v4u __attribute__((ext_vector_type(4)));
typedef unsigned v2u __attribute__((ext_vector_type(2)));
typedef float f32x4 __attribute__((ext_vector_type(4)));
typedef float f32x2 __attribute__((ext_vector_type(2)));
typedef short bf16x8 __attribute__((ext_vector_type(8)));

constexpr int M_TOK = 8192, SEQ = 2048, DM = 2048;
constexpr int EVP = 6656, ODP = 7424;
constexpr int FF = 5632, FE = 2816, NEXP = 8;
constexpr int NPHASE = 21;

constexpr size_t MiB = 1u << 20;
constexpr size_t WS_CTL = 0, CTL_ZERO_BYTES = 1 * MiB;
constexpr size_t WS_WLORA = 1 * MiB, WS_WEVIN = 4 * MiB, WS_WEVOUT = 30 * MiB, WS_WFGU = 38 * MiB, WS_WFD = 82 * MiB;
constexpr size_t WS_WODIN = 104 * MiB, WS_WODOUT = 133 * MiB, WS_WMGU = 141 * MiB, WS_WMD = 317 * MiB;
constexpr size_t WS_XN = 405 * MiB, WS_Y = 437 * MiB, WS_X1 = 469 * MiB, WS_SCR = 533 * MiB;
constexpr size_t SC_U = WS_SCR, SC_LW = WS_SCR + 104 * MiB, SC_LA = WS_SCR + 136 * MiB, SC_LG = WS_SCR + 168 * MiB, SC_ALORA = WS_SCR + 200 * MiB;
constexpr size_t SC_YRAW_E = WS_SCR + 208 * MiB, SC_MLQK = WS_SCR + 240 * MiB, SC_HRAW = WS_SCR + 272 * MiB;
constexpr size_t SC_ACT = WS_SCR;
constexpr size_t SC_XBC = WS_SCR + 116 * MiB, SC_ORAW = WS_SCR + 180 * MiB, SC_YRAW_O = WS_SCR + 212 * MiB;
constexpr int MOE_MAXROWS = 18432;
constexpr size_t SC_HS = WS_SCR, SC_ACTS = WS_SCR + 72 * MiB, SC_OUTS = WS_SCR + 171 * MiB;
constexpr size_t SC_TOPK = WS_SCR + 316 * MiB, SC_POS = SC_TOPK + 131072, SC_CNT = SC_POS + 65536, SC_TILES = SC_CNT + 8192;
constexpr size_t WS_END = WS_SCR + 317 * MiB;
static_assert(SC_OUTS + (size_t)MOE_MAXROWS * DM * 4 <= SC_TOPK, "moe map");
static_assert(WS_END <= 907708384ull, "d_ws map exceeds the guaranteed workspace");
constexpr int CW_BAR = 4096;

constexpr int RING_BYTES = 131072, MISC_OFF = RING_BYTES + 320, LDS_BYTES = 147456;

__device__ __forceinline__ float bf2f(bf16 b) { return __uint_as_float(((unsigned)b) << 16); }
__device__ __forceinline__ unsigned f2bf(float f) { unsigned u = __float_as_uint(f); return (u + 0x7fffu + ((u >> 16) & 1u)) >> 16; }
__device__ __forceinline__ unsigned cvt_pk_bf16(float lo, float hi) { unsigned r; asm volatile("v_cvt_pk_bf16_f32 %0, %1, %2" : "=v"(r) : "v"(lo), "v"(hi)); return r; }
__device__ __forceinline__ float sigmoidf_(float x) { return 1.0f / (1.0f + __expf(-x)); }
__device__ __forceinline__ float siluf_(float x) { return x / (1.0f + __expf(-x)); }
__device__ __forceinline__ float wave_sum(float v) {
#pragma unroll
    for (int o = 1; o < 64; o <<= 1) v += __shfl_xor(v, o);
    return v;
}
template <int CTRL> __device__ __forceinline__ float dppf(float v) { return __builtin_bit_cast(float, __builtin_amdgcn_mov_dpp(__builtin_bit_cast(int, v), CTRL, 0xf, 0xf, false)); }
__device__ __forceinline__ float allred16(float v) { v += dppf<0x128>(v); v += dppf<0x124>(v); v += dppf<0x122>(v); v += dppf<0x121>(v); return v; }

namespace pg8 {
#define PG8_LAS __attribute__((address_space(3)))
typedef unsigned short bf16_t;
typedef unsigned u32x4 __attribute__((ext_vector_type(4)));
constexpr int BM = 256, BK = 64, HALF = 128, HTB = HALF * BK * 2, STAGE_BYTES = 8 * HTB, NXCD = 8, WGM = 8;
__host__ __device__ __forceinline__ int lds_byte(int r, int c) { const int st = (r >> 4) * 2 + (c >> 5), rr = r & 15, cc = c & 31, ob = rr * 64 + cc * 2; return st * 1024 + (ob ^ (((ob >> 9) & 1) << 5)); }
__host__ __device__ __forceinline__ void stage_rc(int b, int& R, int& C) { const int st = b / 1024, sb = b % 1024, swz = sb ^ (((sb >> 9) & 1) << 5); R = (st >> 1) * 16 + swz / 64; C = (st & 1) * 32 + (swz % 64) / 2; }
__host__ __device__ __forceinline__ int perm32(int rho) { const int n = rho >> 4, i = rho & 15; return 8 * (i >> 2) + 4 * n + (i & 3); }

struct Unit { int pm, pn, pc; };
struct Gemm { const bf16_t* A; const bf16_t* Bt; int M, N, K; };

struct StaticOrder {
    int nM, nN, nwg, G, c;
    __device__ void init(int M, int N, int G_, int c_) { nM = M / BM; nN = N / BM; nwg = nM * nN; G = G_; c = c_; }
    __device__ bool next(int i, Unit& u) const {
        const long L = (long)i * G + c; if (L >= nwg) return false;
        int wgid = (int)L; { const int q = nwg / NXCD, r = nwg % NXCD, xcd = wgid % NXCD, off = wgid / NXCD; wgid = (xcd < r ? xcd * (q + 1) : r * (q + 1) + (xcd - r) * q) + off; }
        const int nig = WGM * nN, gid = wgid / nig, fm = gid * WGM, gsz = (nM - fm) < WGM ? (nM - fm) : WGM;
        u.pm = fm + ((wgid % nig) % gsz); u.pn = (wgid % nig) / gsz; u.pc = u.pn; return true;
    }
    __device__ __forceinline__ void a_ready(const Unit&) const {}
    __device__ __forceinline__ void done(const Unit&) const {}
};
struct GroupedOrder {
    const int* tile_e; int NT, npn, G, c;
    __device__ bool next(int i, Unit& u) const {
        const long L = (long)i * G + c; if (L >= (long)NT * npn) return false;
        const int t = (int)(L % NT), pnl = (int)(L / NT);
        const int e = __builtin_amdgcn_readfirstlane(tile_e[t]);
        u.pm = t; u.pn = e * npn + pnl; u.pc = pnl; return true;
    }
    __device__ __forceinline__ void a_ready(const Unit&) const {}
    __device__ __forceinline__ void done(const Unit&) const {}
};

struct EpiBf16 {
    static constexpr bool PERM = true;
    bf16_t* O; int ldc;
    __device__ __forceinline__ void operator()(const f32x4 (&acc)[2][2][4][2], const Unit& u, int wr, int wc, int fr, int fq) const {
        const int row0 = u.pm * BM + wr * 64 + fr, col0 = u.pc * BM + wc * 32 + 8 * fq;
#pragma unroll
        for (int ai = 0; ai < 2; ++ai)
#pragma unroll
            for (int m = 0; m < 4; ++m) { bf16_t* rowp = O + (size_t)(row0 + ai * HALF + m * 16) * ldc + col0;
#pragma unroll
                for (int bj = 0; bj < 2; ++bj) { const f32x4 v0 = acc[ai][bj][m][0], v1 = acc[ai][bj][m][1];
                    u32x4 w; w.x = cvt_pk_bf16(v0[0], v0[1]); w.y = cvt_pk_bf16(v0[2], v0[3]); w.z = cvt_pk_bf16(v1[0], v1[1]); w.w = cvt_pk_bf16(v1[2], v1[3]);
                    *(u32x4*)(rowp + bj * HALF) = w; } }
    }
};
struct EpiSwiGLU {
    static constexpr bool PERM = true;
    bf16_t* O; int ldc;
    __device__ __forceinline__ void operator()(const f32x4 (&acc)[2][2][4][2], const Unit& u, int wr, int wc, int fr, int fq) const {
        const int row0 = u.pm * BM + wr * 64 + fr, col0 = u.pc * HALF + wc * 32 + 8 * fq;
#pragma unroll
        for (int ai = 0; ai < 2; ++ai)
#pragma unroll
            for (int m = 0; m < 4; ++m) { bf16_t* rowp = O + (size_t)(row0 + ai * HALF + m * 16) * ldc + col0;
                float r[8];
#pragma unroll
                for (int n = 0; n < 2; ++n)
#pragma unroll
                    for (int j = 0; j < 4; ++j) { const float g = acc[ai][0][m][n][j], up = acc[ai][1][m][n][j]; r[n * 4 + j] = g * __builtin_amdgcn_rcpf(1.0f + __expf(-g)) * up; }
                u32x4 w; w.x = cvt_pk_bf16(r[0], r[1]); w.y = cvt_pk_bf16(r[2], r[3]); w.z = cvt_pk_bf16(r[4], r[5]); w.w = cvt_pk_bf16(r[6], r[7]);
                *(u32x4*)rowp = w; }
    }
};
struct EpiResF32 {
    static constexpr bool PERM = false;
    const float* res; float* out; int ldc;
    __device__ __forceinline__ void operator()(const f32x4 (&acc)[2][2][4][2], const Unit& u, int wr, int wc, int fr, int fq) const {
        const int row0 = u.pm * BM + wr * 64 + fr, col0 = u.pc * BM + wc * 32 + 4 * fq;
#pragma unroll
        for (int ai = 0; ai < 2; ++ai)
#pragma unroll
            for (int m = 0; m < 4; ++m) { const size_t off = (size_t)(row0 + ai * HALF + m * 16) * ldc + col0;
#pragma unroll
                for (int bj = 0; bj < 2; ++bj)
#pragma unroll
                    for (int n = 0; n < 2; ++n) { f32x4 v = acc[ai][bj][m][n]; if (res) v = v + *(const f32x4*)(res + off + bj * HALF + n * 16); *(f32x4*)(out + off + bj * HALF + n * 16) = v; } }
    }
};
struct EpiLora {
    static constexpr bool PERM = false;
    float* LWAG; const float* w0; const float* a0;
    __device__ __forceinline__ void operator()(const f32x4 (&acc)[2][2][4][2], const Unit& u, int wr, int wc, int fr, int fq) const {
        const int kind = u.pc >> 2; const int row0 = u.pm * BM + wr * 64 + fr, col0 = (u.pc & 3) * BM + wc * 32 + 4 * fq;
        float* dst = LWAG + (size_t)kind * ((size_t)8192 * 1024); const float* bias = kind == 0 ? w0 : a0;
#pragma unroll
        for (int bj = 0; bj < 2; ++bj)
#pragma unroll
            for (int n = 0; n < 2; ++n) { const int c = col0 + bj * HALF + n * 16; f32x4 bv = (f32x4){0.f, 0.f, 0.f, 0.f}; if (kind < 2) bv = *(const f32x4*)(bias + c);
#pragma unroll
                for (int ai = 0; ai < 2; ++ai)
#pragma unroll
                    for (int m = 0; m < 4; ++m) { f32x4 v = acc[ai][bj][m][n] + bv;
                        if (kind < 2) {
#pragma unroll
                            for (int j = 0; j < 4; ++j) { const float s = 1.0f / (1.0f + __expf(-v[j])); v[j] = kind == 0 ? __expf(-0.6065306597126334f * s) : s; } }
                        *(f32x4*)(dst + (size_t)(row0 + ai * HALF + m * 16) * 1024 + c) = v; } }
    }
};

template <class Epi, class Sched, bool ALIGN_EPI, bool SP2>
__device__ __forceinline__ void gemm_phase(PG8_LAS unsigned char* lds, const Gemm g, const Sched& S, const Epi& E) {
    const int tid = threadIdx.x, wid = __builtin_amdgcn_readfirstlane(tid >> 6), lane = tid & 63, wr = wid >> 2, wc = wid & 3, fr = lane & 15, fq = lane >> 4;
    const int K = g.K, nt = K / BK;
    unsigned voffA[2], voffB[2];
#pragma unroll
    for (int i = 0; i < 2; ++i) { int R, C; stage_rc(tid * 16 + i * 8192, R, C); const int Rb = Epi::PERM ? ((R & ~31) + perm32(R & 31)) : R;
        voffA[i] = (unsigned)(R * K + C) * 2u; voffB[i] = (unsigned)(Rb * K + C) * 2u; }
    const size_t kstep = (size_t)(BK * 2);
    const size_t hstep = (size_t)HALF * K * 2;
    const size_t tstep = 2 * hstep;
    const unsigned ldsw = (unsigned)wid * 1024u;
    const int aoff = lds_byte(wr * 64 + fr, fq * 8), boff = lds_byte(wc * 32 + fr, fq * 8);
#define PG8_SA(b, h) (((b) * 2 + (h)) * HTB)
#define PG8_SB(b, h) ((4 + (b) * 2 + (h)) * HTB)
#define PG8_STAGE(bufoff, gbase, voff) do { _Pragma("unroll") for (int _i = 0; _i < 2; ++_i) \
        __builtin_amdgcn_global_load_lds((const unsigned*)((const char*)(gbase) + (voff)[_i]), (PG8_LAS unsigned*)(lds + (bufoff) + ldsw + _i * 8192), 16, 0, 0); } while (0)
#define PG8_LDA(dst, b, h) do { _Pragma("unroll") for (int m = 0; m < 4; ++m) _Pragma("unroll") for (int k = 0; k < 2; ++k) dst[m][k] = *(const PG8_LAS bf16x8*)(lds + PG8_SA(b, h) + aoff + m * 2048 + k * 1024); } while (0)
#define PG8_LDB(dst, b, h) do { _Pragma("unroll") for (int n = 0; n < 2; ++n) _Pragma("unroll") for (int k = 0; k < 2; ++k) dst[n][k] = *(const PG8_LAS bf16x8*)(lds + PG8_SB(b, h) + boff + n * 2048 + k * 1024); } while (0)
#define PG8_MMA(ai, bj, At, Bt) do { __builtin_amdgcn_s_setprio(1); _Pragma("unroll") for (int m = 0; m < 4; ++m) _Pragma("unroll") for (int n = 0; n < 2; ++n) _Pragma("unroll") for (int k = 0; k < 2; ++k) \
        acc[ai][bj][m][n] = __builtin_amdgcn_mfma_f32_16x16x32_bf16(Bt[n][k], At[m][k], acc[ai][bj][m][n], 0, 0, 0); __builtin_amdgcn_s_setprio(0); } while (0)
#define PG8_WAIT_V(n) asm volatile("s_waitcnt vmcnt(" #n ")" ::: "memory")
#define PG8_WAIT_L(n) asm volatile("s_waitcnt lgkmcnt(" #n ")" ::: "memory")
#define PG8_BAR __builtin_amdgcn_s_barrier()
#define PG8_SCHED __builtin_amdgcn_sched_barrier(0)
    Unit cur, nxt; int ui = 0;
    if (!S.next(0, cur)) return;
    f32x4 acc[2][2][4][2];
#pragma unroll
    for (int a = 0; a < 2; ++a)
#pragma unroll
        for (int b = 0; b < 2; ++b)
#pragma unroll
            for (int m = 0; m < 4; ++m)
#pragma unroll
                for (int n = 0; n < 2; ++n) acc[a][b][m][n] = (f32x4){0.f, 0.f, 0.f, 0.f};
    bf16x8 At[4][2], B0[2][2], B1[2][2];
    const char* cA = (const char*)g.A + (size_t)cur.pm * tstep; const char* cB = (const char*)g.Bt + (size_t)cur.pn * tstep;
    S.a_ready(cur);
    if constexpr (SP2) {
        PG8_STAGE(PG8_SB(0, 0), cB, voffB); PG8_STAGE(PG8_SB(0, 1), cB + hstep, voffB); PG8_STAGE(PG8_SA(0, 0), cA, voffA); PG8_STAGE(PG8_SA(0, 1), cA + hstep, voffA);
        if (wr == 1) PG8_BAR;
        PG8_WAIT_V(2); PG8_BAR;
        PG8_STAGE(PG8_SB(1, 0), cB + kstep, voffB); PG8_STAGE(PG8_SA(1, 0), cA + kstep, voffA); PG8_STAGE(PG8_SB(1, 1), cB + hstep + kstep, voffB);
        PG8_WAIT_V(6); PG8_BAR;
    } else {
        PG8_STAGE(PG8_SB(0, 0), cB, voffB); PG8_STAGE(PG8_SA(0, 0), cA, voffA); PG8_STAGE(PG8_SB(0, 1), cB + hstep, voffB); PG8_STAGE(PG8_SA(0, 1), cA + hstep, voffA);
        if (wr == 1) PG8_BAR;
        PG8_WAIT_V(4); PG8_BAR;
        PG8_STAGE(PG8_SB(1, 0), cB + kstep, voffB); PG8_STAGE(PG8_SA(1, 0), cA + kstep, voffA); PG8_STAGE(PG8_SB(1, 1), cB + hstep + kstep, voffB);
        PG8_WAIT_V(6); PG8_BAR;
    }
    for (;;) {
        const bool has_next = S.next(ui + 1, nxt);
        const char* nA = has_next ? (const char*)g.A + (size_t)nxt.pm * tstep : cA; const char* nB = has_next ? (const char*)g.Bt + (size_t)nxt.pn * tstep : cB;
        for (int t = 0; t < nt; t += 2) {
            const bool last = (t == nt - 2);
            const char* a1 = cA + (size_t)(t + 1) * kstep;
            const char* a2 = last ? nA : cA + (size_t)(t + 2) * kstep; const char* b2 = last ? nB : cB + (size_t)(t + 2) * kstep;
            const char* a3 = a2 + kstep; const char* b3 = b2 + kstep;
            if (last && has_next) S.a_ready(nxt);
            if constexpr (SP2) {
            PG8_LDB(B0, 0, 0); PG8_LDB(B1, 0, 1); PG8_SCHED; PG8_LDA(At, 0, 0); PG8_STAGE(PG8_SA(1, 1), a1 + hstep, voffA);
            PG8_WAIT_V(8); PG8_WAIT_L(0); PG8_BAR; PG8_MMA(0, 0, At, B0); PG8_MMA(0, 1, At, B1); PG8_BAR; PG8_SCHED;
            PG8_LDA(At, 0, 1); PG8_STAGE(PG8_SB(0, 0), b2, voffB); PG8_STAGE(PG8_SB(0, 1), b2 + hstep, voffB); PG8_STAGE(PG8_SA(0, 0), a2, voffA);
            PG8_WAIT_V(8); PG8_WAIT_L(0); PG8_BAR; PG8_MMA(1, 0, At, B0); PG8_MMA(1, 1, At, B1); PG8_BAR; PG8_SCHED;
            PG8_LDB(B0, 1, 0); PG8_LDB(B1, 1, 1); PG8_SCHED; PG8_LDA(At, 1, 0); PG8_STAGE(PG8_SA(0, 1), a2 + hstep, voffA);
            PG8_WAIT_V(8); PG8_WAIT_L(0); PG8_BAR; PG8_MMA(0, 0, At, B0); PG8_MMA(0, 1, At, B1); PG8_BAR; PG8_SCHED;
            PG8_LDA(At, 1, 1); PG8_STAGE(PG8_SB(1, 0), b3, voffB); PG8_STAGE(PG8_SB(1, 1), b3 + hstep, voffB); PG8_STAGE(PG8_SA(1, 0), a3, voffA);
            PG8_WAIT_V(8); PG8_WAIT_L(0); PG8_BAR; PG8_MMA(1, 0, At, B0); PG8_MMA(1, 1, At, B1); PG8_BAR; PG8_SCHED;
            } else {
            PG8_LDB(B0, 0, 0); PG8_SCHED; PG8_LDA(At, 0, 0); PG8_STAGE(PG8_SA(1, 1), a1 + hstep, voffA);
            PG8_WAIT_L(8); PG8_BAR; PG8_WAIT_L(0); PG8_MMA(0, 0, At, B0); PG8_BAR; PG8_SCHED;
            PG8_LDB(B1, 0, 1); PG8_STAGE(PG8_SB(0, 0), b2, voffB);
            PG8_BAR; PG8_WAIT_L(0); PG8_MMA(0, 1, At, B1); PG8_BAR;
            PG8_LDA(At, 0, 1); PG8_STAGE(PG8_SA(0, 0), a2, voffA);
            PG8_BAR; PG8_WAIT_L(0); PG8_MMA(1, 0, At, B0); PG8_BAR; PG8_SCHED;
            PG8_STAGE(PG8_SB(0, 1), b2 + hstep, voffB);
            PG8_WAIT_V(6); PG8_BAR; PG8_MMA(1, 1, At, B1); PG8_BAR;
            PG8_LDB(B0, 1, 0); PG8_SCHED; PG8_LDA(At, 1, 0); PG8_STAGE(PG8_SA(0, 1), a2 + hstep, voffA);
            PG8_WAIT_L(8); PG8_BAR; PG8_WAIT_L(0); PG8_MMA(0, 0, At, B0); PG8_BAR; PG8_SCHED;
            PG8_LDB(B1, 1, 1); PG8_STAGE(PG8_SB(1, 0), b3, voffB);
            PG8_BAR; PG8_WAIT_L(0); PG8_MMA(0, 1, At, B1); PG8_BAR;
            PG8_LDA(At, 1, 1); PG8_STAGE(PG8_SA(1, 0), a3, voffA);
            PG8_BAR; PG8_WAIT_L(0); PG8_MMA(1, 0, At, B0); PG8_BAR; PG8_SCHED;
            PG8_STAGE(PG8_SB(1, 1), b3 + hstep, voffB);
            PG8_WAIT_V(6); PG8_BAR; PG8_MMA(1, 1, At, B1); PG8_BAR;
            }
        }
        if constexpr (ALIGN_EPI) { if (wr == 0) PG8_BAR; }
        E(acc, cur, wr, wc, fr, fq); S.done(cur);
        if (!has_next) break;
#pragma unroll
        for (int a = 0; a < 2; ++a)
#pragma unroll
            for (int b = 0; b < 2; ++b)
#pragma unroll
                for (int m = 0; m < 4; ++m)
#pragma unroll
                    for (int n = 0; n < 2; ++n) acc[a][b][m][n] = (f32x4){0.f, 0.f, 0.f, 0.f};
        cur = nxt; cA = nA; cB = nB; ++ui;
        if constexpr (ALIGN_EPI) { if (wr == 1) PG8_BAR; }
    }
    PG8_WAIT_V(0);
    if constexpr (!ALIGN_EPI) { if (wr == 0) PG8_BAR; }
    PG8_BAR;
#undef PG8_SA
#undef PG8_SB
#undef PG8_STAGE
#undef PG8_LDA
#undef PG8_LDB
#undef PG8_MMA
#undef PG8_WAIT_V
#undef PG8_WAIT_L
#undef PG8_BAR
#undef PG8_SCHED
}
}

#define XB_TMO      128
#define XB_XCNT(j)  (256  + 64 * (j))
#define XB_XSUB(j)  (1280 + 64 * (j))
#define XB_XGEN(j)  (2304 + 64 * (j))
#define XB_TOP      3328
#define XB_TOPGEN   3392
#define XCD_BAR_WORDS 3456
#define XB_SPIN_CAP (1u << 18)
__device__ __forceinline__ unsigned xb_ld(unsigned* p)              { return __hip_atomic_load(p, __ATOMIC_RELAXED, __HIP_MEMORY_SCOPE_AGENT); }
__device__ __forceinline__ unsigned xb_add(unsigned* p, unsigned v) { return __hip_atomic_fetch_add(p, v, __ATOMIC_RELAXED, __HIP_MEMORY_SCOPE_AGENT); }
__device__ __forceinline__ unsigned xb_xcc_id() { return (unsigned)__builtin_amdgcn_s_getreg((3 << 11) | 20) & 0xFu; }
#define XB_SPIN(cond, bar) do { unsigned _sp = 0; while (cond) { __builtin_amdgcn_s_sleep(1); \
    if ((++_sp & 255u) == 0u) { if (xb_ld(&(bar)[XB_TMO])) break; if (_sp > XB_SPIN_CAP) { atomicAdd(&(bar)[XB_TMO], 1u); break; } } } } while (0)
struct XcdBarrier { unsigned* bar; unsigned x; volatile LAS unsigned* st; };
__device__ __forceinline__ XcdBarrier xcd_barrier_post(unsigned* bar, volatile LAS unsigned* st) {
    XcdBarrier b; b.bar = bar; b.x = xb_xcc_id(); b.st = st;
    if (threadIdx.x == 0) (void)xb_add(&bar[XB_XCNT(b.x)], 1u);
    return b;
}
__device__ __forceinline__ void xcd_barrier_complete(unsigned* bar, unsigned x, unsigned& nloc, unsigned& nx) {
    const unsigned G = gridDim.x * gridDim.y * gridDim.z;
    unsigned sum, cnt, mine, sp = 0u;
    for (;;) {
        sum = 0u; cnt = 0u; mine = 0u;
#pragma unroll
        for (unsigned j = 0; j < 16; ++j) { const unsigned c = xb_ld(&bar[XB_XCNT(j)]); sum += c; cnt += (c > 0u) ? 1u : 0u; mine = (j == x) ? c : mine; }
        if (sum == G) break;
        __builtin_amdgcn_s_sleep(1);
        if ((++sp & 255u) == 0u) { if (xb_ld(&bar[XB_TMO])) break; if (sp > XB_SPIN_CAP) { atomicAdd(&bar[XB_TMO], 1u); break; } }
    }
    nloc = mine > 0u ? mine : 1u; nx = cnt > 0u ? cnt : 1u;
}
__device__ __forceinline__ void xcd_barrier(const XcdBarrier& b) {
    asm volatile("s_waitcnt vmcnt(0)" ::: "memory");
    __syncthreads();
    if (threadIdx.x == 0) {
        unsigned* bar = b.bar;
        __builtin_amdgcn_s_waitcnt(0);
        unsigned nloc = b.st[0], nx = b.st[1];
        if (nloc == 0u) { xcd_barrier_complete(bar, b.x, nloc, nx); b.st[0] = nloc; b.st[1] = nx; }
        const unsigned old = xb_add(&bar[XB_XSUB(b.x)], 1u);
        const unsigned gen = old / nloc;
        if (old + 1u == (gen + 1u) * nloc) {
            __builtin_amdgcn_fence(__ATOMIC_RELEASE, "agent");
            asm volatile("s_waitcnt vmcnt(0)" ::: "memory");
            const unsigned og = xb_add(&bar[XB_TOP], 1u);
            const unsigned tg = og / nx;
            if (og + 1u == (tg + 1u) * nx) xb_add(&bar[XB_TOPGEN], 1u);
            else XB_SPIN(xb_ld(&bar[XB_TOPGEN]) == tg, bar);
            __builtin_amdgcn_fence(__ATOMIC_ACQUIRE, "agent");
            xb_add(&bar[XB_XGEN(b.x)], 1u);
            asm volatile("s_waitcnt vmcnt(0)" ::: "memory");
        } else {
            XB_SPIN(xb_ld(&bar[XB_XGEN(b.x)]) == gen, bar);
            __builtin_amdgcn_fence(__ATOMIC_ACQUIRE, "agent");
            asm volatile("s_waitcnt vmcnt(0)" ::: "memory");
        }
    }
    __syncthreads();
}

struct Ctx { LAS unsigned char* lds; int tid, lane, wave, bid, G; };

__device__ __forceinline__ void conv_tile(const float* W, int K, int N, bf16* WT, int mode, int kt, int ntile, LAS float* scr, int tid) {
    const int k0 = kt * 64, n0 = ntile * 64;
    { const int n = tid & 63, kq = tid >> 6;
#pragma unroll
      for (int i = 0; i < 8; ++i) { const int kk = kq + 8 * i; scr[kk * 65 + n] = (n0 + n < N) ? W[(size_t)(k0 + kk) * N + n0 + n] : 0.f; } }
    __syncthreads();
    { const int nn = tid >> 3, kc = tid & 7; float v[8];
#pragma unroll
      for (int j = 0; j < 8; ++j) v[j] = scr[(kc * 8 + j) * 65 + nn];
      const int ns = n0 + nn; const int drow = mode == 0 ? ns : ((ns >> 7) * 256 + (ns & 127) + (mode == 2 ? 128 : 0));
      v4u o; o.x = cvt_pk_bf16(v[0], v[1]); o.y = cvt_pk_bf16(v[2], v[3]); o.z = cvt_pk_bf16(v[4], v[5]); o.w = cvt_pk_bf16(v[6], v[7]);
      *(v4u*)(WT + (size_t)drow * K + k0 + kc * 8) = o; }
    __syncthreads();
}
__device__ __forceinline__ void conv_kind(const Ctx& c, const float* W, int K, int N, int Npad, bf16* WT, int mode, int nmat, size_t sstr, size_t dstr, int& base) {
    const int nkt = K / 64, nnt = Npad / 64, per = nkt * nnt, count = per * nmat;
    LAS float* scr = (LAS float*)c.lds;
    int first = (c.bid - base % c.G + c.G) % c.G;
    for (int it = first; it < count; it += c.G) {
        const int mat = it / per, r = it % per, kt = r / nnt, ntile = r % nnt;
        conv_tile(W + (size_t)mat * sstr, K, N, WT + (size_t)mat * dstr, mode, kt, ntile, scr, c.tid);
    }
    base += count;
}
__device__ __forceinline__ void rmsnorm_row_bf16(const float* xr, const float* w, bf16* orow, int lane) {
    f32x4 v[8]; float ss = 0.f;
#pragma unroll
    for (int j = 0; j < 8; ++j) { v[j] = *(const f32x4*)(xr + 4 * lane + 256 * j); ss += (v[j].x * v[j].x + v[j].y * v[j].y) + (v[j].z * v[j].z + v[j].w * v[j].w); }
    const float rs = 1.0f / sqrtf(wave_sum(ss) * (1.0f / 2048.0f) + 1e-6f);
#pragma unroll
    for (int j = 0; j < 8; ++j) { const f32x4 wv = *(const f32x4*)(w + 4 * lane + 256 * j); const f32x4 o = v[j] * rs * wv;
        v2u p; p.x = cvt_pk_bf16(o.x, o.y); p.y = cvt_pk_bf16(o.z, o.w); *(v2u*)(orow + 4 * lane + 256 * j) = p; }
}
__device__ __forceinline__ void rmsnorm_phase(const Ctx& c, const float* X, const float* w, bf16* XN) {
    const int gw = c.bid * 8 + c.wave, NGW = c.G * 8;
    for (int m = gw; m < M_TOK; m += NGW) rmsnorm_row_bf16(X + (size_t)m * DM, w, XN + (size_t)m * DM, c.lane);
}

constexpr int TS = 64;
__device__ __forceinline__ void scan_writeout(const LAS float* OUT, float* dst, int ldd, int tid) {
    const int tt = tid >> 3, i4 = (tid & 7) * 4;
    *(f32x4*)(dst + (size_t)tt * ldd + i4) = *(const LAS f32x4*)(OUT + tt * 32 + i4);
}

__device__ __forceinline__ void scan_rwkv(const Ctx& c, int task, const bf16* U, const float* LW, const float* LA, const float* mu, const float* k_k, const float* k_a, float* YRAW) {
    const int bb = task & 1, head = (task >> 1) & 15, batch = task >> 5;
    LAS float* R = (LAS float*)c.lds; LAS float* W = R + 4096; LAS float* KP = R + 8192; LAS float* KKN = R + 12288; LAS float* BV = R + 16384; LAS float* VB = R + 20480; LAS float* OUT = R + 22528;
    const int s = c.lane & 15, il = 4 * c.wave + (c.lane >> 4);
    const int col = head * 64 + c.lane;
    const float mur = mu[col], muk = mu[1024 + col], muv = mu[2048 + col], kkc = k_k[col], kac = k_a[col];
    float S[4] = {0.f, 0.f, 0.f, 0.f};
    for (int t0 = 0; t0 < SEQ; t0 += TS) {
#pragma unroll 2
        for (int i = 0; i < 8; ++i) {
            const int tt = c.wave + 8 * i, t = t0 + tt; const size_t m = (size_t)batch * SEQ + t;
            const bf16* ur = U + m * EVP;
            float r = bf2f(ur[col]), k = bf2f(ur[1024 + col]), v = bf2f(ur[2048 + col]);
            float rp = 0.f, kp_ = 0.f, vp = 0.f;
            if (t > 0) { rp = bf2f(ur[col - EVP]); kp_ = bf2f(ur[1024 + col - EVP]); vp = bf2f(ur[2048 + col - EVP]); }
            r += (rp - r) * mur; k += (kp_ - k) * muk; v += (vp - v) * muv;
            const float wv = LW[m * 1024 + col], av = LA[m * 1024 + col];
            float kk = k * kkc; const float ss = wave_sum(kk * kk); kk *= 1.0f / sqrtf(fmaxf(ss, 1e-12f));
            const float kpv = k * (1.0f + (av - 1.0f) * kac);
            R[tt * 64 + c.lane] = r; W[tt * 64 + c.lane] = wv; KP[tt * 64 + c.lane] = kpv; KKN[tt * 64 + c.lane] = -kk; BV[tt * 64 + c.lane] = kk * av;
            if ((c.lane >> 5) == bb) VB[tt * 32 + (c.lane & 31)] = v;
        }
        __syncthreads();
        for (int tt = 0; tt < TS; ++tt) {
            const f32x4 kkn = *(const LAS f32x4*)(KKN + tt * 64 + 4 * s), w4 = *(const LAS f32x4*)(W + tt * 64 + 4 * s), bv = *(const LAS f32x4*)(BV + tt * 64 + 4 * s);
            const f32x4 kp4 = *(const LAS f32x4*)(KP + tt * 64 + 4 * s), r4 = *(const LAS f32x4*)(R + tt * 64 + 4 * s);
            const float vb = VB[tt * 32 + il];
            float sa = (S[0] * kkn[0] + S[1] * kkn[1]) + (S[2] * kkn[2] + S[3] * kkn[3]);
            sa = allred16(sa);
            float y = 0.f;
#pragma unroll
            for (int e = 0; e < 4; ++e) { S[e] = S[e] * w4[e] + sa * bv[e] + vb * kp4[e]; y += S[e] * r4[e]; }
            y = allred16(y);
            if (s == 0) OUT[tt * 32 + il] = y;
        }
        __syncthreads();
        scan_writeout(OUT, YRAW + ((size_t)batch * SEQ + t0) * 1024 + head * 64 + bb * 32, 1024, c.tid);
    }
    __syncthreads();
}

__device__ __forceinline__ void scan_mlstm(const Ctx& c, int task, const bf16* U, const float* MLQK, const float* i_b, const float* f_b, float* HRAW) {
    const int bb = task & 7, head = (task >> 3) & 3, batch = task >> 5;
    LAS float* QA = (LAS float*)c.lds; LAS float* KA = QA + 8192; LAS float* VB = QA + 16384; LAS float* OUT = QA + 18432; LAS float* SC = QA + 20480;
    const int s = c.lane & 15, il = 4 * c.wave + (c.lane >> 4);
    const float ib = i_b[head], fb = f_b[head];
    float S[8], Nn[8];
#pragma unroll
    for (int e = 0; e < 8; ++e) { S[e] = 0.f; Nn[e] = 0.f; }
    for (int t0 = 0; t0 < SEQ; t0 += TS) {
#pragma unroll 2
        for (int i = 0; i < 8; ++i) {
            const int tt = c.wave + 8 * i; const size_t m = (size_t)batch * SEQ + t0 + tt;
            const bf16* ur = U + m * EVP; const float* qk = MLQK + m * 1024;
            const float ei = __expf(bf2f(ur[6592 + head]) + ib);
            QA[tt * 128 + c.lane] = qk[head * 128 + c.lane] * 0.08838834764831845f; QA[tt * 128 + 64 + c.lane] = qk[head * 128 + 64 + c.lane] * 0.08838834764831845f;
            KA[tt * 128 + c.lane] = qk[512 + head * 128 + c.lane] * ei; KA[tt * 128 + 64 + c.lane] = qk[512 + head * 128 + 64 + c.lane] * ei;
            if (c.lane < 32) VB[tt * 32 + c.lane] = bf2f(ur[4544 + head * 256 + bb * 32 + c.lane]);
            if (c.lane == 32) SC[tt] = sigmoidf_(bf2f(ur[6596 + head]) + fb);
        }
        __syncthreads();
        for (int tt = 0; tt < TS; ++tt) {
            const f32x4 q0 = *(const LAS f32x4*)(QA + tt * 128 + 4 * s), q1 = *(const LAS f32x4*)(QA + tt * 128 + 64 + 4 * s);
            const f32x4 k0 = *(const LAS f32x4*)(KA + tt * 128 + 4 * s), k1 = *(const LAS f32x4*)(KA + tt * 128 + 64 + 4 * s);
            const float f = SC[tt], vb = VB[tt * 32 + il];
            float y = 0.f, d = 0.f;
#pragma unroll
            for (int e = 0; e < 4; ++e) {
                S[e] = f * S[e] + k0[e] * vb; Nn[e] = f * Nn[e] + k0[e]; y += q0[e] * S[e]; d += q0[e] * Nn[e];
                S[4 + e] = f * S[4 + e] + k1[e] * vb; Nn[4 + e] = f * Nn[4 + e] + k1[e]; y += q1[e] * S[4 + e]; d += q1[e] * Nn[4 + e];
            }
            y = allred16(y); d = allred16(d);
            if (s == 0) OUT[tt * 32 + il] = y / fmaxf(fabsf(d), 1.0f);
        }
        __syncthreads();
        scan_writeout(OUT, HRAW + ((size_t)batch * SEQ + t0) * 1024 + head * 256 + bb * 32, 1024, c.tid);
    }
    __syncthreads();
}

__device__ __forceinline__ void scan_hgrn(const Ctx& c, int task, const bf16* U, const float* lbl, float* ORAW) {
    const int bb = task & 3, head = (task >> 2) & 7, batch = task >> 5;
    LAS float* QA = (LAS float*)c.lds; LAS float* KA = QA + 8192; LAS float* DA = QA + 16384; LAS float* VB = QA + 24576; LAS float* OUT = QA + 26624;
    const int s = c.lane & 15, il = 4 * c.wave + (c.lane >> 4);
    float lb0, lb1;
    { const int a0 = head * 128 + c.lane, a1 = a0 + 64; lb0 = 1.0f / (1.0f + __expf(lbl[a0] - lbl[1024 + a0])); lb1 = 1.0f / (1.0f + __expf(lbl[a1] - lbl[1024 + a1])); }
    float S[8];
#pragma unroll
    for (int e = 0; e < 8; ++e) S[e] = 0.f;
    for (int t0 = 0; t0 < SEQ; t0 += TS) {
#pragma unroll 2
        for (int i = 0; i < 8; ++i) {
            const int tt = c.wave + 8 * i; const size_t m = (size_t)batch * SEQ + t0 + tt;
            const bf16* ur = U + m * ODP;
            const float q0 = bf2f(ur[head * 128 + c.lane]), q1 = bf2f(ur[head * 128 + 64 + c.lane]);
            const float p0 = bf2f(ur[1024 + head * 128 + c.lane]), p1 = bf2f(ur[1024 + head * 128 + 64 + c.lane]);
            const float s0 = sigmoidf_(p0), s1 = sigmoidf_(p1);
            QA[tt * 128 + c.lane] = siluf_(q0); QA[tt * 128 + 64 + c.lane] = siluf_(q1);
            DA[tt * 128 + c.lane] = lb0 + (1.0f - lb0) * s0; DA[tt * 128 + 64 + c.lane] = lb1 + (1.0f - lb1) * s1;
            KA[tt * 128 + c.lane] = (1.0f - lb0) * (1.0f - s0); KA[tt * 128 + 64 + c.lane] = (1.0f - lb1) * (1.0f - s1);
            if (c.lane < 32) VB[tt * 32 + c.lane] = bf2f(ur[2048 + head * 128 + bb * 32 + c.lane]);
        }
        __syncthreads();
        for (int tt = 0; tt < TS; ++tt) {
            const f32x4 q0 = *(const LAS f32x4*)(QA + tt * 128 + 4 * s), q1 = *(const LAS f32x4*)(QA + tt * 128 + 64 + 4 * s);
            const f32x4 k0 = *(const LAS f32x4*)(KA + tt * 128 + 4 * s), k1 = *(const LAS f32x4*)(KA + tt * 128 + 64 + 4 * s);
            const f32x4 d0 = *(const LAS f32x4*)(DA + tt * 128 + 4 * s), d1 = *(const LAS f32x4*)(DA + tt * 128 + 64 + 4 * s);
            const float vb = VB[tt * 32 + il];
            float y = 0.f;
#pragma unroll
            for (int e = 0; e < 4; ++e) {
                S[e] = d0[e] * S[e] + k0[e] * vb; y += q0[e] * S[e];
                S[4 + e] = d1[e] * S[4 + e] + k1[e] * vb; y += q1[e] * S[4 + e];
            }
            y = allred16(y);
            if (s == 0) OUT[tt * 32 + il] = y;
        }
        __syncthreads();
        scan_writeout(OUT, ORAW + ((size_t)batch * SEQ + t0) * 1024 + head * 128 + bb * 32, 1024, c.tid);
    }
    __syncthreads();
}

__device__ __forceinline__ void scan_mamba(const Ctx& c, int task, const bf16* U, const float* XBC, const float* dt_bias, const float* A_log, const float* Dsk, float* YRAW) {
    const int bb = task & 1, head = (task >> 1) & 15, batch = task >> 5, grp = head >> 2;
    LAS float* QA = (LAS float*)c.lds; LAS float* KA = QA + 8192; LAS float* VB = QA + 16384; LAS float* OUT = QA + 18432; LAS float* SC = QA + 20480;
    const int s = c.lane & 15, il = 4 * c.wave + (c.lane >> 4);
    const float dtb = dt_bias[head], Aneg = -__expf(A_log[head]), Dh = Dsk[head];
    float S[8];
#pragma unroll
    for (int e = 0; e < 8; ++e) S[e] = 0.f;
    for (int t0 = 0; t0 < SEQ; t0 += TS) {
#pragma unroll 2
        for (int i = 0; i < 8; ++i) {
            const int tt = c.wave + 8 * i; const size_t m = (size_t)batch * SEQ + t0 + tt;
            const float* xr = XBC + m * 2048;
            QA[tt * 128 + c.lane] = xr[1536 + grp * 128 + c.lane]; QA[tt * 128 + 64 + c.lane] = xr[1536 + grp * 128 + 64 + c.lane];
            KA[tt * 128 + c.lane] = xr[1024 + grp * 128 + c.lane]; KA[tt * 128 + 64 + c.lane] = xr[1024 + grp * 128 + 64 + c.lane];
            if (c.lane < 32) VB[tt * 32 + c.lane] = xr[head * 64 + bb * 32 + c.lane];
            if (c.lane == 32) { const float x = bf2f(U[m * ODP + 7168 + head]) + dtb; const float dt = x > 20.0f ? x : log1pf(__expf(x)); SC[tt * 2] = __expf(Aneg * dt); SC[tt * 2 + 1] = dt; }
        }
        __syncthreads();
        for (int tt = 0; tt < TS; ++tt) {
            const f32x4 q0 = *(const LAS f32x4*)(QA + tt * 128 + 4 * s), q1 = *(const LAS f32x4*)(QA + tt * 128 + 64 + 4 * s);
            const f32x4 k0 = *(const LAS f32x4*)(KA + tt * 128 + 4 * s), k1 = *(const LAS f32x4*)(KA + tt * 128 + 64 + 4 * s);
            const float dec = SC[tt * 2], dt = SC[tt * 2 + 1], vb = VB[tt * 32 + il], xe = vb * dt;
            float y = 0.f;
#pragma unroll
            for (int e = 0; e < 4; ++e) {
                S[e] = dec * S[e] + k0[e] * xe; y += q0[e] * S[e];
                S[4 + e] = dec * S[4 + e] + k1[e] * xe; y += q1[e] * S[4 + e];
            }
            y = allred16(y);
            if (s == 0) OUT[tt * 32 + il] = y + Dh * vb;
        }
        __syncthreads();
        scan_writeout(OUT, YRAW + ((size_t)batch * SEQ + t0) * 1024 + head * 64 + bb * 32, 1024, c.tid);
    }
    __syncthreads();
}

struct Args { const float* in[41]; float* out; unsigned char* ws; int lo, hi; };

__global__ void __launch_bounds__(512, 2) fwd(Args args) {
    extern __shared__ __attribute__((aligned(16))) unsigned char lds_raw[];
    Ctx c; c.lds = (LAS unsigned char*)lds_raw; c.tid = threadIdx.x; c.lane = c.tid & 63; c.wave = __builtin_amdgcn_readfirstlane(c.tid >> 6); c.bid = blockIdx.x; c.G = gridDim.x;
    volatile LAS unsigned* MISC = (volatile LAS unsigned*)(c.lds + MISC_OFF);
    unsigned char* ws = args.ws;
    for (int u = c.tid; u < (LDS_BYTES - RING_BYTES) / 4; u += 512) ((LAS unsigned*)(c.lds + RING_BYTES))[u] = 0u;
    __syncthreads();
    const int lo = args.lo, hi = args.hi;
    XcdBarrier bar; bar.bar = (unsigned*)(ws + WS_CTL) + CW_BAR; bar.x = 0; bar.st = nullptr;
    if (hi - lo > 1) bar = xcd_barrier_post((unsigned*)(ws + WS_CTL) + CW_BAR, MISC + 8);
#define IN(k) (lo <= (k) && (k) < hi)
#define SEAM(k) do { if (IN(k) && IN((k) + 1)) xcd_barrier(bar); } while (0)

    const float* x = args.in[0]; const float* final_norm_w = args.in[1]; const float* hg_lb = args.in[2];
    const float* ev_norm1_w = args.in[3]; const float* ev_w_in = args.in[4]; const float* ev_w_out = args.in[5];
    const float* rw_mu = args.in[6]; const float* rw_w0 = args.in[7]; const float* rw_w2 = args.in[8]; const float* rw_a0 = args.in[9]; const float* rw_a2 = args.in[10]; const float* rw_g2 = args.in[11];
    const float* rw_k_k = args.in[12]; const float* rw_k_a = args.in[13]; const float* rw_r_k = args.in[14]; const float* rw_ln_w = args.in[15]; const float* rw_ln_b = args.in[16];
    const float* ml_conv_w = args.in[17]; const float* ml_conv_b = args.in[18]; const float* ml_i_b = args.in[19]; const float* ml_f_b = args.in[20]; const float* ml_norm_w = args.in[21];
    const float* ev_norm2_w = args.in[22]; const float* ffn_w_gate = args.in[23]; const float* ffn_w_up = args.in[24]; const float* ffn_w_down = args.in[25];
    const float* od_norm1_w = args.in[26]; const float* od_w_in = args.in[27]; const float* od_w_out = args.in[28]; const float* hg_norm_w = args.in[29];
    const float* mb_conv_w = args.in[30]; const float* mb_conv_b = args.in[31]; const float* mb_dt_bias = args.in[32]; const float* mb_A_log = args.in[33]; const float* mb_D = args.in[34]; const float* mb_norm_w = args.in[35];
    const float* od_norm2_w = args.in[36]; const float* moe_router = args.in[37]; const float* moe_w_gate = args.in[38]; const float* moe_w_up = args.in[39]; const float* moe_w_down = args.in[40];
    float* OUT = args.out;
    bf16* W_LORA = (bf16*)(ws + WS_WLORA); bf16* W_EVIN = (bf16*)(ws + WS_WEVIN); bf16* W_EVOUT = (bf16*)(ws + WS_WEVOUT); bf16* W_FGU = (bf16*)(ws + WS_WFGU); bf16* W_FD = (bf16*)(ws + WS_WFD);
    bf16* W_ODIN = (bf16*)(ws + WS_WODIN); bf16* W_ODOUT = (bf16*)(ws + WS_WODOUT); bf16* W_MGU = (bf16*)(ws + WS_WMGU); bf16* W_MD = (bf16*)(ws + WS_WMD);
    bf16* XN = (bf16*)(ws + WS_XN); bf16* Y = (bf16*)(ws + WS_Y); float* X1 = (float*)(ws + WS_X1);
    bf16* U = (bf16*)(ws + SC_U); float* LW = (float*)(ws + SC_LW); float* LA = (float*)(ws + SC_LA); float* LG = (float*)(ws + SC_LG); bf16* ALORA = (bf16*)(ws + SC_ALORA);
    float* YRAW_E = (float*)(ws + SC_YRAW_E); float* MLQK = (float*)(ws + SC_MLQK); float* HRAW = (float*)(ws + SC_HRAW);
    bf16* ACT = (bf16*)(ws + SC_ACT);
    float* XBC = (float*)(ws + SC_XBC); float* ORAW = (float*)(ws + SC_ORAW); float* YRAW_O = (float*)(ws + SC_YRAW_O);
    bf16* HS = (bf16*)(ws + SC_HS); bf16* ACTS = (bf16*)(ws + SC_ACTS); float* OUTS = (float*)(ws + SC_OUTS);
    int* TOPK = (int*)(ws + SC_TOPK); int* POS = (int*)(ws + SC_POS); int* CNT = (int*)(ws + SC_CNT); int* TILES = (int*)(ws + SC_TILES);
    float* X2 = OUT;

    if (IN(0)) {
        int base = 0;
        conv_kind(c, ev_w_in, DM, 6600, EVP, W_EVIN, 0, 1, 0, 0, base);
        conv_kind(c, ev_w_out, DM, DM, DM, W_EVOUT, 0, 1, 0, 0, base);
        conv_kind(c, ffn_w_gate, DM, FF, FF, W_FGU, 1, 1, 0, 0, base);
        conv_kind(c, ffn_w_up, DM, FF, FF, W_FGU, 2, 1, 0, 0, base);
        conv_kind(c, ffn_w_down, FF, DM, DM, W_FD, 0, 1, 0, 0, base);
        conv_kind(c, od_w_in, DM, 7184, ODP, W_ODIN, 0, 1, 0, 0, base);
        conv_kind(c, od_w_out, DM, DM, DM, W_ODOUT, 0, 1, 0, 0, base);
        conv_kind(c, moe_w_gate, DM, FE, FE, W_MGU, 1, NEXP, (size_t)DM * FE, (size_t)2 * FE * DM, base);
        conv_kind(c, moe_w_up, DM, FE, FE, W_MGU, 2, NEXP, (size_t)DM * FE, (size_t)2 * FE * DM, base);
        conv_kind(c, moe_w_down, FE, DM, DM, W_MD, 0, NEXP, (size_t)FE * DM, (size_t)DM * FE, base);
        for (int idx = c.bid * 512 + c.tid; idx < 3072 * 512; idx += c.G * 512) {
            const int k = idx / 3072, n = idx % 3072; float v = 0.f;
            if (n < 1024) { if (k < 96) v = rw_w2[k * 1024 + n]; }
            else if (n < 2048) { if (k >= 96 && k < 192) v = rw_a2[(k - 96) * 1024 + (n - 1024)]; }
            else { if (k >= 192 && k < 448) v = rw_g2[(k - 192) * 1024 + (n - 2048)]; }
            W_LORA[(size_t)n * 512 + k] = (bf16)f2bf(v);
        }
        rmsnorm_phase(c, x, ev_norm1_w, XN);
    }
    SEAM(0);
    if (IN(1)) {
        pg8::Gemm g{XN, W_EVIN, M_TOK, EVP, DM}; pg8::StaticOrder S; S.init(M_TOK, EVP, c.G, c.bid);
        pg8::EpiBf16 E{U, EVP};
        pg8::gemm_phase<pg8::EpiBf16, pg8::StaticOrder, true, true>(c.lds, g, S, E);
    }
    SEAM(1);
    if (IN(2)) {
        for (int m = c.bid; m < M_TOK; m += c.G) {
            const int tl = m & (SEQ - 1); const bf16* ur = U + (size_t)m * EVP;
            for (int idx = c.tid; idx < 1536; idx += 512) {
                if (idx < 512) {
                    float val = 0.f;
                    if (idx < 448) { const int col = 3072 + idx; const float cu = bf2f(ur[col]); const float pv = tl ? bf2f(ur[col - EVP]) : 0.f; const float xs = cu + (pv - cu) * rw_mu[col];
                        val = idx < 96 ? tanhf(xs) : (idx < 192 ? xs : sigmoidf_(xs)); }
                    ALORA[(size_t)m * 512 + idx] = (bf16)f2bf(val);
                } else {
                    const int ch = idx - 512; float acc = ml_conv_b[ch];
#pragma unroll
                    for (int j = 0; j < 4; ++j) { if (tl - 3 + j >= 0) acc += ml_conv_w[j * 1024 + ch] * bf2f(ur[(j - 3) * EVP + 3520 + ch]); }
                    MLQK[(size_t)m * 1024 + ch] = siluf_(acc);
                }
            }
        }
    }
    SEAM(2);
    if (IN(3)) {
        pg8::Gemm g{ALORA, W_LORA, M_TOK, 3072, 512}; pg8::StaticOrder S; S.init(M_TOK, 3072, c.G, c.bid);
        pg8::EpiLora E{LW, rw_w0, rw_a0};
        pg8::gemm_phase<pg8::EpiLora, pg8::StaticOrder, true, true>(c.lds, g, S, E);
    }
    SEAM(3);
    if (IN(4)) {
        for (int task = c.bid; task < 256; task += c.G) {
            if (task < 128) scan_rwkv(c, task, U, LW, LA, rw_mu, rw_k_k, rw_k_a, YRAW_E);
            else scan_mlstm(c, task - 128, U, MLQK, ml_i_b, ml_f_b, HRAW);
        }
    }
    SEAM(4);
    if (IN(5)) {
        for (int m = c.bid; m < M_TOK; m += c.G) {
            const int tl = m & (SEQ - 1); const bf16* ur = U + (size_t)m * EVP;
            if (c.wave < 4) {
                for (int hh = 0; hh < 4; ++hh) {
                    const int head = c.wave * 4 + hh, col = head * 64 + c.lane;
                    const float yv = YRAW_E[(size_t)m * 1024 + col];
                    const float mean = wave_sum(yv) * (1.0f / 64.0f); const float dv = yv - mean; const float var = wave_sum(dv * dv) * (1.0f / 64.0f);
                    const float yn = dv * (1.0f / sqrtf(var + 64e-5f)) * rw_ln_w[col] + rw_ln_b[col];
                    float r = bf2f(ur[col]), k = bf2f(ur[1024 + col]), v = bf2f(ur[2048 + col]);
                    float rp = 0.f, kp = 0.f, vp = 0.f;
                    if (tl) { rp = bf2f(ur[col - EVP]); kp = bf2f(ur[1024 + col - EVP]); vp = bf2f(ur[2048 + col - EVP]); }
                    r += (rp - r) * rw_mu[col]; k += (kp - k) * rw_mu[1024 + col]; v += (vp - v) * rw_mu[2048 + col];
                    const float av = LA[(size_t)m * 1024 + col];
                    const float kpv = k * (1.0f + (av - 1.0f) * rw_k_a[col]);
                    const float bonus = wave_sum(r * kpv * rw_r_k[col]);
                    Y[(size_t)m * DM + col] = (bf16)f2bf((yn + bonus * v) * LG[(size_t)m * 1024 + col]);
                }
            } else {
                const int head = c.wave - 4, col = head * 256 + 4 * c.lane;
                const f32x4 hv = *(const f32x4*)(HRAW + (size_t)m * 1024 + col);
                const float ss = wave_sum((hv.x * hv.x + hv.y * hv.y) + (hv.z * hv.z + hv.w * hv.w));
                const float rs = 1.0f / sqrtf(ss * (1.0f / 256.0f) + 1e-6f);
                const f32x4 nw = *(const f32x4*)(ml_norm_w + col);
                float o[4];
#pragma unroll
                for (int j = 0; j < 4; ++j) o[j] = hv[j] * rs * nw[j] * sigmoidf_(bf2f(ur[5568 + col + j]));
                v2u p; p.x = cvt_pk_bf16(o[0], o[1]); p.y = cvt_pk_bf16(o[2], o[3]); *(v2u*)(Y + (size_t)m * DM + 1024 + col) = p;
            }
        }
    }
    SEAM(5);
    if (IN(6)) {
        pg8::Gemm g{Y, W_EVOUT, M_TOK, DM, DM}; pg8::StaticOrder S; S.init(M_TOK, DM, c.G, c.bid);
        pg8::EpiResF32 E{x, X1, DM};
        pg8::gemm_phase<pg8::EpiResF32, pg8::StaticOrder, false, true>(c.lds, g, S, E);
    }
    SEAM(6);
    if (IN(7)) rmsnorm_phase(c, X1, ev_norm2_w, XN);
    SEAM(7);
    if (IN(8)) {
        pg8::Gemm g{XN, W_FGU, M_TOK, 2 * FF, DM}; pg8::StaticOrder S; S.init(M_TOK, 2 * FF, c.G, c.bid);
        pg8::EpiSwiGLU E{ACT, FF};
        pg8::gemm_phase<pg8::EpiSwiGLU, pg8::StaticOrder, true, true>(c.lds, g, S, E);
    }
    SEAM(8);
    if (IN(9)) {
        pg8::Gemm g{ACT, W_FD, M_TOK, DM, FF}; pg8::StaticOrder S; S.init(M_TOK, DM, c.G, c.bid);
        pg8::EpiResF32 E{X1, X2, DM};
        pg8::gemm_phase<pg8::EpiResF32, pg8::StaticOrder, false, true>(c.lds, g, S, E);
    }
    SEAM(9);
    if (IN(10)) rmsnorm_phase(c, X2, od_norm1_w, XN);
    SEAM(10);
    if (IN(11)) {
        pg8::Gemm g{XN, W_ODIN, M_TOK, ODP, DM}; pg8::StaticOrder S; S.init(M_TOK, ODP, c.G, c.bid);
        pg8::EpiBf16 E{U, ODP};
        pg8::gemm_phase<pg8::EpiBf16, pg8::StaticOrder, true, true>(c.lds, g, S, E);
    }
    SEAM(11);
    if (IN(12)) {
        for (int m = c.bid; m < M_TOK; m += c.G) {
            const int tl = m & (SEQ - 1); const bf16* ur = U + (size_t)m * ODP;
            for (int ch = c.tid; ch < 2048; ch += 512) {
                float acc = mb_conv_b[ch];
#pragma unroll
                for (int j = 0; j < 4; ++j) { if (tl - 3 + j >= 0) acc += mb_conv_w[j * 2048 + ch] * bf2f(ur[(j - 3) * ODP + 5120 + ch]); }
                XBC[(size_t)m * 2048 + ch] = siluf_(acc);
            }
        }
    }
    SEAM(12);
    if (IN(13)) {
        for (int task = c.bid; task < 256; task += c.G) {
            if (task < 128) scan_hgrn(c, task, U, hg_lb, ORAW);
            else scan_mamba(c, task - 128, U, XBC, mb_dt_bias, mb_A_log, mb_D, YRAW_O);
        }
    }
    SEAM(13);
    if (IN(14)) {
        for (int m = c.bid; m < M_TOK; m += c.G) {
            const bf16* ur = U + (size_t)m * ODP;
            if (c.wave < 4) {
#pragma unroll
                for (int hh = 0; hh < 2; ++hh) {
                    const int head = c.wave * 2 + hh, col = head * 128 + 2 * c.lane;
                    const f32x2 ov = *(const f32x2*)(ORAW + (size_t)m * 1024 + col);
                    const float rs = 1.0f / sqrtf(wave_sum(ov.x * ov.x + ov.y * ov.y) * (1.0f / 128.0f) + 1e-6f);
                    const float o0 = ov.x * rs * hg_norm_w[col] * siluf_(bf2f(ur[3072 + col])), o1 = ov.y * rs * hg_norm_w[col + 1] * siluf_(bf2f(ur[3072 + col + 1]));
                    *(unsigned*)(Y + (size_t)m * DM + col) = cvt_pk_bf16(o0, o1);
                }
            } else {
                const int grp = c.wave - 4, col = grp * 256 + 4 * c.lane;
                const f32x4 yv = *(const f32x4*)(YRAW_O + (size_t)m * 1024 + col);
                float t[4]; float ss = 0.f;
#pragma unroll
                for (int j = 0; j < 4; ++j) { t[j] = yv[j] * siluf_(bf2f(ur[4096 + col + j])); ss += t[j] * t[j]; }
                const float rs = 1.0f / sqrtf(wave_sum(ss) * (1.0f / 256.0f) + 1e-6f);
                const f32x4 nw = *(const f32x4*)(mb_norm_w + col);
                v2u p; p.x = cvt_pk_bf16(t[0] * rs * nw[0], t[1] * rs * nw[1]); p.y = cvt_pk_bf16(t[2] * rs * nw[2], t[3] * rs * nw[3]); *(v2u*)(Y + (size_t)m * DM + 1024 + col) = p;
            }
        }
    }
    SEAM(14);
    if (IN(15)) {
        pg8::Gemm g{Y, W_ODOUT, M_TOK, DM, DM}; pg8::StaticOrder S; S.init(M_TOK, DM, c.G, c.bid);
        pg8::EpiResF32 E{X2, X1, DM};
        pg8::gemm_phase<pg8::EpiResF32, pg8::StaticOrder, false, true>(c.lds, g, S, E);
    }
    SEAM(15);
    if (IN(16)) {
        LAS float* RT = (LAS float*)c.lds;
        LAS int* lcnt = (LAS int*)(c.lds + 65536);
        for (int i = c.tid; i < 2048 * 8 / 4; i += 512) *(LAS f32x4*)(RT + 4 * i) = *(const f32x4*)(moe_router + 4 * i);
        __syncthreads();
        for (int blk = c.bid; blk < 256; blk += c.G) {
            if (c.tid < 8) lcnt[c.tid] = 0;
            __syncthreads();
            for (int q = 0; q < 4; ++q) {
                const int m = blk * 32 + c.wave * 4 + q;
                const float* xr = X1 + (size_t)m * DM;
                f32x4 v[8]; float ss = 0.f;
#pragma unroll
                for (int j = 0; j < 8; ++j) { v[j] = *(const f32x4*)(xr + 4 * c.lane + 256 * j); ss += (v[j].x * v[j].x + v[j].y * v[j].y) + (v[j].z * v[j].z + v[j].w * v[j].w); }
                const float rs = 1.0f / sqrtf(wave_sum(ss) * (1.0f / 2048.0f) + 1e-6f);
                float lg[8];
#pragma unroll
                for (int e = 0; e < 8; ++e) lg[e] = 0.f;
#pragma unroll
                for (int j = 0; j < 8; ++j) { const f32x4 wv = *(const f32x4*)(od_norm2_w + 4 * c.lane + 256 * j); const f32x4 hn = v[j] * rs * wv;
                    v2u p; p.x = cvt_pk_bf16(hn.x, hn.y); p.y = cvt_pk_bf16(hn.z, hn.w); *(v2u*)(XN + (size_t)m * DM + 4 * c.lane + 256 * j) = p;
#pragma unroll
                    for (int i = 0; i < 4; ++i) { const int ch = 4 * c.lane + 256 * j + i; const f32x4 r0 = *(const LAS f32x4*)(RT + ch * 8), r1 = *(const LAS f32x4*)(RT + ch * 8 + 4);
                        lg[0] += hn[i] * r0[0]; lg[1] += hn[i] * r0[1]; lg[2] += hn[i] * r0[2]; lg[3] += hn[i] * r0[3]; lg[4] += hn[i] * r1[0]; lg[5] += hn[i] * r1[1]; lg[6] += hn[i] * r1[2]; lg[7] += hn[i] * r1[3]; } }
#pragma unroll
                for (int e = 0; e < 8; ++e) lg[e] = wave_sum(lg[e]);
                int e0 = 0; float v0 = lg[0];
#pragma unroll
                for (int e = 1; e < 8; ++e) if (lg[e] > v0) { v0 = lg[e]; e0 = e; }
                int e1 = -1; float v1 = -3.0e38f;
#pragma unroll
                for (int e = 0; e < 8; ++e) if (e != e0 && lg[e] > v1) { v1 = lg[e]; e1 = e; }
                const float p0 = 1.0f / (1.0f + __expf(v1 - v0)), p1 = 1.0f - p0;
                if (c.lane == 0) { TOPK[m * 4] = e0; TOPK[m * 4 + 1] = e1; TOPK[m * 4 + 2] = __float_as_int(p0); TOPK[m * 4 + 3] = __float_as_int(p1); atomicAdd((int*)&lcnt[e0], 1); atomicAdd((int*)&lcnt[e1], 1); }
            }
            __syncthreads();
            if (c.tid < 8) CNT[blk * 8 + c.tid] = lcnt[c.tid];
            __syncthreads();
        }
    }
    SEAM(16);
    if (IN(17)) {
        LAS int* C8 = (LAS int*)c.lds;
        LAS int* tot = C8 + 2048; LAS int* pre = tot + 8; LAS int* segst = pre + 8; LAS int* ntl = segst + 8; LAS int* basee = ntl + 8; LAS int* lpos = basee + 8;
        for (int blk = c.bid; blk < 256; blk += c.G) {
            for (int i = c.tid; i < 2048; i += 512) C8[i] = CNT[i];
            __syncthreads();
            if (c.tid < 8) { int t = 0, p = 0; for (int b = 0; b < 256; ++b) { const int v = C8[b * 8 + c.tid]; t += v; if (b < blk) p += v; } tot[c.tid] = t; pre[c.tid] = p; }
            __syncthreads();
            if (c.tid == 0) {
                int seg = 0;
                for (int e = 0; e < 8; ++e) { segst[e] = seg; ntl[e] = (tot[e] + 255) >> 8; seg += ntl[e] * 256; basee[e] = seg - ntl[e] * 256 + pre[e]; }
                for (int i = 0; i < 32; ++i) { const int m = blk * 32 + i; const int e0 = TOPK[m * 4], e1 = TOPK[m * 4 + 1];
                    const int p0 = basee[e0]; basee[e0] = p0 + 1; const int p1 = basee[e1]; basee[e1] = p1 + 1;
                    POS[m * 2] = p0; POS[m * 2 + 1] = p1; lpos[2 * i] = p0; lpos[2 * i + 1] = p1; }
                if (blk == 0) { int t = 0; for (int e = 0; e < 8; ++e) for (int k = 0; k < ntl[e]; ++k) TILES[1 + t++] = e; TILES[0] = t; }
            }
            __syncthreads();
            for (int pr = c.wave; pr < 64; pr += 8) {
                const int m = blk * 32 + (pr >> 1); const int pos = lpos[pr];
                const v4u* src = (const v4u*)(XN + (size_t)m * DM); v4u* dst = (v4u*)(HS + (size_t)pos * DM);
#pragma unroll
                for (int j = 0; j < 4; ++j) dst[c.lane + 64 * j] = src[c.lane + 64 * j];
            }
            for (int e = 0; e < 8; ++e) {
                const int npad = ntl[e] * 256 - tot[e], r0 = segst[e] + tot[e];
                for (int p = blk; p < npad; p += 256) { v2u* dst = (v2u*)(HS + (size_t)(r0 + p) * DM); dst[c.tid] = (v2u){0u, 0u}; }
            }
            __syncthreads();
        }
    }
    SEAM(17);
    if (IN(18)) {
        const int NT = __builtin_amdgcn_readfirstlane(TILES[0]);
        pg8::Gemm g{HS, W_MGU, 0, 0, DM}; pg8::GroupedOrder S{TILES + 1, NT, 22, c.G, c.bid};
        pg8::EpiSwiGLU E{ACTS, FE};
        pg8::gemm_phase<pg8::EpiSwiGLU, pg8::GroupedOrder, true, true>(c.lds, g, S, E);
    }
    SEAM(18);
    if (IN(19)) {
        const int NT = __builtin_amdgcn_readfirstlane(TILES[0]);
        pg8::Gemm g{ACTS, W_MD, 0, 0, FE}; pg8::GroupedOrder S{TILES + 1, NT, 8, c.G, c.bid};
        pg8::EpiResF32 E{nullptr, OUTS, DM};
        pg8::gemm_phase<pg8::EpiResF32, pg8::GroupedOrder, true, true>(c.lds, g, S, E);
    }
    SEAM(19);
    if (IN(20)) {
        const int gw = c.bid * 8 + c.wave, NGW = c.G * 8;
        for (int m = gw; m < M_TOK; m += NGW) {
            const float p0 = __int_as_float(TOPK[m * 4 + 2]), p1 = __int_as_float(TOPK[m * 4 + 3]); const int q0 = POS[m * 2], q1 = POS[m * 2 + 1];
            const float* xr = X1 + (size_t)m * DM; const float* o0 = OUTS + (size_t)q0 * DM; const float* o1 = OUTS + (size_t)q1 * DM;
            f32x4 v[8]; float ss = 0.f;
#pragma unroll
            for (int j = 0; j < 8; ++j) { const int o = 4 * c.lane + 256 * j; v[j] = *(const f32x4*)(xr + o) + p0 * *(const f32x4*)(o0 + o) + p1 * *(const f32x4*)(o1 + o);
                ss += (v[j].x * v[j].x + v[j].y * v[j].y) + (v[j].z * v[j].z + v[j].w * v[j].w); }
            const float rs = 1.0f / sqrtf(wave_sum(ss) * (1.0f / 2048.0f) + 1e-6f);
#pragma unroll
            for (int j = 0; j < 8; ++j) { const int o = 4 * c.lane + 256 * j; *(f32x4*)(OUT + (size_t)m * DM + o) = v[j] * rs * *(const f32x4*)(final_norm_w + o); }
        }
    }
#undef IN
#undef SEAM
}

extern "C" void kernel_launch(void* const* d_in, const int* in_sizes, int n_in, void* d_out, int out_size, void* d_ws, size_t ws_size, hipStream_t stream) {
    static int grid = 0;
    if (grid == 0) {
        if (n_in != 41 || out_size != M_TOK * DM || ws_size < WS_END) { fprintf(stderr, "kernel_launch: unexpected problem (n_in %d, out %d, ws %zu < %zu)\n", n_in, out_size, ws_size, (size_t)WS_END); grid = -1; return; }
        int dev = 0, cus = 0, per_cu = 0;
        if (hipGetDevice(&dev) != hipSuccess || hipDeviceGetAttribute(&cus, hipDeviceAttributeMultiprocessorCount, dev) != hipSuccess) { grid = -1; return; }
        if (hipFuncSetAttribute((const void*)fwd, hipFuncAttributeMaxDynamicSharedMemorySize, LDS_BYTES) != hipSuccess) { fprintf(stderr, "kernel_launch: hipFuncSetAttribute failed\n"); grid = -1; return; }
        if (hipOccupancyMaxActiveBlocksPerMultiprocessor(&per_cu, (const void*)fwd, 512, LDS_BYTES) != hipSuccess || per_cu < 1) fprintf(stderr, "kernel_launch: occupancy query says %d\n", per_cu);
        (void)hipGetLastError();
        grid = cus;
    }
    if (grid < 0) return;
    (void)hipMemsetAsync((char*)d_ws + WS_CTL, 0, CTL_ZERO_BYTES, stream);
    Args a{};
    for (int i = 0; i < 41; ++i) a.in[i] = (const float*)d_in[i];
    a.out = (float*)d_out; a.ws = (unsigned char*)d_ws;
    if (MK_N_LAUNCHES == 1) { a.lo = 0; a.hi = NPHASE; hipLaunchKernelGGL(fwd, dim3(grid), dim3(512), LDS_BYTES, stream, a); }
    else { for (int p = 0; p < NPHASE; ++p) { a.lo = p; a.hi = p + 1; hipLaunchKernelGGL(fwd, dim3(grid), dim3(512), LDS_BYTES, stream, a); } }
}
```

```cpp
#include <hip/hip_runtime.h>
#include <cstdio>
#include <cstdint>

#ifndef MK_N_LAUNCHES
#define MK_N_LAUNCHES 1
#endif

#define GAS __attribute__((address_space(1)))
#define LAS __attribute__((address_space(3)))
typedef unsigned short bf16;
typedef unsigned v4u __attribute__((ext_vector_type(4)));
typedef unsigned v2u __attribute__((ext_vector_type(2)));
typedef float f32x4 __attribute__((ext_vector_type(4)));
typedef float f32x2 __attribute__((ext_vector_type(2)));
typedef short bf16x8 __attribute__((ext_vector_type(8)));

constexpr int M_TOK = 8192, SEQ = 2048, DM = 2048;
constexpr int EVP = 6656, ODP = 7424;
constexpr int FF = 5632, FE = 2816, NEXP = 8;
constexpr int NPHASE = 21;

constexpr size_t MiB = 1u << 20;
constexpr size_t WS_CTL = 0, CTL_ZERO_BYTES = 1 * MiB;
constexpr size_t WS_WLORA = 1 * MiB, WS_WEVIN = 4 * MiB, WS_WEVOUT = 30 * MiB, WS_WFGU = 38 * MiB, WS_WFD = 82 * MiB;
constexpr size_t WS_WODIN = 104 * MiB, WS_WODOUT = 133 * MiB, WS_WMGU = 141 * MiB, WS_WMD = 317 * MiB;
constexpr size_t WS_XN = 405 * MiB, WS_Y = 437 * MiB, WS_X1 = 469 * MiB, WS_SCR = 533 * MiB;
constexpr size_t SC_U = WS_SCR, SC_LW = WS_SCR + 104 * MiB, SC_LA = WS_SCR + 136 * MiB, SC_LG = WS_SCR + 168 * MiB, SC_ALORA = WS_SCR + 200 * MiB;
constexpr size_t SC_YRAW_E = WS_SCR + 208 * MiB, SC_MLQK = WS_SCR + 240 * MiB, SC_HRAW = WS_SCR + 272 * MiB;
constexpr size_t SC_ACT = WS_SCR;
constexpr size_t SC_XBC = WS_SCR + 116 * MiB, SC_ORAW = WS_SCR + 180 * MiB, SC_YRAW_O = WS_SCR + 212 * MiB;
constexpr int MOE_MAXROWS = 18432;
constexpr size_t SC_HS = WS_SCR, SC_ACTS = WS_SCR + 72 * MiB, SC_OUTS = WS_SCR + 171 * MiB;
constexpr size_t SC_TOPK = WS_SCR + 316 * MiB, SC_POS = SC_TOPK + 131072, SC_CNT = SC_POS + 65536, SC_TILES = SC_CNT + 8192;
constexpr size_t WS_END = WS_SCR + 317 * MiB;
static_assert(SC_OUTS + (size_t)MOE_MAXROWS * DM * 4 <= SC_TOPK, "moe map");
static_assert(WS_END <= 907708384ull, "d_ws map exceeds the guaranteed workspace");
constexpr int CW_BAR = 4096;

constexpr int RING_BYTES = 131072, MISC_OFF = RING_BYTES + 320, LDS_BYTES = 147456;

__device__ __forceinline__ float bf2f(bf16 b) { return __uint_as_float(((unsigned)b) << 16); }
__device__ __forceinline__ unsigned f2bf(float f) { unsigned u = __float_as_uint(f); return (u + 0x7fffu + ((u >> 16) & 1u)) >> 16; }
__device__ __forceinline__ unsigned cvt_pk_bf16(float lo, float hi) { unsigned r; asm volatile("v_cvt_pk_bf16_f32 %0, %1, %2" : "=v"(r) : "v"(lo), "v"(hi)); return r; }
__device__ __forceinline__ float sigmoidf_(float x) { return 1.0f / (1.0f + __expf(-x)); }
__device__ __forceinline__ float siluf_(float x) { return x / (1.0f + __expf(-x)); }
__device__ __forceinline__ float wave_sum(float v) {
#pragma unroll
    for (int o = 1; o < 64; o <<= 1) v += __shfl_xor(v, o);
    return v;
}
template <int CTRL> __device__ __forceinline__ float dppf(float v) { return __builtin_bit_cast(float, __builtin_amdgcn_mov_dpp(__builtin_bit_cast(int, v), CTRL, 0xf, 0xf, false)); }
__device__ __forceinline__ float allred16(float v) { v += dppf<0x128>(v); v += dppf<0x124>(v); v += dppf<0x122>(v); v += dppf<0x121>(v); return v; }

namespace pg8 {
#define PG8_LAS __attribute__((address_space(3)))
typedef unsigned short bf16_t;
typedef unsigned u32x4 __attribute__((ext_vector_type(4)));
constexpr int BM = 256, BK = 64, HALF = 128, HTB = HALF * BK * 2, STAGE_BYTES = 8 * HTB, NXCD = 8, WGM = 8;
__host__ __device__ __forceinline__ int lds_byte(int r, int c) { const int st = (r >> 4) * 2 + (c >> 5), rr = r & 15, cc = c & 31, ob = rr * 64 + cc * 2; return st * 1024 + (ob ^ (((ob >> 9) & 1) << 5)); }
__host__ __device__ __forceinline__ void stage_rc(int b, int& R, int& C) { const int st = b / 1024, sb = b % 1024, swz = sb ^ (((sb >> 9) & 1) << 5); R = (st >> 1) * 16 + swz / 64; C = (st & 1) * 32 + (swz % 64) / 2; }
__host__ __device__ __forceinline__ int perm32(int rho) { const int n = rho >> 4, i = rho & 15; return 8 * (i >> 2) + 4 * n + (i & 3); }

struct Unit { int pm, pn, pc; };
struct Gemm { const bf16_t* A; const bf16_t* Bt; int M, N, K; };

struct StaticOrder {
    int nM, nN, nwg, G, c;
    __device__ void init(int M, int N, int G_, int c_) { nM = M / BM; nN = N / BM; nwg = nM * nN; G = G_; c = c_; }
    __device__ bool next(int i, Unit& u) const {
        const long L = (long)i * G + c; if (L >= nwg) return false;
        int wgid = (int)L; { const int q = nwg / NXCD, r = nwg % NXCD, xcd = wgid % NXCD, off = wgid / NXCD; wgid = (xcd < r ? xcd * (q + 1) : r * (q + 1) + (xcd - r) * q) + off; }
        const int nig = WGM * nN, gid = wgid / nig, fm = gid * WGM, gsz = (nM - fm) < WGM ? (nM - fm) : WGM;
        u.pm = fm + ((wgid % nig) % gsz); u.pn = (wgid % nig) / gsz; u.pc = u.pn; return true;
    }
    __device__ __forceinline__ void a_ready(const Unit&) const {}
    __device__ __forceinline__ void done(const Unit&) const {}
};
struct GroupedOrder {
    const int* tile_e; int NT, npn, G, c;
    __device__ bool next(int i, Unit& u) const {
        const long L = (long)i * G + c; if (L >= (long)NT * npn) return false;
        const int t = (int)(L % NT), pnl = (int)(L / NT);
        const int e = __builtin_amdgcn_readfirstlane(tile_e[t]);
        u.pm = t; u.pn = e * npn + pnl; u.pc = pnl; return true;
    }
    __device__ __forceinline__ void a_ready(const Unit&) const {}
    __device__ __forceinline__ void done(const Unit&) const {}
};

struct EpiBf16 {
    static constexpr bool PERM = true;
    bf16_t* O; int ldc;
    __device__ __forceinline__ void operator()(const f32x4 (&acc)[2][2][4][2], const Unit& u, int wr, int wc, int fr, int fq) const {
        const int row0 = u.pm * BM + wr * 64 + fr, col0 = u.pc * BM + wc * 32 + 8 * fq;
#pragma unroll
        for (int ai = 0; ai < 2; ++ai)
#pragma unroll
            for (int m = 0; m < 4; ++m) { bf16_t* rowp = O + (size_t)(row0 + ai * HALF + m * 16) * ldc + col0;
#pragma unroll
                for (int bj = 0; bj < 2; ++bj) { const f32x4 v0 = acc[ai][bj][m][0], v1 = acc[ai][bj][m][1];
                    u32x4 w; w.x = cvt_pk_bf16(v0[0], v0[1]); w.y = cvt_pk_bf16(v0[2], v0[3]); w.z = cvt_pk_bf16(v1[0], v1[1]); w.w = cvt_pk_bf16(v1[2], v1[3]);
                    *(u32x4*)(rowp + bj * HALF) = w; } }
    }
};
struct EpiSwiGLU {
    static constexpr bool PERM = true;
    bf16_t* O; int ldc;
    __device__ __forceinline__ void operator()(const f32x4 (&acc)[2][2][4][2], const Unit& u, int wr, int wc, int fr, int fq) const {
        const int row0 = u.pm * BM + wr * 64 + fr, col0 = u.pc * HALF + wc * 32 + 8 * fq;
#pragma unroll
        for (int ai = 0; ai < 2; ++ai)
#pragma unroll
            for (int m = 0; m < 4; ++m) { bf16_t* rowp = O + (size_t)(row0 + ai * HALF + m * 16) * ldc + col0;
                float r[8];
#pragma unroll
                for (int n = 0; n < 2; ++n)
#pragma unroll
                    for (int j = 0; j < 4; ++j) { const float g = acc[ai][0][m][n][j], up = acc[ai][1][m][n][j]; r[n * 4 + j] = g * __builtin_amdgcn_rcpf(1.0f + __expf(-g)) * up; }
                u32x4 w; w.x = cvt_pk_bf16(r[0], r[1]); w.y = cvt_pk_bf16(r[2], r[3]); w.z = cvt_pk_bf16(r[4], r[5]); w.w = cvt_pk_bf16(r[6], r[7]);
                *(u32x4*)rowp = w; }
    }
};
struct EpiResF32 {
    static constexpr bool PERM = false;
    const float* res; float* out; int ldc;
    __device__ __forceinline__ void operator()(const f32x4 (&acc)[2][2][4][2], const Unit& u, int wr, int wc, int fr, int fq) const {
        const int row0 = u.pm * BM + wr * 64 + fr, col0 = u.pc * BM + wc * 32 + 4 * fq;
#pragma unroll
        for (int ai = 0; ai < 2; ++ai)
#pragma unroll
            for (int m = 0; m < 4; ++m) { const size_t off = (size_t)(row0 + ai * HALF + m * 16) * ldc + col0;
#pragma unroll
                for (int bj = 0; bj < 2; ++bj)
#pragma unroll
                    for (int n = 0; n < 2; ++n) { f32x4 v = acc[ai][bj][m][n]; if (res) v = v + *(const f32x4*)(res + off + bj * HALF + n * 16); *(f32x4*)(out + off + bj * HALF + n * 16) = v; } }
    }
};
struct EpiLora {
    static constexpr bool PERM = false;
    float* LWAG; const float* w0; const float* a0;
    __device__ __forceinline__ void operator()(const f32x4 (&acc)[2][2][4][2], const Unit& u, int wr, int wc, int fr, int fq) const {
        const int kind = u.pc >> 2; const int row0 = u.pm * BM + wr * 64 + fr, col0 = (u.pc & 3) * BM + wc * 32 + 4 * fq;
        float* dst = LWAG + (size_t)kind * ((size_t)8192 * 1024); const float* bias = kind == 0 ? w0 : a0;
#pragma unroll
        for (int bj = 0; bj < 2; ++bj)
#pragma unroll
            for (int n = 0; n < 2; ++n) { const int c = col0 + bj * HALF + n * 16; f32x4 bv = (f32x4){0.f, 0.f, 0.f, 0.f}; if (kind < 2) bv = *(const f32x4*)(bias + c);
#pragma unroll
                for (int ai = 0; ai < 2; ++ai)
#pragma unroll
                    for (int m = 0; m < 4; ++m) { f32x4 v = acc[ai][bj][m][n] + bv;
                        if (kind < 2) {
#pragma unroll
                            for (int j = 0; j < 4; ++j) { const float s = 1.0f / (1.0f + __expf(-v[j])); v[j] = kind == 0 ? __expf(-0.6065306597126334f * s) : s; } }
                        *(f32x4*)(dst + (size_t)(row0 + ai * HALF + m * 16) * 1024 + c) = v; } }
    }
};

template <class Epi, class Sched, bool ALIGN_EPI, bool SP2>
__device__ __forceinline__ void gemm_phase(PG8_LAS unsigned char* lds, const Gemm g, const Sched& S, const Epi& E) {
    const int tid = threadIdx.x, wid = __builtin_amdgcn_readfirstlane(tid >> 6), lane = tid & 63, wr = wid >> 2, wc = wid & 3, fr = lane & 15, fq = lane >> 4;
    const int K = g.K, nt = K / BK;
    unsigned voffA[2], voffB[2];
#pragma unroll
    for (int i = 0; i < 2; ++i) { int R, C; stage_rc(tid * 16 + i * 8192, R, C); const int Rb = Epi::PERM ? ((R & ~31) + perm32(R & 31)) : R;
        voffA[i] = (unsigned)(R * K + C) * 2u; voffB[i] = (unsigned)(Rb * K + C) * 2u; }
    const size_t kstep = (size_t)(BK * 2);
    const size_t hstep = (size_t)HALF * K * 2;
    const size_t tstep = 2 * hstep;
    const unsigned ldsw = (unsigned)wid * 1024u;
    const int aoff = lds_byte(wr * 64 + fr, fq * 8), boff = lds_byte(wc * 32 + fr, fq * 8);
#define PG8_SA(b, h) (((b) * 2 + (h)) * HTB)
#define PG8_SB(b, h) ((4 + (b) * 2 + (h)) * HTB)
#define PG8_STAGE(bufoff, gbase, voff) do { _Pragma("unroll") for (int _i = 0; _i < 2; ++_i) \
        __builtin_amdgcn_global_load_lds((const unsigned*)((const char*)(gbase) + (voff)[_i]), (PG8_LAS unsigned*)(lds + (bufoff) + ldsw + _i * 8192), 16, 0, 0); } while (0)
#define PG8_LDA(dst, b, h) do { _Pragma("unroll") for (int m = 0; m < 4; ++m) _Pragma("unroll") for (int k = 0; k < 2; ++k) dst[m][k] = *(const PG8_LAS bf16x8*)(lds + PG8_SA(b, h) + aoff + m * 2048 + k * 1024); } while (0)
#define PG8_LDB(dst, b, h) do { _Pragma("unroll") for (int n = 0; n < 2; ++n) _Pragma("unroll") for (int k = 0; k < 2; ++k) dst[n][k] = *(const PG8_LAS bf16x8*)(lds + PG8_SB(b, h) + boff + n * 2048 + k * 1024); } while (0)
#define PG8_MMA(ai, bj, At, Bt) do { __builtin_amdgcn_s_setprio(1); _Pragma("unroll") for (int m = 0; m < 4; ++m) _Pragma("unroll") for (int n = 0; n < 2; ++n) _Pragma("unroll") for (int k = 0; k < 2; ++k) \
        acc[ai][bj][m][n] = __builtin_amdgcn_mfma_f32_16x16x32_bf16(Bt[n][k], At[m][k], acc[ai][bj][m][n], 0, 0, 0); __builtin_amdgcn_s_setprio(0); } while (0)
#define PG8_WAIT_V(n) asm volatile("s_waitcnt vmcnt(" #n ")" ::: "memory")
#define PG8_WAIT_L(n) asm volatile("s_waitcnt lgkmcnt(" #n ")" ::: "memory")
#define PG8_BAR __builtin_amdgcn_s_barrier()
#define PG8_SCHED __builtin_amdgcn_sched_barrier(0)
    Unit cur, nxt; int ui = 0;
    if (!S.next(0, cur)) return;
    f32x4 acc[2][2][4][2];
#pragma unroll
    for (int a = 0; a < 2; ++a)
#pragma unroll
        for (int b = 0; b < 2; ++b)
#pragma unroll
            for (int m = 0; m < 4; ++m)
#pragma unroll
                for (int n = 0; n < 2; ++n) acc[a][b][m][n] = (f32x4){0.f, 0.f, 0.f, 0.f};
    bf16x8 At[4][2], B0[2][2], B1[2][2];
    const char* cA = (const char*)g.A + (size_t)cur.pm * tstep; const char* cB = (const char*)g.Bt + (size_t)cur.pn * tstep;
    S.a_ready(cur);
    if constexpr (SP2) {
        PG8_STAGE(PG8_SB(0, 0), cB, voffB); PG8_STAGE(PG8_SB(0, 1), cB + hstep, voffB); PG8_STAGE(PG8_SA(0, 0), cA, voffA); PG8_STAGE(PG8_SA(0, 1), cA + hstep, voffA);
        if (wr == 1) PG8_BAR;
        PG8_WAIT_V(2); PG8_BAR;
        PG8_STAGE(PG8_SB(1, 0), cB + kstep, voffB); PG8_STAGE(PG8_SA(1, 0), cA + kstep, voffA); PG8_STAGE(PG8_SB(1, 1), cB + hstep + kstep, voffB);
        PG8_WAIT_V(6); PG8_BAR;
    } else {
        PG8_STAGE(PG8_SB(0, 0), cB, voffB); PG8_STAGE(PG8_SA(0, 0), cA, voffA); PG8_STAGE(PG8_SB(0, 1), cB + hstep, voffB); PG8_STAGE(PG8_SA(0, 1), cA + hstep, voffA);
        if (wr == 1) PG8_BAR;
        PG8_WAIT_V(4); PG8_BAR;
        PG8_STAGE(PG8_SB(1, 0), cB + kstep, voffB); PG8_STAGE(PG8_SA(1, 0), cA + kstep, voffA); PG8_STAGE(PG8_SB(1, 1), cB + hstep + kstep, voffB);
        PG8_WAIT_V(6); PG8_BAR;
    }
    for (;;) {
        const bool has_next = S.next(ui + 1, nxt);
        const char* nA = has_next ? (const char*)g.A + (size_t)nxt.pm * tstep : cA; const char* nB = has_next ? (const char*)g.Bt + (size_t)nxt.pn * tstep : cB;
        for (int t = 0; t < nt; t += 2) {
            const bool last = (t == nt - 2);
            const char* a1 = cA + (size_t)(t + 1) * kstep;
            const char* a2 = last ? nA : cA + (size_t)(t + 2) * kstep; const char* b2 = last ? nB : cB + (size_t)(t + 2) * kstep;
            const char* a3 = a2 + kstep; const char* b3 = b2 + kstep;
            if (last && has_next) S.a_ready(nxt);
            if constexpr (SP2) {
            PG8_LDB(B0, 0, 0); PG8_LDB(B1, 0, 1); PG8_SCHED; PG8_LDA(At, 0, 0); PG8_STAGE(PG8_SA(1, 1), a1 + hstep, voffA);
            PG8_WAIT_V(8); PG8_WAIT_L(0); PG8_BAR; PG8_MMA(0, 0, At, B0); PG8_MMA(0, 1, At, B1); PG8_BAR; PG8_SCHED;
            PG8_LDA(At, 0, 1); PG8_STAGE(PG8_SB(0, 0), b2, voffB); PG8_STAGE(PG8_SB(0, 1), b2 + hstep, voffB); PG8_STAGE(PG8_SA(0, 0), a2, voffA);
            PG8_WAIT_V(8); PG8_WAIT_L(0); PG8_BAR; PG8_MMA(1, 0, At, B0); PG8_MMA(1, 1, At, B1); PG8_BAR; PG8_SCHED;
            PG8_LDB(B0, 1, 0); PG8_LDB(B1, 1, 1); PG8_SCHED; PG8_LDA(At, 1, 0); PG8_STAGE(PG8_SA(0, 1), a2 + hstep, voffA);
            PG8_WAIT_V(8); PG8_WAIT_L(0); PG8_BAR; PG8_MMA(0, 0, At, B0); PG8_MMA(0, 1, At, B1); PG8_BAR; PG8_SCHED;
            PG8_LDA(At, 1, 1); PG8_STAGE(PG8_SB(1, 0), b3, voffB); PG8_STAGE(PG8_SB(1, 1), b3 + hstep, voffB); PG8_STAGE(PG8_SA(1, 0), a3, voffA);
            PG8_WAIT_V(8); PG8_WAIT_L(0); PG8_BAR; PG8_MMA(1, 0, At, B0); PG8_MMA(1, 1, At, B1); PG8_BAR; PG8_SCHED;
            } else {
            PG8_LDB(B0, 0, 0); PG8_SCHED; PG8_LDA(At, 0, 0); PG8_STAGE(PG8_SA(1, 1), a1 + hstep, voffA);
            PG8_WAIT_L(8); PG8_BAR; PG8_WAIT_L(0); PG8_MMA(0, 0, At, B0); PG8_BAR; PG8_SCHED;
            PG8_LDB(B1, 0, 1); PG8_STAGE(PG8_SB(0, 0), b2, voffB);
            PG8_BAR; PG8_WAIT_L(0); PG8_MMA(0, 1, At, B1); PG8_BAR;
            PG8_LDA(At, 0, 1); PG8_STAGE(PG8_SA(0, 0), a2, voffA);
            PG8_BAR; PG8_WAIT_L(0); PG8_MMA(1, 0, At, B0); PG8_BAR; PG8_SCHED;
            PG8_STAGE(PG8_SB(0, 1), b2 + hstep, voffB);
            PG8_WAIT_V(6); PG8_BAR; PG8_MMA(1, 1, At, B1); PG8_BAR;
            PG8_LDB(B0, 1, 0); PG8_SCHED; PG8_LDA(At, 1, 0); PG8_STAGE(PG8_SA(0, 1), a2 + hstep, voffA);
            PG8_WAIT_L(8); PG8_BAR; PG8_WAIT_L(0); PG8_MMA(0, 0, At, B0); PG8_BAR; PG8_SCHED;
            PG8_LDB(B1, 1, 1); PG8_STAGE(PG8_SB(1, 0), b3, voffB);
            PG8_BAR; PG8_WAIT_L(0); PG8_MMA(0, 1, At, B1); PG8_BAR;
            PG8_LDA(At, 1, 1); PG8_STAGE(PG8_SA(1, 0), a3, voffA);
            PG8_BAR; PG8_WAIT_L(0); PG8_MMA(1, 0, At, B0); PG8_BAR; PG8_SCHED;
            PG8_STAGE(PG8_SB(1, 1), b3 + hstep, voffB);
            PG8_WAIT_V(6); PG8_BAR; PG8_MMA(1, 1, At, B1); PG8_BAR;
            }
        }
        if constexpr (ALIGN_EPI) { if (wr == 0) PG8_BAR; }
        E(acc, cur, wr, wc, fr, fq); S.done(cur);
        if (!has_next) break;
#pragma unroll
        for (int a = 0; a < 2; ++a)
#pragma unroll
            for (int b = 0; b < 2; ++b)
#pragma unroll
                for (int m = 0; m < 4; ++m)
#pragma unroll
                    for (int n = 0; n < 2; ++n) acc[a][b][m][n] = (f32x4){0.f, 0.f, 0.f, 0.f};
        cur = nxt; cA = nA; cB = nB; ++ui;
        if constexpr (ALIGN_EPI) { if (wr == 1) PG8_BAR; }
    }
    PG8_WAIT_V(0);
    if constexpr (!ALIGN_EPI) { if (wr == 0) PG8_BAR; }
    PG8_BAR;
#undef PG8_SA
#undef PG8_SB
#undef PG8_STAGE
#undef PG8_LDA
#undef PG8_LDB
#undef PG8_MMA
#undef PG8_WAIT_V
#undef PG8_WAIT_L
#undef PG8_BAR
#undef PG8_SCHED
}
}

#define XB_TMO      128
#define XB_XCNT(j)  (256  + 64 * (j))
#define XB_XSUB(j)  (1280 + 64 * (j))
#define XB_XGEN(j)  (2304 + 64 * (j))
#define XB_TOP      3328
#define XB_TOPGEN   3392
#define XCD_BAR_WORDS 3456
#define XB_SPIN_CAP (1u << 18)
__device__ __forceinline__ unsigned xb_ld(unsigned* p)              { return __hip_atomic_load(p, __ATOMIC_RELAXED, __HIP_MEMORY_SCOPE_AGENT); }
__device__ __forceinline__ unsigned xb_add(unsigned* p, unsigned v) { return __hip_atomic_fetch_add(p, v, __ATOMIC_RELAXED, __HIP_MEMORY_SCOPE_AGENT); }
__device__ __forceinline__ unsigned xb_xcc_id() { return (unsigned)__builtin_amdgcn_s_getreg((3 << 11) | 20) & 0xFu; }
#define XB_SPIN(cond, bar) do { unsigned _sp = 0; while (cond) { __builtin_amdgcn_s_sleep(1); \
    if ((++_sp & 255u) == 0u) { if (xb_ld(&(bar)[XB_TMO])) break; if (_sp > XB_SPIN_CAP) { atomicAdd(&(bar)[XB_TMO], 1u); break; } } } } while (0)
struct XcdBarrier { unsigned* bar; unsigned x; volatile LAS unsigned* st; };
__device__ __forceinline__ XcdBarrier xcd_barrier_post(unsigned* bar, volatile LAS unsigned* st) {
    XcdBarrier b; b.bar = bar; b.x = xb_xcc_id(); b.st = st;
    if (threadIdx.x == 0) (void)xb_add(&bar[XB_XCNT(b.x)], 1u);
    return b;
}
__device__ __forceinline__ void xcd_barrier_complete(unsigned* bar, unsigned x, unsigned& nloc, unsigned& nx) {
    const unsigned G = gridDim.x * gridDim.y * gridDim.z;
    unsigned sum, cnt, mine, sp = 0u;
    for (;;) {
        sum = 0u; cnt = 0u; mine = 0u;
#pragma unroll
        for (unsigned j = 0; j < 16; ++j) { const unsigned c = xb_ld(&bar[XB_XCNT(j)]); sum += c; cnt += (c > 0u) ? 1u : 0u; mine = (j == x) ? c : mine; }
        if (sum == G) break;
        __builtin_amdgcn_s_sleep(1);
        if ((++sp & 255u) == 0u) { if (xb_ld(&bar[XB_TMO])) break; if (sp > XB_SPIN_CAP) { atomicAdd(&bar[XB_TMO], 1u); break; } }
    }
    nloc = mine > 0u ? mine : 1u; nx = cnt > 0u ? cnt : 1u;
}
__device__ __forceinline__ void xcd_barrier(const XcdBarrier& b) {
    asm volatile("s_waitcnt vmcnt(0)" ::: "memory");
    __syncthreads();
    if (threadIdx.x == 0) {
        unsigned* bar = b.bar;
        __builtin_amdgcn_s_waitcnt(0);
        unsigned nloc = b.st[0], nx = b.st[1];
        if (nloc == 0u) { xcd_barrier_complete(bar, b.x, nloc, nx); b.st[0] = nloc; b.st[1] = nx; }
        const unsigned old = xb_add(&bar[XB_XSUB(b.x)], 1u);
        const unsigned gen = old / nloc;
        if (old + 1u == (gen + 1u) * nloc) {
            __builtin_amdgcn_fence(__ATOMIC_RELEASE, "agent");
            asm volatile("s_waitcnt vmcnt(0)" ::: "memory");
            const unsigned og = xb_add(&bar[XB_TOP], 1u);
            const unsigned tg = og / nx;
            if (og + 1u == (tg + 1u) * nx) xb_add(&bar[XB_TOPGEN], 1u);
            else XB_SPIN(xb_ld(&bar[XB_TOPGEN]) == tg, bar);
            __builtin_amdgcn_fence(__ATOMIC_ACQUIRE, "agent");
            xb_add(&bar[XB_XGEN(b.x)], 1u);
            asm volatile("s_waitcnt vmcnt(0)" ::: "memory");
        } else {
            XB_SPIN(xb_ld(&bar[XB_XGEN(b.x)]) == gen, bar);
            __builtin_amdgcn_fence(__ATOMIC_ACQUIRE, "agent");
            asm volatile("s_waitcnt vmcnt(0)" ::: "memory");
        }
    }
    __syncthreads();
}

struct Ctx { LAS unsigned char* lds; int tid, lane, wave, bid, G; };

__device__ __forceinline__ void conv_tile(const float* W, int K, int N, bf16* WT, int mode, int kt, int ntile, LAS float* scr, int tid) {
    const int k0 = kt * 64, n0 = ntile * 64;
    { const int n = tid & 63, kq = tid >> 6;
#pragma unroll
      for (int i = 0; i < 8; ++i) { const int kk = kq + 8 * i; scr[kk * 65 + n] = (n0 + n < N) ? W[(size_t)(k0 + kk) * N + n0 + n] : 0.f; } }
    __syncthreads();
    { const int nn = tid >> 3, kc = tid & 7; float v[8];
#pragma unroll
      for (int j = 0; j < 8; ++j) v[j] = scr[(kc * 8 + j) * 65 + nn];
      const int ns = n0 + nn; const int drow = mode == 0 ? ns : ((ns >> 7) * 256 + (ns & 127) + (mode == 2 ? 128 : 0));
      v4u o; o.x = cvt_pk_bf16(v[0], v[1]); o.y = cvt_pk_bf16(v[2], v[3]); o.z = cvt_pk_bf16(v[4], v[5]); o.w = cvt_pk_bf16(v[6], v[7]);
      *(v4u*)(WT + (size_t)drow * K + k0 + kc * 8) = o; }
    __syncthreads();
}
__device__ __forceinline__ void conv_kind(const Ctx& c, const float* W, int K, int N, int Npad, bf16* WT, int mode, int nmat, size_t sstr, size_t dstr, int& base) {
    const int nkt = K / 64, nnt = Npad / 64, per = nkt * nnt, count = per * nmat;
    LAS float* scr = (LAS float*)c.lds;
    int first = (c.bid - base % c.G + c.G) % c.G;
    for (int it = first; it < count; it += c.G) {
        const int mat = it / per, r = it % per, kt = r / nnt, ntile = r % nnt;
        conv_tile(W + (size_t)mat * sstr, K, N, WT + (size_t)mat * dstr, mode, kt, ntile, scr, c.tid);
    }
    base += count;
}
__device__ __forceinline__ void rmsnorm_row_bf16(const float* xr, const float* w, bf16* orow, int lane) {
    f32x4 v[8]; float ss = 0.f;
#pragma unroll
    for (int j = 0; j < 8; ++j) { v[j] = *(const f32x4*)(xr + 4 * lane + 256 * j); ss += (v[j].x * v[j].x + v[j].y * v[j].y) + (v[j].z * v[j].z + v[j].w * v[j].w); }
    const float rs = 1.0f / sqrtf(wave_sum(ss) * (1.0f / 2048.0f) + 1e-6f);
#pragma unroll
    for (int j = 0; j < 8; ++j) { const f32x4 wv = *(const f32x4*)(w + 4 * lane + 256 * j); const f32x4 o = v[j] * rs * wv;
        v2u p; p.x = cvt_pk_bf16(o.x, o.y); p.y = cvt_pk_bf16(o.z, o.w); *(v2u*)(orow + 4 * lane + 256 * j) = p; }
}
__device__ __forceinline__ void rmsnorm_phase(const Ctx& c, const float* X, const float* w, bf16* XN) {
    const int gw = c.bid * 8 + c.wave, NGW = c.G * 8;
    for (int m = gw; m < M_TOK; m += NGW) rmsnorm_row_bf16(X + (size_t)m * DM, w, XN + (size_t)m * DM, c.lane);
}

constexpr int TS = 64;
__device__ __forceinline__ void scan_writeout(const LAS float* OUT, float* dst, int ldd, int tid) {
    const int tt = tid >> 3, i4 = (tid & 7) * 4;
    *(f32x4*)(dst + (size_t)tt * ldd + i4) = *(const LAS f32x4*)(OUT + tt * 32 + i4);
}

__device__ __forceinline__ void scan_rwkv(const Ctx& c, int task, const bf16* U, const float* LW, const float* LA, const float* mu, const float* k_k, const float* k_a, float* YRAW) {
    const int bb = task & 1, head = (task >> 1) & 15, batch = task >> 5;
    LAS float* R = (LAS float*)c.lds; LAS float* W = R + 4096; LAS float* KP = R + 8192; LAS float* KKN = R + 12288; LAS float* BV = R + 16384; LAS float* VB = R + 20480; LAS float* OUT = R + 22528;
    const int s = c.lane & 15, il = 4 * c.wave + (c.lane >> 4);
    const int col = head * 64 + c.lane;
    const float mur = mu[col], muk = mu[1024 + col], muv = mu[2048 + col], kkc = k_k[col], kac = k_a[col];
    float S[4] = {0.f, 0.f, 0.f, 0.f};
    for (int t0 = 0; t0 < SEQ; t0 += TS) {
#pragma unroll 2
        for (int i = 0; i < 8; ++i) {
            const int tt = c.wave + 8 * i, t = t0 + tt; const size_t m = (size_t)batch * SEQ + t;
            const bf16* ur = U + m * EVP;
            float r = bf2f(ur[col]), k = bf2f(ur[1024 + col]), v = bf2f(ur[2048 + col]);
            float rp = 0.f, kp_ = 0.f, vp = 0.f;
            if (t > 0) { rp = bf2f(ur[col - EVP]); kp_ = bf2f(ur[1024 + col - EVP]); vp = bf2f(ur[2048 + col - EVP]); }
            r += (rp - r) * mur; k += (kp_ - k) * muk; v += (vp - v) * muv;
            const float wv = LW[m * 1024 + col], av = LA[m * 1024 + col];
            float kk = k * kkc; const float ss = wave_sum(kk * kk); kk *= 1.0f / sqrtf(fmaxf(ss, 1e-12f));
            const float kpv = k * (1.0f + (av - 1.0f) * kac);
            R[tt * 64 + c.lane] = r; W[tt * 64 + c.lane] = wv; KP[tt * 64 + c.lane] = kpv; KKN[tt * 64 + c.lane] = -kk; BV[tt * 64 + c.lane] = kk * av;
            if ((c.lane >> 5) == bb) VB[tt * 32 + (c.lane & 31)] = v;
        }
        __syncthreads();
        for (int tt = 0; tt < TS; ++tt) {
            const f32x4 kkn = *(const LAS f32x4*)(KKN + tt * 64 + 4 * s), w4 = *(const LAS f32x4*)(W + tt * 64 + 4 * s), bv = *(const LAS f32x4*)(BV + tt * 64 + 4 * s);
            const f32x4 kp4 = *(const LAS f32x4*)(KP + tt * 64 + 4 * s), r4 = *(const LAS f32x4*)(R + tt * 64 + 4 * s);
            const float vb = VB[tt * 32 + il];
            float sa = (S[0] * kkn[0] + S[1] * kkn[1]) + (S[2] * kkn[2] + S[3] * kkn[3]);
            sa = allred16(sa);
            float y = 0.f;
#pragma unroll
            for (int e = 0; e < 4; ++e) { S[e] = S[e] * w4[e] + sa * bv[e] + vb * kp4[e]; y += S[e] * r4[e]; }
            y = allred16(y);
            if (s == 0) OUT[tt * 32 + il] = y;
        }
        __syncthreads();
        scan_writeout(OUT, YRAW + ((size_t)batch * SEQ + t0) * 1024 + head * 64 + bb * 32, 1024, c.tid);
    }
    __syncthreads();
}

__device__ __forceinline__ void scan_mlstm(const Ctx& c, int task, const bf16* U, const float* MLQK, const float* i_b, const float* f_b, float* HRAW) {
    const int bb = task & 7, head = (task >> 3) & 3, batch = task >> 5;
    LAS float* QA = (LAS float*)c.lds; LAS float* KA = QA + 8192; LAS float* VB = QA + 16384; LAS float* OUT = QA + 18432; LAS float* SC = QA + 20480;
    const int s = c.lane & 15, il = 4 * c.wave + (c.lane >> 4);
    const float ib = i_b[head], fb = f_b[head];
    float S[8], Nn[8];
#pragma unroll
    for (int e = 0; e < 8; ++e) { S[e] = 0.f; Nn[e] = 0.f; }
    for (int t0 = 0; t0 < SEQ; t0 += TS) {
#pragma unroll 2
        for (int i = 0; i < 8; ++i) {
            const int tt = c.wave + 8 * i; const size_t m = (size_t)batch * SEQ + t0 + tt;
            const bf16* ur = U + m * EVP; const float* qk = MLQK + m * 1024;
            const float ei = __expf(bf2f(ur[6592 + head]) + ib);
            QA[tt * 128 + c.lane] = qk[head * 128 + c.lane] * 0.08838834764831845f; QA[tt * 128 + 64 + c.lane] = qk[head * 128 + 64 + c.lane] * 0.08838834764831845f;
            KA[tt * 128 + c.lane] = qk[512 + head * 128 + c.lane] * ei; KA[tt * 128 + 64 + c.lane] = qk[512 + head * 128 + 64 + c.lane] * ei;
            if (c.lane < 32) VB[tt * 32 + c.lane] = bf2f(ur[4544 + head * 256 + bb * 32 + c.lane]);
            if (c.lane == 32) SC[tt] = sigmoidf_(bf2f(ur[6596 + head]) + fb);
        }
        __syncthreads();
        for (int tt = 0; tt < TS; ++tt) {
            const f32x4 q0 = *(const LAS f32x4*)(QA + tt * 128 + 4 * s), q1 = *(const LAS f32x4*)(QA + tt * 128 + 64 + 4 * s);
            const f32x4 k0 = *(const LAS f32x4*)(KA + tt * 128 + 4 * s), k1 = *(const LAS f32x4*)(KA + tt * 128 + 64 + 4 * s);
            const float f = SC[tt], vb = VB[tt * 32 + il];
            float y = 0.f, d = 0.f;
#pragma unroll
            for (int e = 0; e < 4; ++e) {
                S[e] = f * S[e] + k0[e] * vb; Nn[e] = f * Nn[e] + k0[e]; y += q0[e] * S[e]; d += q0[e] * Nn[e];
                S[4 + e] = f * S[4 + e] + k1[e] * vb; Nn[4 + e] = f * Nn[4 + e] + k1[e]; y += q1[e] * S[4 + e]; d += q1[e] * Nn[4 + e];
            }
            y = allred16(y); d = allred16(d);
            if (s == 0) OUT[tt * 32 + il] = y / fmaxf(fabsf(d), 1.0f);
        }
        __syncthreads();
        scan_writeout(OUT, HRAW + ((size_t)batch * SEQ + t0) * 1024 + head * 256 + bb * 32, 1024, c.tid);
    }
    __syncthreads();
}

__device__ __forceinline__ void scan_hgrn(const Ctx& c, int task, const bf16* U, const float* lbl, float* ORAW) {
    const int bb = task & 3, head = (task >> 2) & 7, batch = task >> 5;
    LAS float* QA = (LAS float*)c.lds; LAS float* KA = QA + 8192; LAS float* DA = QA + 16384; LAS float* VB = QA + 24576; LAS float* OUT = QA + 26624;
    const int s = c.lane & 15, il = 4 * c.wave + (c.lane >> 4);
    float lb0, lb1;
    { const int a0 = head * 128 + c.lane, a1 = a0 + 64; lb0 = 1.0f / (1.0f + __expf(lbl[a0] - lbl[1024 + a0])); lb1 = 1.0f / (1.0f + __expf(lbl[a1] - lbl[1024 + a1])); }
    float S[8];
#pragma unroll
    for (int e = 0; e < 8; ++e) S[e] = 0.f;
    for (int t0 = 0; t0 < SEQ; t0 += TS) {
#pragma unroll 2
        for (int i = 0; i < 8; ++i) {
            const int tt = c.wave + 8 * i; const size_t m = (size_t)batch * SEQ + t0 + tt;
            const bf16* ur = U + m * ODP;
            const float q0 = bf2f(ur[head * 128 + c.lane]), q1 = bf2f(ur[head * 128 + 64 + c.lane]);
            const float p0 = bf2f(ur[1024 + head * 128 + c.lane]), p1 = bf2f(ur[1024 + head * 128 + 64 + c.lane]);
            const float s0 = sigmoidf_(p0), s1 = sigmoidf_(p1);
            QA[tt * 128 + c.lane] = siluf_(q0); QA[tt * 128 + 64 + c.lane] = siluf_(q1);
            DA[tt * 128 + c.lane] = lb0 + (1.0f - lb0) * s0; DA[tt * 128 + 64 + c.lane] = lb1 + (1.0f - lb1) * s1;
            KA[tt * 128 + c.lane] = (1.0f - lb0) * (1.0f - s0); KA[tt * 128 + 64 + c.lane] = (1.0f - lb1) * (1.0f - s1);
            if (c.lane < 32) VB[tt * 32 + c.lane] = bf2f(ur[2048 + head * 128 + bb * 32 + c.lane]);
        }
        __syncthreads();
        for (int tt = 0; tt < TS; ++tt) {
            const f32x4 q0 = *(const LAS f32x4*)(QA + tt * 128 + 4 * s), q1 = *(const LAS f32x4*)(QA + tt * 128 + 64 + 4 * s);
            const f32x4 k0 = *(const LAS f32x4*)(KA + tt * 128 + 4 * s), k1 = *(const LAS f32x4*)(KA + tt * 128 + 64 + 4 * s);
            const f32x4 d0 = *(const LAS f32x4*)(DA + tt * 128 + 4 * s), d1 = *(const LAS f32x4*)(DA + tt * 128 + 64 + 4 * s);
            const float vb = VB[tt * 32 + il];
            float y = 0.f;
#pragma unroll
            for (int e = 0; e < 4; ++e) {
                S[e] = d0[e] * S[e] + k0[e] * vb; y += q0[e] * S[e];
                S[4 + e] = d1[e] * S[4 + e] + k1[e] * vb; y += q1[e] * S[4 + e];
            }
            y = allred16(y);
            if (s == 0) OUT[tt * 32 + il] = y;
        }
        __syncthreads();
        scan_writeout(OUT, ORAW + ((size_t)batch * SEQ + t0) * 1024 + head * 128 + bb * 32, 1024, c.tid);
    }
    __syncthreads();
}

__device__ __forceinline__ void scan_mamba(const Ctx& c, int task, const bf16* U, const float* XBC, const float* dt_bias, const float* A_log, const float* Dsk, float* YRAW) {
    const int bb = task & 1, head = (task >> 1) & 15, batch = task >> 5, grp = head >> 2;
    LAS float* QA = (LAS float*)c.lds; LAS float* KA = QA + 8192; LAS float* VB = QA + 16384; LAS float* OUT = QA + 18432; LAS float* SC = QA + 20480;
    const int s = c.lane & 15, il = 4 * c.wave + (c.lane >> 4);
    const float dtb = dt_bias[head], Aneg = -__expf(A_log[head]), Dh = Dsk[head];
    float S[8];
#pragma unroll
    for (int e = 0; e < 8; ++e) S[e] = 0.f;
    for (int t0 = 0; t0 < SEQ; t0 += TS) {
#pragma unroll 2
        for (int i = 0; i < 8; ++i) {
            const int tt = c.wave + 8 * i; const size_t m = (size_t)batch * SEQ + t0 + tt;
            const float* xr = XBC + m * 2048;
            QA[tt * 128 + c.lane] = xr[1536 + grp * 128 + c.lane]; QA[tt * 128 + 64 + c.lane] = xr[1536 + grp * 128 + 64 + c.lane];
            KA[tt * 128 + c.lane] = xr[1024 + grp * 128 + c.lane]; KA[tt * 128 + 64 + c.lane] = xr[1024 + grp * 128 + 64 + c.lane];
            if (c.lane < 32) VB[tt * 32 + c.lane] = xr[head * 64 + bb * 32 + c.lane];
            if (c.lane == 32) { const float x = bf2f(U[m * ODP + 7168 + head]) + dtb; const float dt = x > 20.0f ? x : log1pf(__expf(x)); SC[tt * 2] = __expf(Aneg * dt); SC[tt * 2 + 1] = dt; }
        }
        __syncthreads();
        for (int tt = 0; tt < TS; ++tt) {
            const f32x4 q0 = *(const LAS f32x4*)(QA + tt * 128 + 4 * s), q1 = *(const LAS f32x4*)(QA + tt * 128 + 64 + 4 * s);
            const f32x4 k0 = *(const LAS f32x4*)(KA + tt * 128 + 4 * s), k1 = *(const LAS f32x4*)(KA + tt * 128 + 64 + 4 * s);
            const float dec = SC[tt * 2], dt = SC[tt * 2 + 1], vb = VB[tt * 32 + il], xe = vb * dt;
            float y = 0.f;
#pragma unroll
            for (int e = 0; e < 4; ++e) {
                S[e] = dec * S[e] + k0[e] * xe; y += q0[e] * S[e];
                S[4 + e] = dec * S[4 + e] + k1[e] * xe; y += q1[e] * S[4 + e];
            }
            y = allred16(y);
            if (s == 0) OUT[tt * 32 + il] = y + Dh * vb;
        }
        __syncthreads();
        scan_writeout(OUT, YRAW + ((size_t)batch * SEQ + t0) * 1024 + head * 64 + bb * 32, 1024, c.tid);
    }
    __syncthreads();
}

struct Args { const float* in[41]; float* out; unsigned char* ws; int lo, hi; };

__global__ void __launch_bounds__(512, 2) fwd(Args args) {
    extern __shared__ __attribute__((aligned(16))) unsigned char lds_raw[];
    Ctx c; c.lds = (LAS unsigned char*)lds_raw; c.tid = threadIdx.x; c.lane = c.tid & 63; c.wave = __builtin_amdgcn_readfirstlane(c.tid >> 6); c.bid = blockIdx.x; c.G = gridDim.x;
    volatile LAS unsigned* MISC = (volatile LAS unsigned*)(c.lds + MISC_OFF);
    unsigned char* ws = args.ws;
    for (int u = c.tid; u < (LDS_BYTES - RING_BYTES) / 4; u += 512) ((LAS unsigned*)(c.lds + RING_BYTES))[u] = 0u;
    __syncthreads();
    const int lo = args.lo, hi = args.hi;
    XcdBarrier bar; bar.bar = (unsigned*)(ws + WS_CTL) + CW_BAR; bar.x = 0; bar.st = nullptr;
    if (hi - lo > 1) bar = xcd_barrier_post((unsigned*)(ws + WS_CTL) + CW_BAR, MISC + 8);
#define IN(k) (lo <= (k) && (k) < hi)
#define SEAM(k) do { if (IN(k) && IN((k) + 1)) xcd_barrier(bar); } while (0)

    const float* x = args.in[0]; const float* final_norm_w = args.in[1]; const float* hg_lb = args.in[2];
    const float* ev_norm1_w = args.in[3]; const float* ev_w_in = args.in[4]; const float* ev_w_out = args.in[5];
    const float* rw_mu = args.in[6]; const float* rw_w0 = args.in[7]; const float* rw_w2 = args.in[8]; const float* rw_a0 = args.in[9]; const float* rw_a2 = args.in[10]; const float* rw_g2 = args.in[11];
    const float* rw_k_k = args.in[12]; const float* rw_k_a = args.in[13]; const float* rw_r_k = args.in[14]; const float* rw_ln_w = args.in[15]; const float* rw_ln_b = args.in[16];
    const float* ml_conv_w = args.in[17]; const float* ml_conv_b = args.in[18]; const float* ml_i_b = args.in[19]; const float* ml_f_b = args.in[20]; const float* ml_norm_w = args.in[21];
    const float* ev_norm2_w = args.in[22]; const float* ffn_w_gate = args.in[23]; const float* ffn_w_up = args.in[24]; const float* ffn_w_down = args.in[25];
    const float* od_norm1_w = args.in[26]; const float* od_w_in = args.in[27]; const float* od_w_out = args.in[28]; const float* hg_norm_w = args.in[29];
    const float* mb_conv_w = args.in[30]; const float* mb_conv_b = args.in[31]; const float* mb_dt_bias = args.in[32]; const float* mb_A_log = args.in[33]; const float* mb_D = args.in[34]; const float* mb_norm_w = args.in[35];
    const float* od_norm2_w = args.in[36]; const float* moe_router = args.in[37]; const float* moe_w_gate = args.in[38]; const float* moe_w_up = args.in[39]; const float* moe_w_down = args.in[40];
    float* OUT = args.out;
    bf16* W_LORA = (bf16*)(ws + WS_WLORA); bf16* W_EVIN = (bf16*)(ws + WS_WEVIN); bf16* W_EVOUT = (bf16*)(ws + WS_WEVOUT); bf16* W_FGU = (bf16*)(ws + WS_WFGU); bf16* W_FD = (bf16*)(ws + WS_WFD);
    bf16* W_ODIN = (bf16*)(ws + WS_WODIN); bf16* W_ODOUT = (bf16*)(ws + WS_WODOUT); bf16* W_MGU = (bf16*)(ws + WS_WMGU); bf16* W_MD = (bf16*)(ws + WS_WMD);
    bf16* XN = (bf16*)(ws + WS_XN); bf16* Y = (bf16*)(ws + WS_Y); float* X1 = (float*)(ws + WS_X1);
    bf16* U = (bf16*)(ws + SC_U); float* LW = (float*)(ws + SC_LW); float* LA = (float*)(ws + SC_LA); float* LG = (float*)(ws + SC_LG); bf16* ALORA = (bf16*)(ws + SC_ALORA);
    float* YRAW_E = (float*)(ws + SC_YRAW_E); float* MLQK = (float*)(ws + SC_MLQK); float* HRAW = (float*)(ws + SC_HRAW);
    bf16* ACT = (bf16*)(ws + SC_ACT);
    float* XBC = (float*)(ws + SC_XBC); float* ORAW = (float*)(ws + SC_ORAW); float* YRAW_O = (float*)(ws + SC_YRAW_O);
    bf16* HS = (bf16*)(ws + SC_HS); bf16* ACTS = (bf16*)(ws + SC_ACTS); float* OUTS = (float*)(ws + SC_OUTS);
    int* TOPK = (int*)(ws + SC_TOPK); int* POS = (int*)(ws + SC_POS); int* CNT = (int*)(ws + SC_CNT); int* TILES = (int*)(ws + SC_TILES);
    float* X2 = OUT;

    if (IN(0)) {
        int base = 0;
        conv_kind(c, ev_w_in, DM, 6600, EVP, W_EVIN, 0, 1, 0, 0, base);
        conv_kind(c, ev_w_out, DM, DM, DM, W_EVOUT, 0, 1, 0, 0, base);
        conv_kind(c, ffn_w_gate, DM, FF, FF, W_FGU, 1, 1, 0, 0, base);
        conv_kind(c, ffn_w_up, DM, FF, FF, W_FGU, 2, 1, 0, 0, base);
        conv_kind(c, ffn_w_down, FF, DM, DM, W_FD, 0, 1, 0, 0, base);
        conv_kind(c, od_w_in, DM, 7184, ODP, W_ODIN, 0, 1, 0, 0, base);
        conv_kind(c, od_w_out, DM, DM, DM, W_ODOUT, 0, 1, 0, 0, base);
        conv_kind(c, moe_w_gate, DM, FE, FE, W_MGU, 1, NEXP, (size_t)DM * FE, (size_t)2 * FE * DM, base);
        conv_kind(c, moe_w_up, DM, FE, FE, W_MGU, 2, NEXP, (size_t)DM * FE, (size_t)2 * FE * DM, base);
        conv_kind(c, moe_w_down, FE, DM, DM, W_MD, 0, NEXP, (size_t)FE * DM, (size_t)DM * FE, base);
        for (int idx = c.bid * 512 + c.tid; idx < 3072 * 512; idx += c.G * 512) {
            const int k = idx / 3072, n = idx % 3072; float v = 0.f;
            if (n < 1024) { if (k < 96) v = rw_w2[k * 1024 + n]; }
            else if (n < 2048) { if (k >= 96 && k < 192) v = rw_a2[(k - 96) * 1024 + (n - 1024)]; }
            else { if (k >= 192 && k < 448) v = rw_g2[(k - 192) * 1024 + (n - 2048)]; }
            W_LORA[(size_t)n * 512 + k] = (bf16)f2bf(v);
        }
        rmsnorm_phase(c, x, ev_norm1_w, XN);
    }
    SEAM(0);
    if (IN(1)) {
        pg8::Gemm g{XN, W_EVIN, M_TOK, EVP, DM}; pg8::StaticOrder S; S.init(M_TOK, EVP, c.G, c.bid);
        pg8::EpiBf16 E{U, EVP};
        pg8::gemm_phase<pg8::EpiBf16, pg8::StaticOrder, true, true>(c.lds, g, S, E);
    }
    SEAM(1);
    if (IN(2)) {
        for (int m = c.bid; m < M_TOK; m += c.G) {
            const int tl = m & (SEQ - 1); const bf16* ur = U + (size_t)m * EVP;
            for (int idx = c.tid; idx < 1536; idx += 512) {
                if (idx < 512) {
                    float val = 0.f;
                    if (idx < 448) { const int col = 3072 + idx; const float cu = bf2f(ur[col]); const float pv = tl ? bf2f(ur[col - EVP]) : 0.f; const float xs = cu + (pv - cu) * rw_mu[col];
                        val = idx < 96 ? tanhf(xs) : (idx < 192 ? xs : sigmoidf_(xs)); }
                    ALORA[(size_t)m * 512 + idx] = (bf16)f2bf(val);
                } else {
                    const int ch = idx - 512; float acc = ml_conv_b[ch];
#pragma unroll
                    for (int j = 0; j < 4; ++j) { if (tl - 3 + j >= 0) acc += ml_conv_w[j * 1024 + ch] * bf2f(ur[(j - 3) * EVP + 3520 + ch]); }
                    MLQK[(size_t)m * 1024 + ch] = siluf_(acc);
                }
            }
        }
    }
    SEAM(2);
    if (IN(3)) {
        pg8::Gemm g{ALORA, W_LORA, M_TOK, 3072, 512}; pg8::StaticOrder S; S.init(M_TOK, 3072, c.G, c.bid);
        pg8::EpiLora E{LW, rw_w0, rw_a0};
        pg8::gemm_phase<pg8::EpiLora, pg8::StaticOrder, true, true>(c.lds, g, S, E);
    }
    SEAM(3);
    if (IN(4)) {
        for (int task = c.bid; task < 256; task += c.G) {
            if (task < 128) scan_rwkv(c, task, U, LW, LA, rw_mu, rw_k_k, rw_k_a, YRAW_E);
            else scan_mlstm(c, task - 128, U, MLQK, ml_i_b, ml_f_b, HRAW);
        }
    }
    SEAM(4);
    if (IN(5)) {
        for (int m = c.bid; m < M_TOK; m += c.G) {
            const int tl = m & (SEQ - 1); const bf16* ur = U + (size_t)m * EVP;
            if (c.wave < 4) {
                for (int hh = 0; hh < 4; ++hh) {
                    const int head = c.wave * 4 + hh, col = head * 64 + c.lane;
                    const float yv = YRAW_E[(size_t)m * 1024 + col];
                    const float mean = wave_sum(yv) * (1.0f / 64.0f); const float dv = yv - mean; const float var = wave_sum(dv * dv) * (1.0f / 64.0f);
                    const float yn = dv * (1.0f / sqrtf(var + 64e-5f)) * rw_ln_w[col] + rw_ln_b[col];
                    float r = bf2f(ur[col]), k = bf2f(ur[1024 + col]), v = bf2f(ur[2048 + col]);
                    float rp = 0.f, kp = 0.f, vp = 0.f;
                    if (tl) { rp = bf2f(ur[col - EVP]); kp = bf2f(ur[1024 + col - EVP]); vp = bf2f(ur[2048 + col - EVP]); }
                    r += (rp - r) * rw_mu[col]; k += (kp - k) * rw_mu[1024 + col]; v += (vp - v) * rw_mu[2048 + col];
                    const float av = LA[(size_t)m * 1024 + col];
                    const float kpv = k * (1.0f + (av - 1.0f) * rw_k_a[col]);
                    const float bonus = wave_sum(r * kpv * rw_r_k[col]);
                    Y[(size_t)m * DM + col] = (bf16)f2bf((yn + bonus * v) * LG[(size_t)m * 1024 + col]);
                }
            } else {
                const int head = c.wave - 4, col = head * 256 + 4 * c.lane;
                const f32x4 hv = *(const f32x4*)(HRAW + (size_t)m * 1024 + col);
                const float ss = wave_sum((hv.x * hv.x + hv.y * hv.y) + (hv.z * hv.z + hv.w * hv.w));
                const float rs = 1.0f / sqrtf(ss * (1.0f / 256.0f) + 1e-6f);
                const f32x4 nw = *(const f32x4*)(ml_norm_w + col);
                float o[4];
#pragma unroll
                for (int j = 0; j < 4; ++j) o[j] = hv[j] * rs * nw[j] * sigmoidf_(bf2f(ur[5568 + col + j]));
                v2u p; p.x = cvt_pk_bf16(o[0], o[1]); p.y = cvt_pk_bf16(o[2], o[3]); *(v2u*)(Y + (size_t)m * DM + 1024 + col) = p;
            }
        }
    }
    SEAM(5);
    if (IN(6)) {
        pg8::Gemm g{Y, W_EVOUT, M_TOK, DM, DM}; pg8::StaticOrder S; S.init(M_TOK, DM, c.G, c.bid);
        pg8::EpiResF32 E{x, X1, DM};
        pg8::gemm_phase<pg8::EpiResF32, pg8::StaticOrder, false, true>(c.lds, g, S, E);
    }
    SEAM(6);
    if (IN(7)) rmsnorm_phase(c, X1, ev_norm2_w, XN);
    SEAM(7);
    if (IN(8)) {
        pg8::Gemm g{XN, W_FGU, M_TOK, 2 * FF, DM}; pg8::StaticOrder S; S.init(M_TOK, 2 * FF, c.G, c.bid);
        pg8::EpiSwiGLU E{ACT, FF};
        pg8::gemm_phase<pg8::EpiSwiGLU, pg8::StaticOrder, true, true>(c.lds, g, S, E);
    }
    SEAM(8);
    if (IN(9)) {
        pg8::Gemm g{ACT, W_FD, M_TOK, DM, FF}; pg8::StaticOrder S; S.init(M_TOK, DM, c.G, c.bid);
        pg8::EpiResF32 E{X1, X2, DM};
        pg8::gemm_phase<pg8::EpiResF32, pg8::StaticOrder, false, true>(c.lds, g, S, E);
    }
    SEAM(9);
    if (IN(10)) rmsnorm_phase(c, X2, od_norm1_w, XN);
    SEAM(10);
    if (IN(11)) {
        pg8::Gemm g{XN, W_ODIN, M_TOK, ODP, DM}; pg8::StaticOrder S; S.init(M_TOK, ODP, c.G, c.bid);
        pg8::EpiBf16 E{U, ODP};
        pg8::gemm_phase<pg8::EpiBf16, pg8::StaticOrder, true, true>(c.lds, g, S, E);
    }
    SEAM(11);
    if (IN(12)) {
        for (int m = c.bid; m < M_TOK; m += c.G) {
            const int tl = m & (SEQ - 1); const bf16* ur = U + (size_t)m * ODP;
            for (int ch = c.tid; ch < 2048; ch += 512) {
                float acc = mb_conv_b[ch];
#pragma unroll
                for (int j = 0; j < 4; ++j) { if (tl - 3 + j >= 0) acc += mb_conv_w[j * 2048 + ch] * bf2f(ur[(j - 3) * ODP + 5120 + ch]); }
                XBC[(size_t)m * 2048 + ch] = siluf_(acc);
            }
        }
    }
    SEAM(12);
    if (IN(13)) {
        for (int task = c.bid; task < 256; task += c.G) {
            if (task < 128) scan_hgrn(c, task, U, hg_lb, ORAW);
            else scan_mamba(c, task - 128, U, XBC, mb_dt_bias, mb_A_log, mb_D, YRAW_O);
        }
    }
    SEAM(13);
    if (IN(14)) {
        for (int m = c.bid; m < M_TOK; m += c.G) {
            const bf16* ur = U + (size_t)m * ODP;
            if (c.wave < 4) {
#pragma unroll
                for (int hh = 0; hh < 2; ++hh) {
                    const int head = c.wave * 2 + hh, col = head * 128 + 2 * c.lane;
                    const f32x2 ov = *(const f32x2*)(ORAW + (size_t)m * 1024 + col);
                    const float rs = 1.0f / sqrtf(wave_sum(ov.x * ov.x + ov.y * ov.y) * (1.0f / 128.0f) + 1e-6f);
                    const float o0 = ov.x * rs * hg_norm_w[col] * siluf_(bf2f(ur[3072 + col])), o1 = ov.y * rs * hg_norm_w[col + 1] * siluf_(bf2f(ur[3072 + col + 1]));
                    *(unsigned*)(Y + (size_t)m * DM + col) = cvt_pk_bf16(o0, o1);
                }
            } else {
                const int grp = c.wave - 4, col = grp * 256 + 4 * c.lane;
                const f32x4 yv = *(const f32x4*)(YRAW_O + (size_t)m * 1024 + col);
                float t[4]; float ss = 0.f;
#pragma unroll
                for (int j = 0; j < 4; ++j) { t[j] = yv[j] * siluf_(bf2f(ur[4096 + col + j])); ss += t[j] * t[j]; }
                const float rs = 1.0f / sqrtf(wave_sum(ss) * (1.0f / 256.0f) + 1e-6f);
                const f32x4 nw = *(const f32x4*)(mb_norm_w + col);
                v2u p; p.x = cvt_pk_bf16(t[0] * rs * nw[0], t[1] * rs * nw[1]); p.y = cvt_pk_bf16(t[2] * rs * nw[2], t[3] * rs * nw[3]); *(v2u*)(Y + (size_t)m * DM + 1024 + col) = p;
            }
        }
    }
    SEAM(14);
    if (IN(15)) {
        pg8::Gemm g{Y, W_ODOUT, M_TOK, DM, DM}; pg8::StaticOrder S; S.init(M_TOK, DM, c.G, c.bid);
        pg8::EpiResF32 E{X2, X1, DM};
        pg8::gemm_phase<pg8::EpiResF32, pg8::StaticOrder, false, true>(c.lds, g, S, E);
    }
    SEAM(15);
    if (IN(16)) {
        LAS float* RT = (LAS float*)c.lds;
        LAS int* lcnt = (LAS int*)(c.lds + 65536);
        for (int i = c.tid; i < 2048 * 8 / 4; i += 512) *(LAS f32x4*)(RT + 4 * i) = *(const f32x4*)(moe_router + 4 * i);
        __syncthreads();
        for (int blk = c.bid; blk < 256; blk += c.G) {
            if (c.tid < 8) lcnt[c.tid] = 0;
            __syncthreads();
            for (int q = 0; q < 4; ++q) {
                const int m = blk * 32 + c.wave * 4 + q;
                const float* xr = X1 + (size_t)m * DM;
                f32x4 v[8]; float ss = 0.f;
#pragma unroll
                for (int j = 0; j < 8; ++j) { v[j] = *(const f32x4*)(xr + 4 * c.lane + 256 * j); ss += (v[j].x * v[j].x + v[j].y * v[j].y) + (v[j].z * v[j].z + v[j].w * v[j].w); }
                const float rs = 1.0f / sqrtf(wave_sum(ss) * (1.0f / 2048.0f) + 1e-6f);
                float lg[8];
#pragma unroll
                for (int e = 0; e < 8; ++e) lg[e] = 0.f;
#pragma unroll
                for (int j = 0; j < 8; ++j) { const f32x4 wv = *(const f32x4*)(od_norm2_w + 4 * c.lane + 256 * j); const f32x4 hn = v[j] * rs * wv;
                    v2u p; p.x = cvt_pk_bf16(hn.x, hn.y); p.y = cvt_pk_bf16(hn.z, hn.w); *(v2u*)(XN + (size_t)m * DM + 4 * c.lane + 256 * j) = p;
#pragma unroll
                    for (int i = 0; i < 4; ++i) { const int ch = 4 * c.lane + 256 * j + i; const f32x4 r0 = *(const LAS f32x4*)(RT + ch * 8), r1 = *(const LAS f32x4*)(RT + ch * 8 + 4);
                        lg[0] += hn[i] * r0[0]; lg[1] += hn[i] * r0[1]; lg[2] += hn[i] * r0[2]; lg[3] += hn[i] * r0[3]; lg[4] += hn[i] * r1[0]; lg[5] += hn[i] * r1[1]; lg[6] += hn[i] * r1[2]; lg[7] += hn[i] * r1[3]; } }
#pragma unroll
                for (int e = 0; e < 8; ++e) lg[e] = wave_sum(lg[e]);
                int e0 = 0; float v0 = lg[0];
#pragma unroll
                for (int e = 1; e < 8; ++e) if (lg[e] > v0) { v0 = lg[e]; e0 = e; }
                int e1 = -1; float v1 = -3.0e38f;
#pragma unroll
                for (int e = 0; e < 8; ++e) if (e != e0 && lg[e] > v1) { v1 = lg[e]; e1 = e; }
                const float p0 = 1.0f / (1.0f + __expf(v1 - v0)), p1 = 1.0f - p0;
                if (c.lane == 0) { TOPK[m * 4] = e0; TOPK[m * 4 + 1] = e1; TOPK[m * 4 + 2] = __float_as_int(p0); TOPK[m * 4 + 3] = __float_as_int(p1); atomicAdd((int*)&lcnt[e0], 1); atomicAdd((int*)&lcnt[e1], 1); }
            }
            __syncthreads();
            if (c.tid < 8) CNT[blk * 8 + c.tid] = lcnt[c.tid];
            __syncthreads();
        }
    }
    SEAM(16);
    if (IN(17)) {
        LAS int* C8 = (LAS int*)c.lds;
        LAS int* tot = C8 + 2048; LAS int* pre = tot + 8; LAS int* segst = pre + 8; LAS int* ntl = segst + 8; LAS int* basee = ntl + 8; LAS int* lpos = basee + 8;
        for (int blk = c.bid; blk < 256; blk += c.G) {
            for (int i = c.tid; i < 2048; i += 512) C8[i] = CNT[i];
            __syncthreads();
            if (c.tid < 8) { int t = 0, p = 0; for (int b = 0; b < 256; ++b) { const int v = C8[b * 8 + c.tid]; t += v; if (b < blk) p += v; } tot[c.tid] = t; pre[c.tid] = p; }
            __syncthreads();
            if (c.tid == 0) {
                int seg = 0;
                for (int e = 0; e < 8; ++e) { segst[e] = seg; ntl[e] = (tot[e] + 255) >> 8; seg += ntl[e] * 256; basee[e] = seg - ntl[e] * 256 + pre[e]; }
                for (int i = 0; i < 32; ++i) { const int m = blk * 32 + i; const int e0 = TOPK[m * 4], e1 = TOPK[m * 4 + 1];
                    const int p0 = basee[e0]; basee[e0] = p0 + 1; const int p1 = basee[e1]; basee[e1] = p1 + 1;
                    POS[m * 2] = p0; POS[m * 2 + 1] = p1; lpos[2 * i] = p0; lpos[2 * i + 1] = p1; }
                if (blk == 0) { int t = 0; for (int e = 0; e < 8; ++e) for (int k = 0; k < ntl[e]; ++k) TILES[1 + t++] = e; TILES[0] = t; }
            }
            __syncthreads();
            for (int pr = c.wave; pr < 64; pr += 8) {
                const int m = blk * 32 + (pr >> 1); const int pos = lpos[pr];
                const v4u* src = (const v4u*)(XN + (size_t)m * DM); v4u* dst = (v4u*)(HS + (size_t)pos * DM);
#pragma unroll
                for (int j = 0; j < 4; ++j) dst[c.lane + 64 * j] = src[c.lane + 64 * j];
            }
            for (int e = 0; e < 8; ++e) {
                const int npad = ntl[e] * 256 - tot[e], r0 = segst[e] + tot[e];
                for (int p = blk; p < npad; p += 256) { v2u* dst = (v2u*)(HS + (size_t)(r0 + p) * DM); dst[c.tid] = (v2u){0u, 0u}; }
            }
            __syncthreads();
        }
    }
    SEAM(17);
    if (IN(18)) {
        const int NT = __builtin_amdgcn_readfirstlane(TILES[0]);
        pg8::Gemm g{HS, W_MGU, 0, 0, DM}; pg8::GroupedOrder S{TILES + 1, NT, 22, c.G, c.bid};
        pg8::EpiSwiGLU E{ACTS, FE};
        pg8::gemm_phase<pg8::EpiSwiGLU, pg8::GroupedOrder, true, true>(c.lds, g, S, E);
    }
    SEAM(18);
    if (IN(19)) {
        const int NT = __builtin_amdgcn_readfirstlane(TILES[0]);
        pg8::Gemm g{ACTS, W_MD, 0, 0, FE}; pg8::GroupedOrder S{TILES + 1, NT, 8, c.G, c.bid};
        pg8::EpiResF32 E{nullptr, OUTS, DM};
        pg8::gemm_phase<pg8::EpiResF32, pg8::GroupedOrder, true, true>(c.lds, g, S, E);
    }
    SEAM(19);
    if (IN(20)) {
        const int gw = c.bid * 8 + c.wave, NGW = c.G * 8;
        for (int m = gw; m < M_TOK; m += NGW) {
            const float p0 = __int_as_float(TOPK[m * 4 + 2]), p1 = __int_as_float(TOPK[m * 4 + 3]); const int q0 = POS[m * 2], q1 = POS[m * 2 + 1];
            const float* xr = X1 + (size_t)m * DM; const float* o0 = OUTS + (size_t)q0 * DM; const float* o1 = OUTS + (size_t)q1 * DM;
            f32x4 v[8]; float ss = 0.f;
#pragma unroll
            for (int j = 0; j < 8; ++j) { const int o = 4 * c.lane + 256 * j; v[j] = *(const f32x4*)(xr + o) + p0 * *(const f32x4*)(o0 + o) + p1 * *(const f32x4*)(o1 + o);
                ss += (v[j].x * v[j].x + v[j].y * v[j].y) + (v[j].z * v[j].z + v[j].w * v[j].w); }
            const float rs = 1.0f / sqrtf(wave_sum(ss) * (1.0f / 2048.0f) + 1e-6f);
#pragma unroll
            for (int j = 0; j < 8; ++j) { const int o = 4 * c.lane + 256 * j; *(f32x4*)(OUT + (size_t)m * DM + o) = v[j] * rs * *(const f32x4*)(final_norm_w + o); }
        }
    }
#undef IN
#undef SEAM
}

extern "C" void kernel_launch(void* const* d_in, const int* in_sizes, int n_in, void* d_out, int out_size, void* d_ws, size_t ws_size, hipStream_t stream) {
    static int grid = 0;
    if (grid == 0) {
        if (n_in != 41 || out_size != M_TOK * DM || ws_size < WS_END) { fprintf(stderr, "kernel_launch: unexpected problem (n_in %d, out %d, ws %zu < %zu)\n", n_in, out_size, ws_size, (size_t)WS_END); grid = -1; return; }
        int dev = 0, cus = 0, per_cu = 0;
        if (hipGetDevice(&dev) != hipSuccess || hipDeviceGetAttribute(&cus, hipDeviceAttributeMultiprocessorCount, dev) != hipSuccess) { grid = -1; return; }
        if (hipFuncSetAttribute((const void*)fwd, hipFuncAttributeMaxDynamicSharedMemorySize, LDS_BYTES) != hipSuccess) { fprintf(stderr, "kernel_launch: hipFuncSetAttribute failed\n"); grid = -1; return; }
        if (hipOccupancyMaxActiveBlocksPerMultiprocessor(&per_cu, (const void*)fwd, 512, LDS_BYTES) != hipSuccess || per_cu < 1) fprintf(stderr, "kernel_launch: occupancy query says %d\n", per_cu);
        (void)hipGetLastError();
        grid = cus;
    }
    if (grid < 0) return;
    (void)hipMemsetAsync((char*)d_ws + WS_CTL, 0, CTL_ZERO_BYTES, stream);
    Args a{};
    for (int i = 0; i < 41; ++i) a.in[i] = (const float*)d_in[i];
    a.out = (float*)d_out; a.ws = (unsigned char*)d_ws;
    if (MK_N_LAUNCHES == 1) { a.lo = 0; a.hi = NPHASE; hipLaunchKernelGGL(fwd, dim3(grid), dim3(512), LDS_BYTES, stream, a); }
    else { for (int p = 0; p < NPHASE; ++p) { a.lo = p; a.hi = p + 1; hipLaunchKernelGGL(fwd, dim3(grid), dim3(512), LDS_BYTES, stream, a); } }
}
```

```cpp
#include <hip/hip_runtime.h>
#include <cstdio>
#include <cstdint>

#ifndef MK_N_LAUNCHES
#define MK_N_LAUNCHES 1
#endif

#ifndef PROBE_DUP
#define PROBE_DUP 0u
#endif
#ifndef PROBE_EXTRA
#define PROBE_EXTRA 1
#endif
#define GAS __attribute__((address_space(1)))
#define LAS __attribute__((address_space(3)))
typedef unsigned short bf16;
typedef unsigned v4u __attribute__((ext_vector_type(4)));
typedef unsigned v2u __attribute__((ext_vector_type(2)));
typedef float f32x4 __attribute__((ext_vector_type(4)));
typedef float f32x2 __attribute__((ext_vector_type(2)));
typedef short bf16x8 __attribute__((ext_vector_type(8)));

constexpr int M_TOK = 8192, SEQ = 2048, DM = 2048;
constexpr int EVP = 6656, ODP = 7424;
constexpr int FF = 5632, FE = 2816, NEXP = 8;
constexpr int NPHASE = 22;

constexpr size_t MiB = 1u << 20;
constexpr size_t WS_CTL = 0, CTL_ZERO_BYTES = 1 * MiB;
constexpr size_t WS_WLORA = 1 * MiB, WS_WEVIN = 4 * MiB, WS_WEVOUT = 30 * MiB, WS_WFGU = 38 * MiB, WS_WFD = 82 * MiB;
constexpr size_t WS_WODIN = 104 * MiB, WS_WODOUT = 133 * MiB, WS_WMGU = 141 * MiB, WS_WMD = 317 * MiB;
constexpr size_t WS_XN = 405 * MiB, WS_Y = 437 * MiB, WS_X1 = 469 * MiB, WS_SCR = 533 * MiB;
constexpr size_t SC_U = WS_SCR, SC_LW = WS_SCR + 104 * MiB, SC_LA = WS_SCR + 136 * MiB, SC_LG = WS_SCR + 168 * MiB, SC_ALORA = WS_SCR + 200 * MiB;
constexpr size_t SC_YRAW_E = WS_SCR + 208 * MiB, SC_MLQK = WS_SCR + 240 * MiB, SC_HRAW = WS_SCR + 272 * MiB;
constexpr size_t SC_DEN = WS_SCR + 304 * MiB;
constexpr size_t SC_ACT = WS_SCR;
constexpr size_t SC_XBC = WS_SCR + 116 * MiB, SC_ORAW = WS_SCR + 180 * MiB, SC_YRAW_O = WS_SCR + 212 * MiB;
constexpr int MOE_MAXROWS = 18432;
constexpr size_t SC_HS = WS_SCR, SC_ACTS = WS_SCR + 72 * MiB, SC_OUTS = WS_SCR + 171 * MiB;
constexpr size_t SC_TOPK = WS_SCR + 316 * MiB, SC_POS = SC_TOPK + 131072, SC_CNT = SC_POS + 65536, SC_TILES = SC_CNT + 8192;
constexpr size_t WS_END = WS_SCR + 317 * MiB;
static_assert(SC_OUTS + (size_t)MOE_MAXROWS * DM * 4 <= SC_TOPK, "moe map");
static_assert(WS_END <= 907708384ull, "d_ws map exceeds the guaranteed workspace");
constexpr int CW_BAR = 4096;

constexpr int RING_BYTES = 131072, MISC_OFF = RING_BYTES + 320, LDS_BYTES = 147456;

__device__ __forceinline__ float bf2f(bf16 b) { return __uint_as_float(((unsigned)b) << 16); }
__device__ __forceinline__ unsigned f2bf(float f) { unsigned u = __float_as_uint(f); return (u + 0x7fffu + ((u >> 16) & 1u)) >> 16; }
typedef __bf16 bf16v2 __attribute__((ext_vector_type(2)));
__device__ __forceinline__ unsigned cvt_pk_bf16(float lo, float hi) { const bf16v2 v = {(__bf16)lo, (__bf16)hi}; return __builtin_bit_cast(unsigned, v); }
__device__ __forceinline__ float sigmoidf_(float x) { return 1.0f / (1.0f + __expf(-x)); }
__device__ __forceinline__ float siluf_(float x) { return x / (1.0f + __expf(-x)); }
__device__ __forceinline__ float wave_sum(float v) {
#pragma unroll
    for (int o = 1; o < 64; o <<= 1) v += __shfl_xor(v, o);
    return v;
}
template <int CTRL> __device__ __forceinline__ float dppf(float v) { return __builtin_bit_cast(float, __builtin_amdgcn_mov_dpp(__builtin_bit_cast(int, v), CTRL, 0xf, 0xf, false)); }
__device__ __forceinline__ float allred16(float v) { v += dppf<0x128>(v); v += dppf<0x124>(v); v += dppf<0x122>(v); v += dppf<0x121>(v); return v; }

namespace pg8 {
#define PG8_LAS __attribute__((address_space(3)))
typedef unsigned short bf16_t;
typedef unsigned u32x4 __attribute__((ext_vector_type(4)));
constexpr int BM = 256, BK = 64, HALF = 128, HTB = HALF * BK * 2, STAGE_BYTES = 8 * HTB, NXCD = 8, WGM = 8;
__host__ __device__ __forceinline__ int lds_byte(int r, int c) { const int st = (r >> 4) * 2 + (c >> 5), rr = r & 15, cc = c & 31, ob = rr * 64 + cc * 2; return st * 1024 + (ob ^ (((ob >> 9) & 1) << 5)); }
__host__ __device__ __forceinline__ void stage_rc(int b, int& R, int& C) { const int st = b / 1024, sb = b % 1024, swz = sb ^ (((sb >> 9) & 1) << 5); R = (st >> 1) * 16 + swz / 64; C = (st & 1) * 32 + (swz % 64) / 2; }
__host__ __device__ __forceinline__ int perm32(int rho) { const int n = rho >> 4, i = rho & 15; return 8 * (i >> 2) + 4 * n + (i & 3); }

struct Unit { int pm, pn, pc; };
struct Gemm { const bf16_t* A; const bf16_t* Bt; int M, N, K; };

struct StaticOrder {
    int nM, nN, nwg, G, c;
    __device__ void init(int M, int N, int G_, int c_) { nM = M / BM; nN = N / BM; nwg = nM * nN; G = G_; c = c_; }
    __device__ bool next(int i, Unit& u) const {
        const long L = (long)i * G + c; if (L >= nwg) return false;
        int wgid = (int)L; { const int q = nwg / NXCD, r = nwg % NXCD, xcd = wgid % NXCD, off = wgid / NXCD; wgid = (xcd < r ? xcd * (q + 1) : r * (q + 1) + (xcd - r) * q) + off; }
        const int nig = WGM * nN, gid = wgid / nig, fm = gid * WGM, gsz = (nM - fm) < WGM ? (nM - fm) : WGM;
        u.pm = fm + ((wgid % nig) % gsz); u.pn = (wgid % nig) / gsz; u.pc = u.pn; return true;
    }
    __device__ __forceinline__ void a_ready(const Unit&) const {}
    __device__ __forceinline__ void done(const Unit&) const {}
};
struct GroupedOrder {
    const int* tile_e; int NT, npn, G, c;
    __device__ bool next(int i, Unit& u) const {
        const long L = (long)i * G + c; if (L >= (long)NT * npn) return false;
        const int t = (int)(L % NT), pnl = (int)(L / NT);
        const int e = __builtin_amdgcn_readfirstlane(tile_e[t]);
        u.pm = t; u.pn = e * npn + pnl; u.pc = pnl; return true;
    }
    __device__ __forceinline__ void a_ready(const Unit&) const {}
    __device__ __forceinline__ void done(const Unit&) const {}
};

struct EpiBf16 {
    static constexpr bool PERM = true;
    bf16_t* O; int ldc;
    __device__ __forceinline__ void operator()(const f32x4 (&acc)[2][2][4][2], const Unit& u, int wr, int wc, int fr, int fq) const {
        const int row0 = u.pm * BM + wr * 64 + fr, col0 = u.pc * BM + wc * 32 + 8 * fq;
#pragma unroll
        for (int ai = 0; ai < 2; ++ai)
#pragma unroll
            for (int m = 0; m < 4; ++m) { bf16_t* rowp = O + (size_t)(row0 + ai * HALF + m * 16) * ldc + col0;
#pragma unroll
                for (int bj = 0; bj < 2; ++bj) { const f32x4 v0 = acc[ai][bj][m][0], v1 = acc[ai][bj][m][1];
                    u32x4 w; w.x = cvt_pk_bf16(v0[0], v0[1]); w.y = cvt_pk_bf16(v0[2], v0[3]); w.z = cvt_pk_bf16(v1[0], v1[1]); w.w = cvt_pk_bf16(v1[2], v1[3]);
                    *(u32x4*)(rowp + bj * HALF) = w; } }
    }
};
struct EpiSwiGLU {
    static constexpr bool PERM = true;
    bf16_t* O; int ldc;
    __device__ __forceinline__ void operator()(const f32x4 (&acc)[2][2][4][2], const Unit& u, int wr, int wc, int fr, int fq) const {
        const int row0 = u.pm * BM + wr * 64 + fr, col0 = u.pc * HALF + wc * 32 + 8 * fq;
#pragma unroll
        for (int ai = 0; ai < 2; ++ai)
#pragma unroll
            for (int m = 0; m < 4; ++m) { bf16_t* rowp = O + (size_t)(row0 + ai * HALF + m * 16) * ldc + col0;
                float r[8];
#pragma unroll
                for (int n = 0; n < 2; ++n)
#pragma unroll
                    for (int j = 0; j < 4; ++j) { const float g = acc[ai][0][m][n][j], up = acc[ai][1][m][n][j]; r[n * 4 + j] = g * __builtin_amdgcn_rcpf(1.0f + __expf(-g)) * up; }
                u32x4 w; w.x = cvt_pk_bf16(r[0], r[1]); w.y = cvt_pk_bf16(r[2], r[3]); w.z = cvt_pk_bf16(r[4], r[5]); w.w = cvt_pk_bf16(r[6], r[7]);
                *(u32x4*)rowp = w; }
    }
};
struct EpiResF32 {
    static constexpr bool PERM = false;
    const float* res; float* out; int ldc;
    __device__ __forceinline__ void operator()(const f32x4 (&acc)[2][2][4][2], const Unit& u, int wr, int wc, int fr, int fq) const {
        const int row0 = u.pm * BM + wr * 64 + fr, col0 = u.pc * BM + wc * 32 + 4 * fq;
#pragma unroll
        for (int ai = 0; ai < 2; ++ai)
#pragma unroll
            for (int m = 0; m < 4; ++m) { const size_t off = (size_t)(row0 + ai * HALF + m * 16) * ldc + col0;
#pragma unroll
                for (int bj = 0; bj < 2; ++bj)
#pragma unroll
                    for (int n = 0; n < 2; ++n) { f32x4 v = acc[ai][bj][m][n]; if (res) v = v + *(const f32x4*)(res + off + bj * HALF + n * 16); *(f32x4*)(out + off + bj * HALF + n * 16) = v; } }
    }
};
struct EpiLora {
    static constexpr bool PERM = false;
    float* LWAG; const float* w0; const float* a0;
    __device__ __forceinline__ void operator()(const f32x4 (&acc)[2][2][4][2], const Unit& u, int wr, int wc, int fr, int fq) const {
        const int kind = u.pc >> 2; const int row0 = u.pm * BM + wr * 64 + fr, col0 = (u.pc & 3) * BM + wc * 32 + 4 * fq;
        float* dst = LWAG + (size_t)kind * ((size_t)8192 * 1024); const float* bias = kind == 0 ? w0 : a0;
#pragma unroll
        for (int bj = 0; bj < 2; ++bj)
#pragma unroll
            for (int n = 0; n < 2; ++n) { const int c = col0 + bj * HALF + n * 16; f32x4 bv = (f32x4){0.f, 0.f, 0.f, 0.f}; if (kind < 2) bv = *(const f32x4*)(bias + c);
#pragma unroll
                for (int ai = 0; ai < 2; ++ai)
#pragma unroll
                    for (int m = 0; m < 4; ++m) { f32x4 v = acc[ai][bj][m][n] + bv;
                        if (kind < 2) {
#pragma unroll
                            for (int j = 0; j < 4; ++j) { const float s = 1.0f / (1.0f + __expf(-v[j])); v[j] = kind == 0 ? (-0.6065306597126334f * s) : s; } }
                        *(f32x4*)(dst + (size_t)(row0 + ai * HALF + m * 16) * 1024 + c) = v; } }
    }
};

template <class Epi, class Sched, bool ALIGN_EPI, bool SP2>
__device__ __forceinline__ void gemm_phase(PG8_LAS unsigned char* lds, const Gemm g, const Sched& S, const Epi& E) {
    const int tid = threadIdx.x, wid = __builtin_amdgcn_readfirstlane(tid >> 6), lane = tid & 63, wr = wid >> 2, wc = wid & 3, fr = lane & 15, fq = lane >> 4;
    const int K = g.K, nt = K / BK;
    unsigned voffA[2], voffB[2];
#pragma unroll
    for (int i = 0; i < 2; ++i) { int R, C; stage_rc(tid * 16 + i * 8192, R, C); const int Rb = Epi::PERM ? ((R & ~31) + perm32(R & 31)) : R;
        voffA[i] = (unsigned)(R * K + C) * 2u; voffB[i] = (unsigned)(Rb * K + C) * 2u; }
    const size_t kstep = (size_t)(BK * 2);
    const size_t hstep = (size_t)HALF * K * 2;
    const size_t tstep = 2 * hstep;
    const unsigned ldsw = (unsigned)wid * 1024u;
    const int aoff = lds_byte(wr * 64 + fr, fq * 8), boff = lds_byte(wc * 32 + fr, fq * 8);
#define PG8_SA(b, h) (((b) * 2 + (h)) * HTB)
#define PG8_SB(b, h) ((4 + (b) * 2 + (h)) * HTB)
#define PG8_STAGE(bufoff, gbase, voff) do { _Pragma("unroll") for (int _i = 0; _i < 2; ++_i) \
        __builtin_amdgcn_global_load_lds((const unsigned*)((const char*)(gbase) + (voff)[_i]), (PG8_LAS unsigned*)(lds + (bufoff) + ldsw + _i * 8192), 16, 0, 0); } while (0)
#define PG8_LDA(dst, b, h) do { _Pragma("unroll") for (int m = 0; m < 4; ++m) _Pragma("unroll") for (int k = 0; k < 2; ++k) dst[m][k] = *(const PG8_LAS bf16x8*)(lds + PG8_SA(b, h) + aoff + m * 2048 + k * 1024); } while (0)
#define PG8_LDB(dst, b, h) do { _Pragma("unroll") for (int n = 0; n < 2; ++n) _Pragma("unroll") for (int k = 0; k < 2; ++k) dst[n][k] = *(const PG8_LAS bf16x8*)(lds + PG8_SB(b, h) + boff + n * 2048 + k * 1024); } while (0)
#define PG8_MMA(ai, bj, At, Bt) do { __builtin_amdgcn_s_setprio(1); _Pragma("unroll") for (int m = 0; m < 4; ++m) _Pragma("unroll") for (int n = 0; n < 2; ++n) _Pragma("unroll") for (int k = 0; k < 2; ++k) \
        acc[ai][bj][m][n] = __builtin_amdgcn_mfma_f32_16x16x32_bf16(Bt[n][k], At[m][k], acc[ai][bj][m][n], 0, 0, 0); __builtin_amdgcn_s_setprio(0); } while (0)
#define PG8_WAIT_V(n) asm volatile("s_waitcnt vmcnt(" #n ")" ::: "memory")
#define PG8_WAIT_L(n) asm volatile("s_waitcnt lgkmcnt(" #n ")" ::: "memory")
#define PG8_BAR __builtin_amdgcn_s_barrier()
#define PG8_SCHED __builtin_amdgcn_sched_barrier(0)
    Unit cur, nxt; int ui = 0;
    if (!S.next(0, cur)) return;
    f32x4 acc[2][2][4][2];
#pragma unroll
    for (int a = 0; a < 2; ++a)
#pragma unroll
        for (int b = 0; b < 2; ++b)
#pragma unroll
            for (int m = 0; m < 4; ++m)
#pragma unroll
                for (int n = 0; n < 2; ++n) acc[a][b][m][n] = (f32x4){0.f, 0.f, 0.f, 0.f};
    bf16x8 At[4][2], B0[2][2], B1[2][2];
    const char* cA = (const char*)g.A + (size_t)cur.pm * tstep; const char* cB = (const char*)g.Bt + (size_t)cur.pn * tstep;
    S.a_ready(cur);
    if constexpr (SP2) {
        PG8_STAGE(PG8_SB(0, 0), cB, voffB); PG8_STAGE(PG8_SB(0, 1), cB + hstep, voffB); PG8_STAGE(PG8_SA(0, 0), cA, voffA); PG8_STAGE(PG8_SA(0, 1), cA + hstep, voffA);
        if (wr == 1) PG8_BAR;
        PG8_WAIT_V(2); PG8_BAR;
        PG8_STAGE(PG8_SB(1, 0), cB + kstep, voffB); PG8_STAGE(PG8_SA(1, 0), cA + kstep, voffA); PG8_STAGE(PG8_SB(1, 1), cB + hstep + kstep, voffB);
        PG8_WAIT_V(6); PG8_BAR;
    } else {
        PG8_STAGE(PG8_SB(0, 0), cB, voffB); PG8_STAGE(PG8_SA(0, 0), cA, voffA); PG8_STAGE(PG8_SB(0, 1), cB + hstep, voffB); PG8_STAGE(PG8_SA(0, 1), cA + hstep, voffA);
        if (wr == 1) PG8_BAR;
        PG8_WAIT_V(4); PG8_BAR;
        PG8_STAGE(PG8_SB(1, 0), cB + kstep, voffB); PG8_STAGE(PG8_SA(1, 0), cA + kstep, voffA); PG8_STAGE(PG8_SB(1, 1), cB + hstep + kstep, voffB);
        PG8_WAIT_V(6); PG8_BAR;
    }
    for (;;) {
        const bool has_next = S.next(ui + 1, nxt);
        const char* nA = has_next ? (const char*)g.A + (size_t)nxt.pm * tstep : cA; const char* nB = has_next ? (const char*)g.Bt + (size_t)nxt.pn * tstep : cB;
        for (int t = 0; t < nt; t += 2) {
            const bool last = (t == nt - 2);
            const char* a1 = cA + (size_t)(t + 1) * kstep;
            const char* a2 = last ? nA : cA + (size_t)(t + 2) * kstep; const char* b2 = last ? nB : cB + (size_t)(t + 2) * kstep;
            const char* a3 = a2 + kstep; const char* b3 = b2 + kstep;
            if (last && has_next) S.a_ready(nxt);
            if constexpr (SP2) {
            PG8_LDB(B0, 0, 0); PG8_LDB(B1, 0, 1); PG8_SCHED; PG8_LDA(At, 0, 0); PG8_STAGE(PG8_SA(1, 1), a1 + hstep, voffA);
            PG8_WAIT_V(8); PG8_WAIT_L(0); PG8_BAR; PG8_MMA(0, 0, At, B0); PG8_MMA(0, 1, At, B1); PG8_BAR; PG8_SCHED;
            PG8_LDA(At, 0, 1); PG8_STAGE(PG8_SB(0, 0), b2, voffB); PG8_STAGE(PG8_SB(0, 1), b2 + hstep, voffB); PG8_STAGE(PG8_SA(0, 0), a2, voffA);
            PG8_WAIT_V(8); PG8_WAIT_L(0); PG8_BAR; PG8_MMA(1, 0, At, B0); PG8_MMA(1, 1, At, B1); PG8_BAR; PG8_SCHED;
            PG8_LDB(B0, 1, 0); PG8_LDB(B1, 1, 1); PG8_SCHED; PG8_LDA(At, 1, 0); PG8_STAGE(PG8_SA(0, 1), a2 + hstep, voffA);
            PG8_WAIT_V(8); PG8_WAIT_L(0); PG8_BAR; PG8_MMA(0, 0, At, B0); PG8_MMA(0, 1, At, B1); PG8_BAR; PG8_SCHED;
            PG8_LDA(At, 1, 1); PG8_STAGE(PG8_SB(1, 0), b3, voffB); PG8_STAGE(PG8_SB(1, 1), b3 + hstep, voffB); PG8_STAGE(PG8_SA(1, 0), a3, voffA);
            PG8_WAIT_V(8); PG8_WAIT_L(0); PG8_BAR; PG8_MMA(1, 0, At, B0); PG8_MMA(1, 1, At, B1); PG8_BAR; PG8_SCHED;
            } else {
            PG8_LDB(B0, 0, 0); PG8_SCHED; PG8_LDA(At, 0, 0); PG8_STAGE(PG8_SA(1, 1), a1 + hstep, voffA);
            PG8_WAIT_L(8); PG8_BAR; PG8_WAIT_L(0); PG8_MMA(0, 0, At, B0); PG8_BAR; PG8_SCHED;
            PG8_LDB(B1, 0, 1); PG8_STAGE(PG8_SB(0, 0), b2, voffB);
            PG8_BAR; PG8_WAIT_L(0); PG8_MMA(0, 1, At, B1); PG8_BAR;
            PG8_LDA(At, 0, 1); PG8_STAGE(PG8_SA(0, 0), a2, voffA);
            PG8_BAR; PG8_WAIT_L(0); PG8_MMA(1, 0, At, B0); PG8_BAR; PG8_SCHED;
            PG8_STAGE(PG8_SB(0, 1), b2 + hstep, voffB);
            PG8_WAIT_V(6); PG8_BAR; PG8_MMA(1, 1, At, B1); PG8_BAR;
            PG8_LDB(B0, 1, 0); PG8_SCHED; PG8_LDA(At, 1, 0); PG8_STAGE(PG8_SA(0, 1), a2 + hstep, voffA);
            PG8_WAIT_L(8); PG8_BAR; PG8_WAIT_L(0); PG8_MMA(0, 0, At, B0); PG8_BAR; PG8_SCHED;
            PG8_LDB(B1, 1, 1); PG8_STAGE(PG8_SB(1, 0), b3, voffB);
            PG8_BAR; PG8_WAIT_L(0); PG8_MMA(0, 1, At, B1); PG8_BAR;
            PG8_LDA(At, 1, 1); PG8_STAGE(PG8_SA(1, 0), a3, voffA);
            PG8_BAR; PG8_WAIT_L(0); PG8_MMA(1, 0, At, B0); PG8_BAR; PG8_SCHED;
            PG8_STAGE(PG8_SB(1, 1), b3 + hstep, voffB);
            PG8_WAIT_V(6); PG8_BAR; PG8_MMA(1, 1, At, B1); PG8_BAR;
            }
        }
        if constexpr (ALIGN_EPI) { if (wr == 0) PG8_BAR; }
        E(acc, cur, wr, wc, fr, fq); S.done(cur);
        if (!has_next) break;
#pragma unroll
        for (int a = 0; a < 2; ++a)
#pragma unroll
            for (int b = 0; b < 2; ++b)
#pragma unroll
                for (int m = 0; m < 4; ++m)
#pragma unroll
                    for (int n = 0; n < 2; ++n) acc[a][b][m][n] = (f32x4){0.f, 0.f, 0.f, 0.f};
        cur = nxt; cA = nA; cB = nB; ++ui;
        if constexpr (ALIGN_EPI) { if (wr == 1) PG8_BAR; }
    }
    PG8_WAIT_V(0);
    if constexpr (!ALIGN_EPI) { if (wr == 0) PG8_BAR; }
    PG8_BAR;
#undef PG8_SA
#undef PG8_SB
#undef PG8_STAGE
#undef PG8_LDA
#undef PG8_LDB
#undef PG8_MMA
#undef PG8_WAIT_V
#undef PG8_WAIT_L
#undef PG8_BAR
#undef PG8_SCHED
}
}

#define XB_TMO      128
#define XB_XCNT(j)  (256  + 64 * (j))
#define XB_XSUB(j)  (1280 + 64 * (j))
#define XB_XGEN(j)  (2304 + 64 * (j))
#define XB_TOP      3328
#define XB_TOPGEN   3392
#define XCD_BAR_WORDS 3456
#define XB_SPIN_CAP (1u << 18)
__device__ __forceinline__ unsigned xb_ld(unsigned* p)              { return __hip_atomic_load(p, __ATOMIC_RELAXED, __HIP_MEMORY_SCOPE_AGENT); }
__device__ __forceinline__ unsigned xb_add(unsigned* p, unsigned v) { return __hip_atomic_fetch_add(p, v, __ATOMIC_RELAXED, __HIP_MEMORY_SCOPE_AGENT); }
__device__ __forceinline__ unsigned xb_xcc_id() { return (unsigned)__builtin_amdgcn_s_getreg((3 << 11) | 20) & 0xFu; }
#define XB_SPIN(cond, bar) do { unsigned _sp = 0; while (cond) { __builtin_amdgcn_s_sleep(1); \
    if ((++_sp & 255u) == 0u) { if (xb_ld(&(bar)[XB_TMO])) break; if (_sp > XB_SPIN_CAP) { atomicAdd(&(bar)[XB_TMO], 1u); break; } } } } while (0)
struct XcdBarrier { unsigned* bar; unsigned x; volatile LAS unsigned* st; };
__device__ __forceinline__ XcdBarrier xcd_barrier_post(unsigned* bar, volatile LAS unsigned* st) {
    XcdBarrier b; b.bar = bar; b.x = xb_xcc_id(); b.st = st;
    if (threadIdx.x == 0) (void)xb_add(&bar[XB_XCNT(b.x)], 1u);
    return b;
}
__device__ __forceinline__ void xcd_barrier_complete(unsigned* bar, unsigned x, unsigned& nloc, unsigned& nx) {
    const unsigned G = gridDim.x * gridDim.y * gridDim.z;
    unsigned sum, cnt, mine, sp = 0u;
    for (;;) {
        sum = 0u; cnt = 0u; mine = 0u;
#pragma unroll
        for (unsigned j = 0; j < 16; ++j) { const unsigned c = xb_ld(&bar[XB_XCNT(j)]); sum += c; cnt += (c > 0u) ? 1u : 0u; mine = (j == x) ? c : mine; }
        if (sum == G) break;
        __builtin_amdgcn_s_sleep(1);
        if ((++sp & 255u) == 0u) { if (xb_ld(&bar[XB_TMO])) break; if (sp > XB_SPIN_CAP) { atomicAdd(&bar[XB_TMO], 1u); break; } }
    }
    nloc = mine > 0u ? mine : 1u; nx = cnt > 0u ? cnt : 1u;
}
__device__ __forceinline__ void xcd_barrier(const XcdBarrier& b) {
    asm volatile("s_waitcnt vmcnt(0)" ::: "memory");
    __syncthreads();
    if (threadIdx.x == 0) {
        unsigned* bar = b.bar;
        __builtin_amdgcn_s_waitcnt(0);
        unsigned nloc = b.st[0], nx = b.st[1];
        if (nloc == 0u) { xcd_barrier_complete(bar, b.x, nloc, nx); b.st[0] = nloc; b.st[1] = nx; }
        const unsigned old = xb_add(&bar[XB_XSUB(b.x)], 1u);
        const unsigned gen = old / nloc;
        if (old + 1u == (gen + 1u) * nloc) {
            __builtin_amdgcn_fence(__ATOMIC_RELEASE, "agent");
            asm volatile("s_waitcnt vmcnt(0)" ::: "memory");
            const unsigned og = xb_add(&bar[XB_TOP], 1u);
            const unsigned tg = og / nx;
            if (og + 1u == (tg + 1u) * nx) xb_add(&bar[XB_TOPGEN], 1u);
            else XB_SPIN(xb_ld(&bar[XB_TOPGEN]) == tg, bar);
            __builtin_amdgcn_fence(__ATOMIC_ACQUIRE, "agent");
            xb_add(&bar[XB_XGEN(b.x)], 1u);
            asm volatile("s_waitcnt vmcnt(0)" ::: "memory");
        } else {
            XB_SPIN(xb_ld(&bar[XB_XGEN(b.x)]) == gen, bar);
            __builtin_amdgcn_fence(__ATOMIC_ACQUIRE, "agent");
            asm volatile("s_waitcnt vmcnt(0)" ::: "memory");
        }
    }
    __syncthreads();
}

struct Ctx { LAS unsigned char* lds; int tid, lane, wave, bid, G; };

__device__ __forceinline__ void conv_tile(const float* W, int K, int N, bf16* WT, int mode, int kt, int ntile, LAS float* scr, int tid) {
    const int k0 = kt * 64, n0 = ntile * 64;
    { const int n = tid & 63, kq = tid >> 6;
#pragma unroll
      for (int i = 0; i < 8; ++i) { const int kk = kq + 8 * i; scr[kk * 65 + n] = (n0 + n < N) ? W[(size_t)(k0 + kk) * N + n0 + n] : 0.f; } }
    __syncthreads();
    { const int nn = tid >> 3, kc = tid & 7; float v[8];
#pragma unroll
      for (int j = 0; j < 8; ++j) v[j] = scr[(kc * 8 + j) * 65 + nn];
      const int ns = n0 + nn; const int drow = mode == 0 ? ns : ((ns >> 7) * 256 + (ns & 127) + (mode == 2 ? 128 : 0));
      v4u o; o.x = cvt_pk_bf16(v[0], v[1]); o.y = cvt_pk_bf16(v[2], v[3]); o.z = cvt_pk_bf16(v[4], v[5]); o.w = cvt_pk_bf16(v[6], v[7]);
      *(v4u*)(WT + (size_t)drow * K + k0 + kc * 8) = o; }
    __syncthreads();
}
__device__ __forceinline__ void conv_kind(const Ctx& c, const float* W, int K, int N, int Npad, bf16* WT, int mode, int nmat, size_t sstr, size_t dstr, int& base) {
    const int nkt = K / 64, nnt = Npad / 64, per = nkt * nnt, count = per * nmat;
    LAS float* scr = (LAS float*)c.lds;
    int first = (c.bid - base % c.G + c.G) % c.G;
    for (int it = first; it < count; it += c.G) {
        const int mat = it / per, r = it % per, kt = r / nnt, ntile = r % nnt;
        conv_tile(W + (size_t)mat * sstr, K, N, WT + (size_t)mat * dstr, mode, kt, ntile, scr, c.tid);
    }
    base += count;
}
__device__ __forceinline__ void rmsnorm_row_bf16(const float* xr, const float* w, bf16* orow, int lane) {
    f32x4 v[8]; float ss = 0.f;
#pragma unroll
    for (int j = 0; j < 8; ++j) { v[j] = *(const f32x4*)(xr + 4 * lane + 256 * j); ss += (v[j].x * v[j].x + v[j].y * v[j].y) + (v[j].z * v[j].z + v[j].w * v[j].w); }
    const float rs = 1.0f / sqrtf(wave_sum(ss) * (1.0f / 2048.0f) + 1e-6f);
#pragma unroll
    for (int j = 0; j < 8; ++j) { const f32x4 wv = *(const f32x4*)(w + 4 * lane + 256 * j); const f32x4 o = v[j] * rs * wv;
        v2u p; p.x = cvt_pk_bf16(o.x, o.y); p.y = cvt_pk_bf16(o.z, o.w); *(v2u*)(orow + 4 * lane + 256 * j) = p; }
}
__device__ __forceinline__ void rmsnorm_phase(const Ctx& c, const float* X, const float* w, bf16* XN) {
    const int gw = c.bid * 8 + c.wave, NGW = c.G * 8;
    for (int m = gw; m < M_TOK; m += NGW) rmsnorm_row_bf16(X + (size_t)m * DM, w, XN + (size_t)m * DM, c.lane);
}

__device__ __forceinline__ LAS unsigned char* launder_lds(LAS unsigned char* p) {
#if defined(__HIP_DEVICE_COMPILE__)
    unsigned v = __builtin_bit_cast(unsigned, p); asm volatile("" : "+v"(v)); return __builtin_bit_cast(LAS unsigned char*, v);
#else
    return p;
#endif
}
__device__ __forceinline__ bf16x8 frag_row(const LAS bf16* img, int stride, int r0, int k0, int lane) { return *(const LAS bf16x8*)(img + (r0 + (lane & 15)) * stride + k0 + 8 * (lane >> 4)); }
typedef short s16x4 __attribute__((ext_vector_type(4)));
__device__ __forceinline__ bf16x8 frag_tr(const LAS bf16* img, int stride, int n0, int k0, int lane) {
    const int g = lane >> 4, qq = (lane & 15) >> 2, pp = lane & 3;
    const LAS bf16* p0 = img + (k0 + 8 * g + qq) * stride + n0 + 4 * pp;
#if defined(__HIP_DEVICE_COMPILE__)
    const s16x4 lo = __builtin_amdgcn_ds_read_tr16_b64_v4i16((LAS s16x4*)p0), hi = __builtin_amdgcn_ds_read_tr16_b64_v4i16((LAS s16x4*)(p0 + 4 * stride));
#else
    const s16x4 lo = (s16x4){0, 0, 0, 0}, hi = lo; (void)p0;
#endif
    return (bf16x8){lo.x, lo.y, lo.z, lo.w, hi.x, hi.y, hi.z, hi.w};
}
__device__ __forceinline__ v4u pack8(const f32x4 a, const f32x4 b) { v4u o; o.x = cvt_pk_bf16(a[0], a[1]); o.y = cvt_pk_bf16(a[2], a[3]); o.z = cvt_pk_bf16(b[0], b[1]); o.w = cvt_pk_bf16(b[2], b[3]); return o; }
__device__ __forceinline__ float softplusf_(float x) { return x > 20.0f ? x : log1pf(__expf(x)); }

template <bool ML>
__device__ __forceinline__ void chunk_scan(const Ctx& c, int task, const bf16* U, const float* SRC, const float* par0, const float* par1, const float* par2, float* OUTP, float* DEN) {
    constexpr int NP = ML ? 5 : 4, SX = 88, S1 = 136, SM = 72, UP = ML ? EVP : ODP;
    int batch, head, slice;
    if (ML) { slice = task & 3; head = (task >> 2) & 3; batch = task >> 4; } else { slice = 0; head = task & 15; batch = task >> 4; }
    const int lane = c.lane, w = c.wave, r = lane & 15, q = lane >> 4, trow = c.tid >> 3, part = c.tid & 7;
    const float g0 = ML ? par0[head] : par0[head];
    const float g1 = ML ? par1[head] : -__expf(par1[head]);
    const float Dh = ML ? 0.f : par2[head];
    const int qoff = ML ? head * 128 : 1536 + (head >> 2) * 128, koff = ML ? 512 + head * 128 : 1024 + (head >> 2) * 128, srcw = ML ? 1024 : 2048;
    f32x4 Hacc[NP];
#pragma unroll
    for (int i = 0; i < NP; ++i) Hacc[i] = (f32x4){0.f, 0.f, 0.f, 0.f};
    f32x4 rc[4], rb[4], rx[2]; v4u rv; float gr0, gr1;
#define CS_LOAD(ch) do { const size_t m_ = (size_t)batch * SEQ + (ch) * 64 + trow; const float* sr_ = SRC + m_ * srcw; \
        _Pragma("unroll") for (int i_ = 0; i_ < 4; ++i_) { rc[i_] = *(const f32x4*)(sr_ + qoff + 16 * part + 4 * i_); rb[i_] = *(const f32x4*)(sr_ + koff + 16 * part + 4 * i_); } \
        if (ML) rv = *(const v4u*)(U + m_ * UP + 4544 + head * 256 + slice * 64 + 8 * part); else { rx[0] = *(const f32x4*)(sr_ + head * 64 + 8 * part); rx[1] = *(const f32x4*)(sr_ + head * 64 + 8 * part + 4); } \
        const bf16* ug_ = U + ((size_t)batch * SEQ + (ch) * 64 + lane) * UP; \
        if (ML) { gr0 = bf2f(ug_[6592 + head]); gr1 = bf2f(ug_[6596 + head]); } else { gr0 = bf2f(ug_[7168 + head]); gr1 = 0.f; } } while (0)
    CS_LOAD(0);
    for (int ch = 0; ch < 32; ++ch) {
        LAS bf16* Cb = (LAS bf16*)launder_lds(c.lds); LAS bf16* Bb = Cb + 64 * S1; LAS bf16* Ce = Bb + 64 * S1; LAS bf16* Hb = Ce + 64 * S1; LAS bf16* Xs = Hb + 80 * S1; LAS bf16* Xw = Xs + 64 * SX; LAS bf16* Mm = Xw + 64 * SX;
        LAS float* cumL = (LAS float*)(Mm + 64 * SM); LAS float* wL = cumL + 64;
        float a_t, wgt;
        if (ML) { wgt = __expf(gr0 + g0); a_t = -softplusf_(-(gr1 + g1)); } else { wgt = softplusf_(gr0 + g0); a_t = g1 * wgt; }
        float cum = a_t;
#pragma unroll
        for (int o = 1; o < 64; o <<= 1) { const float v_ = __shfl_up(cum, o); if (lane >= o) cum += v_; }
        const float gtot = __shfl(cum, 63);
        const float cum_t = __shfl(cum, trow), w_t = __shfl(wgt, trow);
        { const float sc = ML ? 0.08838834764831845f : 1.0f; const float et = __expf(cum_t) * sc, wx = w_t * __expf(gtot - cum_t);
          *(v4u*)(Cb + trow * S1 + 16 * part) = pack8(rc[0] * sc, rc[1] * sc); *(v4u*)(Cb + trow * S1 + 16 * part + 8) = pack8(rc[2] * sc, rc[3] * sc);
          *(v4u*)(Ce + trow * S1 + 16 * part) = pack8(rc[0] * et, rc[1] * et); *(v4u*)(Ce + trow * S1 + 16 * part + 8) = pack8(rc[2] * et, rc[3] * et);
          *(v4u*)(Bb + trow * S1 + 16 * part) = pack8(rb[0], rb[1]); *(v4u*)(Bb + trow * S1 + 16 * part + 8) = pack8(rb[2], rb[3]);
          f32x4 x0, x1;
          if (ML) { x0 = (f32x4){__uint_as_float(rv.x << 16), __uint_as_float(rv.x & 0xffff0000u), __uint_as_float(rv.y << 16), __uint_as_float(rv.y & 0xffff0000u)};
                    x1 = (f32x4){__uint_as_float(rv.z << 16), __uint_as_float(rv.z & 0xffff0000u), __uint_as_float(rv.w << 16), __uint_as_float(rv.w & 0xffff0000u)}; }
          else { x0 = rx[0]; x1 = rx[1]; }
          *(v4u*)(Xs + trow * SX + 8 * part) = pack8(x0, x1); *(v4u*)(Xw + trow * SX + 8 * part) = pack8(x0 * wx, x1 * wx);
          if (ML && part == 0) { const f32x4 z = (f32x4){0.f, 0.f, 0.f, 0.f};
              *(v4u*)(Xs + trow * SX + 64) = pack8((f32x4){1.f, 0.f, 0.f, 0.f}, z); *(v4u*)(Xs + trow * SX + 72) = pack8(z, z);
              *(v4u*)(Xw + trow * SX + 64) = pack8((f32x4){wx, 0.f, 0.f, 0.f}, z); *(v4u*)(Xw + trow * SX + 72) = pack8(z, z); }
#pragma unroll
          for (int pt = 0; pt < NP; ++pt) { v2u hp; hp.x = cvt_pk_bf16(Hacc[pt][0], Hacc[pt][1]); hp.y = cvt_pk_bf16(Hacc[pt][2], Hacc[pt][3]); *(v2u*)(Hb + (16 * pt + r) * S1 + 16 * w + 4 * q) = hp; }
          if (w == 0) { cumL[lane] = cum; wL[lane] = wgt; } }
        if (ch + 1 < 32) CS_LOAD(ch + 1);
        __syncthreads();
        { const int tt = w >> 1;
#pragma unroll
          for (int i = 0; i < 2; ++i) { const int ts = 2 * (w & 1) + i; f32x4 acc = (f32x4){0.f, 0.f, 0.f, 0.f};
              if (ts <= tt) {
#pragma unroll
                  for (int kk = 0; kk < 4; ++kk) acc = __builtin_amdgcn_mfma_f32_16x16x32_bf16(frag_row(Bb, S1, 16 * ts, 32 * kk, lane), frag_row(Cb, S1, 16 * tt, 32 * kk, lane), acc, 0, 0, 0);
                  const int t = 16 * tt + r; const float ct = cumL[t];
#pragma unroll
                  for (int j = 0; j < 4; ++j) { const int sj = 16 * ts + 4 * q + j; acc[j] = (sj <= t) ? acc[j] * __expf(ct - cumL[sj]) * wL[sj] : 0.f; } }
              v2u mp; mp.x = cvt_pk_bf16(acc[0], acc[1]); mp.y = cvt_pk_bf16(acc[2], acc[3]); *(v2u*)(Mm + (16 * tt + r) * SM + 16 * ts + 4 * q) = mp; }
          const float eg = __expf(gtot);
#pragma unroll
          for (int pt = 0; pt < NP; ++pt) Hacc[pt] = Hacc[pt] * eg;
#pragma unroll
          for (int ks = 0; ks < 2; ++ks) { const bf16x8 af = frag_tr(Bb, S1, 16 * w, 32 * ks, lane);
#pragma unroll
              for (int pt = 0; pt < NP; ++pt) Hacc[pt] = __builtin_amdgcn_mfma_f32_16x16x32_bf16(af, frag_tr(Xw, SX, 16 * pt, 32 * ks, lane), Hacc[pt], 0, 0, 0); } }
        __syncthreads();
        { const int tt = w >> 1, half = w & 1; const size_t mrow = (size_t)batch * SEQ + ch * 64 + 16 * tt + r;
#pragma unroll
          for (int i = 0; i < 3; ++i) { const int pt = half ? 2 + i : (i < 2 ? i : 4); if ((half && i == 2) || (!ML && i == 2)) continue;
              f32x4 acc = (f32x4){0.f, 0.f, 0.f, 0.f};
#pragma unroll
              for (int ks = 0; ks < 2; ++ks) acc = __builtin_amdgcn_mfma_f32_16x16x32_bf16(frag_tr(Xs, SX, 16 * pt, 32 * ks, lane), frag_row(Mm, SM, 16 * tt, 32 * ks, lane), acc, 0, 0, 0);
#pragma unroll
              for (int kk = 0; kk < 4; ++kk) acc = __builtin_amdgcn_mfma_f32_16x16x32_bf16(frag_row(Hb, S1, 16 * pt, 32 * kk, lane), frag_row(Ce, S1, 16 * tt, 32 * kk, lane), acc, 0, 0, 0);
              if (ML) { if (pt < 4) *(f32x4*)(OUTP + mrow * 1024 + head * 256 + slice * 64 + 16 * pt + 4 * q) = acc; else if (q == 0 && slice == 0) DEN[mrow * 4 + head] = acc[0]; }
              else { const v2u xv = *(const LAS v2u*)(Xs + (16 * tt + r) * SX + 16 * pt + 4 * q);
                     acc[0] += Dh * __uint_as_float(xv.x << 16); acc[1] += Dh * __uint_as_float(xv.x & 0xffff0000u); acc[2] += Dh * __uint_as_float(xv.y << 16); acc[3] += Dh * __uint_as_float(xv.y & 0xffff0000u);
                     *(f32x4*)(OUTP + mrow * 1024 + head * 64 + 16 * pt + 4 * q) = acc; } } }
        __syncthreads();
    }
#undef CS_LOAD
}


__device__ __forceinline__ void chunk_hgrn(const Ctx& c, int task, const bf16* U, const float* lbl, float* ORAW) {
    constexpr int S1 = 136, SX = 72, SM = 72, LFS = 132;
    const int slice = task & 1, head = (task >> 1) & 7, batch = task >> 4;
    constexpr int LBL_OFF = (3 * 64 * S1 + 64 * SX + 64 * SM) * 2 + (64 * LFS + 512) * 4;
    { LAS float* LBL0 = (LAS float*)(c.lds + LBL_OFF); if (c.tid < 128) { const int a = head * 128 + c.tid; LBL0[c.tid] = 1.0f / (1.0f + __expf(lbl[a] - lbl[1024 + a])); } }
    const int lane = c.lane, w = c.wave, r = lane & 15, q = lane >> 4, trow = c.tid >> 3, part = c.tid & 7;
    f32x4 Hacc[4];
#pragma unroll
    for (int i = 0; i < 4; ++i) Hacc[i] = (f32x4){0.f, 0.f, 0.f, 0.f};
    v4u rq[2], rf[2], ri;
#define HG_LOAD(ch) do { const bf16* ur_ = U + ((size_t)batch * SEQ + (ch) * 64 + trow) * ODP; \
        rq[0] = *(const v4u*)(ur_ + head * 128 + 16 * part); rq[1] = *(const v4u*)(ur_ + head * 128 + 16 * part + 8); \
        rf[0] = *(const v4u*)(ur_ + 1024 + head * 128 + 16 * part); rf[1] = *(const v4u*)(ur_ + 1024 + head * 128 + 16 * part + 8); \
        ri = *(const v4u*)(ur_ + 2048 + head * 128 + slice * 64 + 8 * part); } while (0)
#define HG_UNPK(dst, src) do { dst[0] = __uint_as_float((src).x << 16); dst[1] = __uint_as_float((src).x & 0xffff0000u); dst[2] = __uint_as_float((src).y << 16); dst[3] = __uint_as_float((src).y & 0xffff0000u); \
        dst[4] = __uint_as_float((src).z << 16); dst[5] = __uint_as_float((src).z & 0xffff0000u); dst[6] = __uint_as_float((src).w << 16); dst[7] = __uint_as_float((src).w & 0xffff0000u); } while (0)
    HG_LOAD(0);
    __syncthreads();
    for (int ch = 0; ch < 32; ++ch) {
        LAS bf16* Qi = (LAS bf16*)launder_lds(c.lds); LAS bf16* Ki = Qi + 64 * S1; LAS bf16* Hb = Ki + 64 * S1; LAS bf16* Xs = Hb + 64 * S1; LAS bf16* Mm = Xs + 64 * SX;
        LAS float* LF = (LAS float*)(Mm + 64 * SM); LAS float* SEGT = LF + 64 * LFS; LAS float* LBL = SEGT + 512;
#pragma unroll
        for (int h2 = 0; h2 < 2; ++h2) { float fp[8]; HG_UNPK(fp, rf[h2]);
            const f32x4 b0 = *(const LAS f32x4*)(LBL + 16 * part + 8 * h2), b1 = *(const LAS f32x4*)(LBL + 16 * part + 8 * h2 + 4); float lf[8];
#pragma unroll
            for (int j = 0; j < 8; ++j) { const float lbv = j < 4 ? b0[j & 3] : b1[j & 3]; lf[j] = __logf(lbv + (1.0f - lbv) * sigmoidf_(fp[j])); }
            *(LAS f32x4*)(LF + trow * LFS + 16 * part + 8 * h2) = (f32x4){lf[0], lf[1], lf[2], lf[3]}; *(LAS f32x4*)(LF + trow * LFS + 16 * part + 8 * h2 + 4) = (f32x4){lf[4], lf[5], lf[6], lf[7]}; }
        __syncthreads();
        { const int k = c.tid & 127, seg = c.tid >> 7; float run = 0.f;
#pragma unroll
          for (int i = 0; i < 16; ++i) { run += LF[(16 * seg + i) * LFS + k]; LF[(16 * seg + i) * LFS + k] = run; }
          SEGT[seg * 128 + k] = run; }
        __syncthreads();
        { const int seg = trow >> 4;
#pragma unroll
          for (int h2 = 0; h2 < 2; ++h2) { float fp[8], qr[8], qt[8], kt[8]; HG_UNPK(fp, rf[h2]); HG_UNPK(qr, rq[h2]);
#pragma unroll
              for (int j4 = 0; j4 < 2; ++j4) { const int kb = 16 * part + 8 * h2 + 4 * j4;
                  const f32x4 l = *(const LAS f32x4*)(LF + trow * LFS + kb), l31 = *(const LAS f32x4*)(LF + 31 * LFS + kb), bb = *(const LAS f32x4*)(LBL + kb);
                  const f32x4 s0 = *(const LAS f32x4*)(SEGT + kb), s1 = *(const LAS f32x4*)(SEGT + 128 + kb), s2 = *(const LAS f32x4*)(SEGT + 256 + kb);
#pragma unroll
                  for (int e = 0; e < 4; ++e) { float off = 0.f; if (seg > 0) off += s0[e]; if (seg > 1) off += s1[e]; if (seg > 2) off += s2[e];
                      const float d = (l[e] + off) - (l31[e] + s0[e]); const int j = 4 * j4 + e;
                      qt[j] = siluf_(qr[j]) * __expf(d); kt[j] = (1.0f - bb[e]) * (1.0f - sigmoidf_(fp[j])) * __expf(-d); } }
              *(v4u*)(Qi + trow * S1 + 16 * part + 8 * h2) = pack8((f32x4){qt[0], qt[1], qt[2], qt[3]}, (f32x4){qt[4], qt[5], qt[6], qt[7]});
              *(v4u*)(Ki + trow * S1 + 16 * part + 8 * h2) = pack8((f32x4){kt[0], kt[1], kt[2], kt[3]}, (f32x4){kt[4], kt[5], kt[6], kt[7]}); }
          *(v4u*)(Xs + trow * SX + 8 * part) = ri; }
        float eg[4], egr[4];
        { const int kb = 16 * w + 4 * q;
          const f32x4 l31 = *(const LAS f32x4*)(LF + 31 * LFS + kb), l63 = *(const LAS f32x4*)(LF + 63 * LFS + kb);
          const f32x4 s0 = *(const LAS f32x4*)(SEGT + kb), s1 = *(const LAS f32x4*)(SEGT + 128 + kb), s2 = *(const LAS f32x4*)(SEGT + 256 + kb);
          float er[4];
#pragma unroll
          for (int j = 0; j < 4; ++j) { const float rf_ = l31[j] + s0[j], g_ = l63[j] + s0[j] + s1[j] + s2[j]; er[j] = __expf(rf_); eg[j] = __expf(g_); egr[j] = __expf(g_ - rf_); }
#pragma unroll
          for (int pt = 0; pt < 4; ++pt) { v2u hp; hp.x = cvt_pk_bf16(Hacc[pt][0] * er[0], Hacc[pt][1] * er[1]); hp.y = cvt_pk_bf16(Hacc[pt][2] * er[2], Hacc[pt][3] * er[3]); *(v2u*)(Hb + (16 * pt + r) * S1 + 16 * w + 4 * q) = hp; } }
        if (ch + 1 < 32) HG_LOAD(ch + 1);
        __syncthreads();
        { const int tt = w >> 1;
#pragma unroll
          for (int i = 0; i < 2; ++i) { const int ts = 2 * (w & 1) + i; f32x4 acc = (f32x4){0.f, 0.f, 0.f, 0.f};
              if (ts <= tt) {
#pragma unroll
                  for (int k4 = 0; k4 < 4; ++k4) acc = __builtin_amdgcn_mfma_f32_16x16x32_bf16(frag_row(Ki, S1, 16 * ts, 32 * k4, lane), frag_row(Qi, S1, 16 * tt, 32 * k4, lane), acc, 0, 0, 0);
                  const int t = 16 * tt + r;
#pragma unroll
                  for (int j = 0; j < 4; ++j) { const int sj = 16 * ts + 4 * q + j; acc[j] = (sj <= t) ? acc[j] : 0.f; } }
              v2u mp; mp.x = cvt_pk_bf16(acc[0], acc[1]); mp.y = cvt_pk_bf16(acc[2], acc[3]); *(v2u*)(Mm + (16 * tt + r) * SM + 16 * ts + 4 * q) = mp; }
          f32x4 tmp[4];
#pragma unroll
          for (int pt = 0; pt < 4; ++pt) tmp[pt] = (f32x4){0.f, 0.f, 0.f, 0.f};
#pragma unroll
          for (int ks = 0; ks < 2; ++ks) { const bf16x8 af = frag_tr(Ki, S1, 16 * w, 32 * ks, lane);
#pragma unroll
              for (int pt = 0; pt < 4; ++pt) tmp[pt] = __builtin_amdgcn_mfma_f32_16x16x32_bf16(af, frag_tr(Xs, SX, 16 * pt, 32 * ks, lane), tmp[pt], 0, 0, 0); }
#pragma unroll
          for (int pt = 0; pt < 4; ++pt)
#pragma unroll
              for (int j = 0; j < 4; ++j) Hacc[pt][j] = eg[j] * Hacc[pt][j] + egr[j] * tmp[pt][j]; }
        __syncthreads();
        { const int tt = w >> 1; const size_t mrow = (size_t)batch * SEQ + ch * 64 + 16 * tt + r;
#pragma unroll
          for (int i = 0; i < 2; ++i) { const int pt = 2 * (w & 1) + i; f32x4 acc = (f32x4){0.f, 0.f, 0.f, 0.f};
#pragma unroll
              for (int ks = 0; ks < 2; ++ks) acc = __builtin_amdgcn_mfma_f32_16x16x32_bf16(frag_tr(Xs, SX, 16 * pt, 32 * ks, lane), frag_row(Mm, SM, 16 * tt, 32 * ks, lane), acc, 0, 0, 0);
#pragma unroll
              for (int k4 = 0; k4 < 4; ++k4) acc = __builtin_amdgcn_mfma_f32_16x16x32_bf16(frag_row(Hb, S1, 16 * pt, 32 * k4, lane), frag_row(Qi, S1, 16 * tt, 32 * k4, lane), acc, 0, 0, 0);
              *(f32x4*)(ORAW + mrow * 1024 + head * 128 + slice * 64 + 16 * pt + 4 * q) = acc; } }
        __syncthreads();
    }
#undef HG_LOAD
#undef HG_UNPK
}


constexpr int RST = 72;
__device__ __forceinline__ void tile_store(LAS bf16* img, int rt, int ct, const f32x4 a, int lane) { v2u p; p.x = cvt_pk_bf16(a[0], a[1]); p.y = cvt_pk_bf16(a[2], a[3]); *(LAS v2u*)(img + (16 * rt + (lane & 15)) * RST + 16 * ct + 4 * (lane >> 4)) = p; }
__device__ __forceinline__ f32x4 tile_load(const LAS bf16* img, int rt, int ct, int lane) { const v2u p = *(const LAS v2u*)(img + (16 * rt + (lane & 15)) * RST + 16 * ct + 4 * (lane >> 4));
    return (f32x4){__uint_as_float(p.x << 16), __uint_as_float(p.x & 0xffff0000u), __uint_as_float(p.y << 16), __uint_as_float(p.y & 0xffff0000u)}; }
__device__ __forceinline__ f32x4 mm_xy(const LAS bf16* X, const LAS bf16* Y, int rt, int ct, f32x4 acc, int lane) {
#pragma unroll
    for (int ks = 0; ks < 2; ++ks) acc = __builtin_amdgcn_mfma_f32_16x16x32_bf16(frag_tr(Y, RST, 16 * ct, 32 * ks, lane), frag_row(X, RST, 16 * rt, 32 * ks, lane), acc, 0, 0, 0);
    return acc; }
__device__ __forceinline__ f32x4 mm_xty(const LAS bf16* X, const LAS bf16* Y, int rt, int ct, f32x4 acc, int lane) {
#pragma unroll
    for (int ks = 0; ks < 2; ++ks) acc = __builtin_amdgcn_mfma_f32_16x16x32_bf16(frag_tr(Y, RST, 16 * ct, 32 * ks, lane), frag_tr(X, RST, 16 * rt, 32 * ks, lane), acc, 0, 0, 0);
    return acc; }
__device__ __forceinline__ f32x4 mm_xyt(const LAS bf16* X, const LAS bf16* Y, int rt, int ct, f32x4 acc, int lane) {
#pragma unroll
    for (int ks = 0; ks < 2; ++ks) acc = __builtin_amdgcn_mfma_f32_16x16x32_bf16(frag_row(Y, RST, 16 * ct, 32 * ks, lane), frag_row(X, RST, 16 * rt, 32 * ks, lane), acc, 0, 0, 0);
    return acc; }
__device__ __forceinline__ void gtile_store(bf16* g, int rt, int ct, const f32x4 a, int lane) { v2u p; p.x = cvt_pk_bf16(a[0], a[1]); p.y = cvt_pk_bf16(a[2], a[3]); *(v2u*)(g + (16 * rt + (lane & 15)) * 64 + 16 * ct + 4 * (lane >> 4)) = p; }
__device__ __forceinline__ f32x4 gtile_load(const bf16* g, int rt, int ct, int lane) { const v2u p = *(const v2u*)(g + (16 * rt + (lane & 15)) * 64 + 16 * ct + 4 * (lane >> 4));
    return (f32x4){__uint_as_float(p.x << 16), __uint_as_float(p.x & 0xffff0000u), __uint_as_float(p.y << 16), __uint_as_float(p.y & 0xffff0000u)}; }

__device__ __forceinline__ void rwkv_prep_unit(const Ctx& c, int unit, const bf16* U, const float* LW, const float* LA, const float* mu, const float* k_k, const float* k_a, bf16* PHI, bf16* RAP, bf16* PSI, bf16* YVB) {
    const int chunk = unit & 31, head = (unit >> 5) & 15, batch = unit >> 9;
    LAS unsigned char* base = launder_lds(c.lds);
#define RIMG(n) ((LAS bf16*)(base + (n) * 9216))
    LAS bf16* Ai = RIMG(0); LAS bf16* Ri = RIMG(1); LAS bf16* Bi = RIMG(2); LAS bf16* Ki = RIMG(3); LAS bf16* Vi = RIMG(4); LAS bf16* Aak = RIMG(5); LAS bf16* Arb = RIMG(6); LAS bf16* Ark = RIMG(7);
    LAS bf16* PA = RIMG(8); LAS bf16* PB = RIMG(9); LAS bf16* T0 = RIMG(10); LAS bf16* T1 = RIMG(11);
    LAS float* LF = (LAS float*)(base + 10 * 9216);
    LAS float* SEGT = (LAS float*)(base + 12 * 9216); LAS float* ER = SEGT + 512; LAS float* EG = ER + 64; LAS float* EGR = EG + 64;
    const int lane = c.lane, w = c.wave, r = lane & 15, q = lane >> 4, trow = c.tid >> 3, part = c.tid & 7;
    const int rt = w >> 1, ct0 = 2 * (w & 1);
    { const int j0 = 8 * part, col = head * 64 + j0, tl = chunk * 64 + trow; const size_t m = (size_t)batch * SEQ + tl; const bf16* ur = U + m * EVP;
      const v4u r8 = *(const v4u*)(ur + col), k8 = *(const v4u*)(ur + 1024 + col), v8 = *(const v4u*)(ur + 2048 + col);
      v4u rp = (v4u){0u, 0u, 0u, 0u}, kp = rp, vp = rp;
      if (tl > 0) { rp = *(const v4u*)(ur - EVP + col); kp = *(const v4u*)(ur - EVP + 1024 + col); vp = *(const v4u*)(ur - EVP + 2048 + col); }
      const f32x4 lw0 = *(const f32x4*)(LW + m * 1024 + col), lw1 = *(const f32x4*)(LW + m * 1024 + col + 4), al0 = *(const f32x4*)(LA + m * 1024 + col), al1 = *(const f32x4*)(LA + m * 1024 + col + 4);
      float rr[8], kk[8], vv[8], rq[8], kq[8], vq[8], lw[8], al[8];
#define RW_UNPK(dst, src) do { dst[0] = __uint_as_float((src).x << 16); dst[1] = __uint_as_float((src).x & 0xffff0000u); dst[2] = __uint_as_float((src).y << 16); dst[3] = __uint_as_float((src).y & 0xffff0000u); \
        dst[4] = __uint_as_float((src).z << 16); dst[5] = __uint_as_float((src).z & 0xffff0000u); dst[6] = __uint_as_float((src).w << 16); dst[7] = __uint_as_float((src).w & 0xffff0000u); } while (0)
      RW_UNPK(rr, r8); RW_UNPK(kk, k8); RW_UNPK(vv, v8); RW_UNPK(rq, rp); RW_UNPK(kq, kp); RW_UNPK(vq, vp);
#pragma unroll
      for (int e = 0; e < 4; ++e) { lw[e] = lw0[e]; lw[4 + e] = lw1[e]; al[e] = al0[e]; al[4 + e] = al1[e]; }
      float kn[8], ss = 0.f;
#pragma unroll
      for (int e = 0; e < 8; ++e) { rr[e] += (rq[e] - rr[e]) * mu[col + e]; kk[e] += (kq[e] - kk[e]) * mu[1024 + col + e]; vv[e] += (vq[e] - vv[e]) * mu[2048 + col + e]; kn[e] = kk[e] * k_k[col + e]; ss += kn[e] * kn[e]; }
      ss += __shfl_xor(ss, 1); ss += __shfl_xor(ss, 2); ss += __shfl_xor(ss, 4);
      const float rn = 1.0f / sqrtf(fmaxf(ss, 1e-12f));
      *(LAS f32x4*)(LF + trow * 68 + j0) = (f32x4){lw[0], lw[1], lw[2], lw[3]}; *(LAS f32x4*)(LF + trow * 68 + j0 + 4) = (f32x4){lw[4], lw[5], lw[6], lw[7]};
      __syncthreads();
      { const int j = c.tid & 63, seg = c.tid >> 6; float run = 0.f;
#pragma unroll
        for (int i = 0; i < 8; ++i) { run += LF[(8 * seg + i) * 68 + j]; LF[(8 * seg + i) * 68 + j] = run; }
        SEGT[seg * 64 + j] = run; }
      __syncthreads();
      const int segt = trow >> 3; float ai[8], ri[8], bi[8], ki[8];
#pragma unroll
      for (int h2 = 0; h2 < 2; ++h2) { f32x4 cum = *(const LAS f32x4*)(LF + trow * 68 + j0 + 4 * h2), ref = *(const LAS f32x4*)(LF + 31 * 68 + j0 + 4 * h2), g = *(const LAS f32x4*)(LF + 63 * 68 + j0 + 4 * h2);
#pragma unroll
          for (int sgi = 0; sgi < 7; ++sgi) { const f32x4 sv = *(const LAS f32x4*)(SEGT + sgi * 64 + j0 + 4 * h2); if (sgi < segt) cum = cum + sv; if (sgi < 3) ref = ref + sv; g = g + sv; }
#pragma unroll
          for (int e4 = 0; e4 < 4; ++e4) { const int e = 4 * h2 + e4; const float d = cum[e4] - ref[e4], ed = __expf(d), edi = __expf(-d); const float kkn = kn[e] * rn;
              ai[e] = -kkn * __expf(d - lw[e]); ri[e] = rr[e] * ed; bi[e] = kkn * al[e] * edi; ki[e] = kk[e] * (1.0f + (al[e] - 1.0f) * k_a[col + e]) * edi;
              if (trow == 0) { ER[j0 + e] = __expf(ref[e4]); EG[j0 + e] = __expf(g[e4]); EGR[j0 + e] = __expf(g[e4] - ref[e4]); } } }
      *(LAS v4u*)(Ai + trow * RST + j0) = pack8((f32x4){ai[0], ai[1], ai[2], ai[3]}, (f32x4){ai[4], ai[5], ai[6], ai[7]});
      *(LAS v4u*)(Ri + trow * RST + j0) = pack8((f32x4){ri[0], ri[1], ri[2], ri[3]}, (f32x4){ri[4], ri[5], ri[6], ri[7]});
      *(LAS v4u*)(Bi + trow * RST + j0) = pack8((f32x4){bi[0], bi[1], bi[2], bi[3]}, (f32x4){bi[4], bi[5], bi[6], bi[7]});
      *(LAS v4u*)(Ki + trow * RST + j0) = pack8((f32x4){ki[0], ki[1], ki[2], ki[3]}, (f32x4){ki[4], ki[5], ki[6], ki[7]});
      *(LAS v4u*)(Vi + trow * RST + j0) = pack8((f32x4){vv[0], vv[1], vv[2], vv[3]}, (f32x4){vv[4], vv[5], vv[6], vv[7]});
#undef RW_UNPK
    }
    __syncthreads();
    f32x4 Tacc[2];
#pragma unroll
    for (int i = 0; i < 2; ++i) { const int ct = ct0 + i; const f32x4 z = (f32x4){0.f, 0.f, 0.f, 0.f}; f32x4 ab = z, ak = z, rb = z, rk = z;
        if (ct <= rt) { ab = mm_xyt(Ai, Bi, rt, ct, z, lane); ak = mm_xyt(Ai, Ki, rt, ct, z, lane); rb = mm_xyt(Ri, Bi, rt, ct, z, lane); rk = mm_xyt(Ri, Ki, rt, ct, z, lane);
            const int t = 16 * rt + r;
#pragma unroll
            for (int j = 0; j < 4; ++j) { const int sj = 16 * ct + 4 * q + j; if (sj >= t) { ab[j] = 0.f; ak[j] = 0.f; } if (sj > t) { rb[j] = 0.f; rk[j] = 0.f; } } }
        tile_store(PA, rt, ct, ab, lane); tile_store(Aak, rt, ct, ak, lane); tile_store(Arb, rt, ct, rb, lane); tile_store(Ark, rt, ct, rk, lane);
        Tacc[i] = ab;
#pragma unroll
        for (int j = 0; j < 4; ++j) if (16 * ct + 4 * q + j == 16 * rt + r) Tacc[i][j] += 1.0f;
        tile_store(T0, rt, ct, Tacc[i], lane); }
    __syncthreads();
#pragma unroll
    for (int i = 0; i < 2; ++i) { const int ct = ct0 + i; f32x4 pz = (f32x4){0.f, 0.f, 0.f, 0.f}; if (ct <= rt) pz = mm_xy(PA, PA, rt, ct, pz, lane); tile_store(PB, rt, ct, pz, lane); }
    __syncthreads();
#pragma unroll
    for (int lv = 1; lv <= 5; ++lv) {
        LAS bf16* Pc = (lv & 1) ? PB : PA; LAS bf16* Pn = (lv & 1) ? PA : PB; LAS bf16* Tc = (lv & 1) ? T0 : T1; LAS bf16* Tn = (lv & 1) ? T1 : T0;
#pragma unroll
        for (int i = 0; i < 2; ++i) { const int ct = ct0 + i;
            if (ct <= rt) Tacc[i] = mm_xy(Pc, Tc, rt, ct, Tacc[i], lane);
            tile_store(Tn, rt, ct, Tacc[i], lane);
            if (lv < 5) { f32x4 pz = (f32x4){0.f, 0.f, 0.f, 0.f}; if (ct <= rt) pz = mm_xy(Pc, Pc, rt, ct, pz, lane); tile_store(Pn, rt, ct, pz, lane); } }
        __syncthreads();
    }
#pragma unroll
    for (int i = 0; i < 2; ++i) { const int ct = ct0 + i; const f32x4 z = (f32x4){0.f, 0.f, 0.f, 0.f};
        tile_store(PA, rt, ct, mm_xy(Aak, Vi, rt, ct, z, lane), lane); tile_store(PB, rt, ct, mm_xy(T1, Ai, rt, ct, z, lane), lane); }
    __syncthreads();
    const size_t ub = (size_t)unit * 4096;
#pragma unroll
    for (int i = 0; i < 2; ++i) { const int ct = ct0 + i; const f32x4 z = (f32x4){0.f, 0.f, 0.f, 0.f};
        tile_store(T0, rt, ct, mm_xy(T1, PA, rt, ct, z, lane), lane);
        f32x4 ra = mm_xy(Arb, PB, rt, ct, tile_load(Ri, rt, ct, lane), lane); const f32x4 er = *(const LAS f32x4*)(ER + 16 * ct + 4 * q);
        gtile_store(RAP + ub, rt, ct, ra * er, lane);
        f32x4 gph = mm_xty(Bi, PB, rt, ct, z, lane); const float egr = EGR[16 * rt + r], egj = EG[16 * rt + r];
#pragma unroll
        for (int j = 0; j < 4; ++j) { gph[j] = gph[j] * egr * er[j]; if (16 * ct + 4 * q + j == 16 * rt + r) gph[j] += egj; }
        gtile_store(PHI + ub, rt, ct, gph, lane); }
    __syncthreads();
#pragma unroll
    for (int i = 0; i < 2; ++i) { const int ct = ct0 + i; const f32x4 z = (f32x4){0.f, 0.f, 0.f, 0.f};
        gtile_store(YVB + ub, rt, ct, mm_xy(Ark, Vi, rt, ct, mm_xy(Arb, T0, rt, ct, z, lane), lane), lane);
        const f32x4 ps = mm_xty(Ki, Vi, rt, ct, mm_xty(Bi, T0, rt, ct, z, lane), lane);
        gtile_store(PSI + ub, rt, ct, ps * EGR[16 * rt + r], lane); }
    __syncthreads();
#undef RIMG
}

__device__ __forceinline__ void rwkv_chain(const Ctx& c, int task, const bf16* PHI, const bf16* RAP, const bf16* PSI, const bf16* YVB, float* YRAW) {
    const int head = task & 15, batch = task >> 4;
    const int lane = c.lane, w = c.wave, r = lane & 15, q = lane >> 4, trow = c.tid >> 3, part = c.tid & 7;
    const int it = w >> 1, x0 = 2 * (w & 1);
    { LAS bf16* H0 = (LAS bf16*)c.lds; for (int i = c.tid; i < 64 * RST / 2; i += 512) ((LAS unsigned*)H0)[i] = 0u; }
    const size_t u0 = (size_t)(batch * 16 + head) * 32;
    v4u pphi = *(const v4u*)(PHI + u0 * 4096 + trow * 64 + 8 * part), prap = *(const v4u*)(RAP + u0 * 4096 + trow * 64 + 8 * part);
    __syncthreads();
    for (int ch = 0; ch < 32; ++ch) {
        LAS unsigned char* base = launder_lds(c.lds);
        LAS bf16* Hc = (LAS bf16*)(base + (ch & 1) * 9216); LAS bf16* Hn = (LAS bf16*)(base + ((ch & 1) ^ 1) * 9216); LAS bf16* PHi = (LAS bf16*)(base + 2 * 9216); LAS bf16* RAi = (LAS bf16*)(base + 3 * 9216);
        const size_t ub = (u0 + ch) * 4096;
        *(LAS v4u*)(PHi + trow * RST + 8 * part) = pphi; *(LAS v4u*)(RAi + trow * RST + 8 * part) = prap;
        if (ch + 1 < 32) { pphi = *(const v4u*)(PHI + ub + 4096 + trow * 64 + 8 * part); prap = *(const v4u*)(RAP + ub + 4096 + trow * 64 + 8 * part); }
        f32x4 yv[2], ps[2];
#pragma unroll
        for (int i = 0; i < 2; ++i) { yv[i] = gtile_load(YVB + ub, x0 + i, it, lane); ps[i] = gtile_load(PSI + ub, x0 + i, it, lane); }
        __syncthreads();
#pragma unroll
        for (int i = 0; i < 2; ++i) { const int xt = x0 + i;
            const f32x4 y = mm_xy(RAi, Hc, xt, it, yv[i], lane);
            *(f32x4*)(YRAW + ((size_t)batch * SEQ + ch * 64 + 16 * xt + r) * 1024 + head * 64 + 16 * it + 4 * q) = y;
            const f32x4 hn = mm_xy(PHi, Hc, xt, it, ps[i], lane);
            tile_store(Hn, xt, it, hn, lane); }
        __syncthreads();
    }
}

struct Args { const float* in[41]; float* out; unsigned char* ws; int lo, hi; };

__global__ void __launch_bounds__(512, 2) fwd(Args args) {
    extern __shared__ __attribute__((aligned(16))) unsigned char lds_raw[];
    Ctx c; c.lds = (LAS unsigned char*)lds_raw; c.tid = threadIdx.x; c.lane = c.tid & 63; c.wave = __builtin_amdgcn_readfirstlane(c.tid >> 6); c.bid = blockIdx.x; c.G = gridDim.x;
    volatile LAS unsigned* MISC = (volatile LAS unsigned*)(c.lds + MISC_OFF);
    unsigned char* ws = args.ws;
    for (int u = c.tid; u < (LDS_BYTES - RING_BYTES) / 4; u += 512) ((LAS unsigned*)(c.lds + RING_BYTES))[u] = 0u;
    __syncthreads();
    const int lo = args.lo, hi = args.hi;
    XcdBarrier bar; bar.bar = (unsigned*)(ws + WS_CTL) + CW_BAR; bar.x = 0; bar.st = nullptr;
    if (hi - lo > 1) bar = xcd_barrier_post((unsigned*)(ws + WS_CTL) + CW_BAR, MISC + 8);
#define IN(k) (lo <= (k) && (k) < hi)
#define SEAM(k) do { if (IN(k) && IN((k) + 1)) xcd_barrier(bar); } while (0)

    const float* x = args.in[0]; const float* final_norm_w = args.in[1]; const float* hg_lb = args.in[2];
    const float* ev_norm1_w = args.in[3]; const float* ev_w_in = args.in[4]; const float* ev_w_out = args.in[5];
    const float* rw_mu = args.in[6]; const float* rw_w0 = args.in[7]; const float* rw_w2 = args.in[8]; const float* rw_a0 = args.in[9]; const float* rw_a2 = args.in[10]; const float* rw_g2 = args.in[11];
    const float* rw_k_k = args.in[12]; const float* rw_k_a = args.in[13]; const float* rw_r_k = args.in[14]; const float* rw_ln_w = args.in[15]; const float* rw_ln_b = args.in[16];
    const float* ml_conv_w = args.in[17]; const float* ml_conv_b = args.in[18]; const float* ml_i_b = args.in[19]; const float* ml_f_b = args.in[20]; const float* ml_norm_w = args.in[21];
    const float* ev_norm2_w = args.in[22]; const float* ffn_w_gate = args.in[23]; const float* ffn_w_up = args.in[24]; const float* ffn_w_down = args.in[25];
    const float* od_norm1_w = args.in[26]; const float* od_w_in = args.in[27]; const float* od_w_out = args.in[28]; const float* hg_norm_w = args.in[29];
    const float* mb_conv_w = args.in[30]; const float* mb_conv_b = args.in[31]; const float* mb_dt_bias = args.in[32]; const float* mb_A_log = args.in[33]; const float* mb_D = args.in[34]; const float* mb_norm_w = args.in[35];
    const float* od_norm2_w = args.in[36]; const float* moe_router = args.in[37]; const float* moe_w_gate = args.in[38]; const float* moe_w_up = args.in[39]; const float* moe_w_down = args.in[40];
    float* OUT = args.out;
    bf16* W_LORA = (bf16*)(ws + WS_WLORA); bf16* W_EVIN = (bf16*)(ws + WS_WEVIN); bf16* W_EVOUT = (bf16*)(ws + WS_WEVOUT); bf16* W_FGU = (bf16*)(ws + WS_WFGU); bf16* W_FD = (bf16*)(ws + WS_WFD);
    bf16* W_ODIN = (bf16*)(ws + WS_WODIN); bf16* W_ODOUT = (bf16*)(ws + WS_WODOUT); bf16* W_MGU = (bf16*)(ws + WS_WMGU); bf16* W_MD = (bf16*)(ws + WS_WMD);
    bf16* XN = (bf16*)(ws + WS_XN); bf16* Y = (bf16*)(ws + WS_Y); float* X1 = (float*)(ws + WS_X1);
    bf16* U = (bf16*)(ws + SC_U); float* LW = (float*)(ws + SC_LW); float* LA = (float*)(ws + SC_LA); float* LG = (float*)(ws + SC_LG); bf16* ALORA = (bf16*)(ws + SC_ALORA);
    bf16* RW_PHI = (bf16*)(ws + WS_X1); bf16* RW_RAP = RW_PHI + (size_t)2048 * 4096; bf16* RW_PSI = RW_RAP + (size_t)2048 * 4096; bf16* RW_YV = RW_PSI + (size_t)2048 * 4096;
    float* YRAW_E = (float*)(ws + SC_YRAW_E); float* MLQK = (float*)(ws + SC_MLQK); float* HRAW = (float*)(ws + SC_HRAW); float* DEN = (float*)(ws + SC_DEN);
    bf16* ACT = (bf16*)(ws + SC_ACT);
    float* XBC = (float*)(ws + SC_XBC); float* ORAW = (float*)(ws + SC_ORAW); float* YRAW_O = (float*)(ws + SC_YRAW_O);
    bf16* HS = (bf16*)(ws + SC_HS); bf16* ACTS = (bf16*)(ws + SC_ACTS); float* OUTS = (float*)(ws + SC_OUTS);
    int* TOPK = (int*)(ws + SC_TOPK); int* POS = (int*)(ws + SC_POS); int* CNT = (int*)(ws + SC_CNT); int* TILES = (int*)(ws + SC_TILES);
    float* X2 = OUT;

    if (IN(0)) {
        int base = 0;
        conv_kind(c, ev_w_in, DM, 6600, EVP, W_EVIN, 0, 1, 0, 0, base);
        conv_kind(c, ev_w_out, DM, DM, DM, W_EVOUT, 0, 1, 0, 0, base);
        conv_kind(c, ffn_w_gate, DM, FF, FF, W_FGU, 1, 1, 0, 0, base);
        conv_kind(c, ffn_w_up, DM, FF, FF, W_FGU, 2, 1, 0, 0, base);
        conv_kind(c, ffn_w_down, FF, DM, DM, W_FD, 0, 1, 0, 0, base);
        conv_kind(c, od_w_in, DM, 7184, ODP, W_ODIN, 0, 1, 0, 0, base);
        conv_kind(c, od_w_out, DM, DM, DM, W_ODOUT, 0, 1, 0, 0, base);
        conv_kind(c, moe_w_gate, DM, FE, FE, W_MGU, 1, NEXP, (size_t)DM * FE, (size_t)2 * FE * DM, base);
        conv_kind(c, moe_w_up, DM, FE, FE, W_MGU, 2, NEXP, (size_t)DM * FE, (size_t)2 * FE * DM, base);
        conv_kind(c, moe_w_down, FE, DM, DM, W_MD, 0, NEXP, (size_t)FE * DM, (size_t)DM * FE, base);
        for (int idx = c.bid * 512 + c.tid; idx < 3072 * 512; idx += c.G * 512) {
            const int k = idx / 3072, n = idx % 3072; float v = 0.f;
            if (n < 1024) { if (k < 96) v = rw_w2[k * 1024 + n]; }
            else if (n < 2048) { if (k >= 96 && k < 192) v = rw_a2[(k - 96) * 1024 + (n - 1024)]; }
            else { if (k >= 192 && k < 448) v = rw_g2[(k - 192) * 1024 + (n - 2048)]; }
            W_LORA[(size_t)n * 512 + k] = (bf16)f2bf(v);
        }
        rmsnorm_phase(c, x, ev_norm1_w, XN);
    }
    SEAM(0);
    if (IN(1)) {
        pg8::Gemm g{XN, W_EVIN, M_TOK, EVP, DM}; pg8::StaticOrder S; S.init(M_TOK, EVP, c.G, c.bid);
        pg8::EpiBf16 E{U, EVP};
        pg8::gemm_phase<pg8::EpiBf16, pg8::StaticOrder, true, true>(c.lds, g, S, E);
    }
    SEAM(1);
    if (IN(2)) {
        for (int m = c.bid; m < M_TOK; m += c.G) {
            const int tl = m & (SEQ - 1); const bf16* ur = U + (size_t)m * EVP;
            for (int idx = c.tid; idx < 1536; idx += 512) {
                if (idx < 512) {
                    float val = 0.f;
                    if (idx < 448) { const int col = 3072 + idx; const float cu = bf2f(ur[col]); const float pv = tl ? bf2f(ur[col - EVP]) : 0.f; const float xs = cu + (pv - cu) * rw_mu[col];
                        val = idx < 96 ? tanhf(xs) : (idx < 192 ? xs : sigmoidf_(xs)); }
                    ALORA[(size_t)m * 512 + idx] = (bf16)f2bf(val);
                } else {
                    const int ch = idx - 512; float acc = ml_conv_b[ch];
#pragma unroll
                    for (int j = 0; j < 4; ++j) { if (tl - 3 + j >= 0) acc += ml_conv_w[j * 1024 + ch] * bf2f(ur[(j - 3) * EVP + 3520 + ch]); }
                    MLQK[(size_t)m * 1024 + ch] = siluf_(acc);
                }
            }
        }
    }
    SEAM(2);
    if (IN(3)) {
        pg8::Gemm g{ALORA, W_LORA, M_TOK, 3072, 512}; pg8::StaticOrder S; S.init(M_TOK, 3072, c.G, c.bid);
        pg8::EpiLora E{LW, rw_w0, rw_a0};
        pg8::gemm_phase<pg8::EpiLora, pg8::StaticOrder, true, true>(c.lds, g, S, E);
    }
    SEAM(3);
    if (IN(4)) {
        for (int unit = c.bid; unit < 2048; unit += c.G) rwkv_prep_unit(c, unit, U, LW, LA, rw_mu, rw_k_k, rw_k_a, RW_PHI, RW_RAP, RW_PSI, RW_YV);
    }
    SEAM(4);
    if (IN(5)) {
        for (int task = c.bid; task < 128; task += c.G) {
            if (task < 64) rwkv_chain(c, task, RW_PHI, RW_RAP, RW_PSI, RW_YV, YRAW_E);
            else chunk_scan<true>(c, task - 64, U, MLQK, ml_i_b, ml_f_b, nullptr, HRAW, DEN);
        }
    }
    SEAM(5);
    if (IN(6)) {
        for (int m = c.bid; m < M_TOK; m += c.G) {
            const int tl = m & (SEQ - 1); const bf16* ur = U + (size_t)m * EVP;
            if (c.wave < 4) {
                for (int hh = 0; hh < 4; ++hh) {
                    const int head = c.wave * 4 + hh, col = head * 64 + c.lane;
                    const float yv = YRAW_E[(size_t)m * 1024 + col];
                    const float mean = wave_sum(yv) * (1.0f / 64.0f); const float dv = yv - mean; const float var = wave_sum(dv * dv) * (1.0f / 64.0f);
                    const float yn = dv * (1.0f / sqrtf(var + 64e-5f)) * rw_ln_w[col] + rw_ln_b[col];
                    float r = bf2f(ur[col]), k = bf2f(ur[1024 + col]), v = bf2f(ur[2048 + col]);
                    float rp = 0.f, kp = 0.f, vp = 0.f;
                    if (tl) { rp = bf2f(ur[col - EVP]); kp = bf2f(ur[1024 + col - EVP]); vp = bf2f(ur[2048 + col - EVP]); }
                    r += (rp - r) * rw_mu[col]; k += (kp - k) * rw_mu[1024 + col]; v += (vp - v) * rw_mu[2048 + col];
                    const float av = LA[(size_t)m * 1024 + col];
                    const float kpv = k * (1.0f + (av - 1.0f) * rw_k_a[col]);
                    const float bonus = wave_sum(r * kpv * rw_r_k[col]);
                    Y[(size_t)m * DM + col] = (bf16)f2bf((yn + bonus * v) * LG[(size_t)m * 1024 + col]);
                }
            } else {
                const int head = c.wave - 4, col = head * 256 + 4 * c.lane;
                f32x4 hv = *(const f32x4*)(HRAW + (size_t)m * 1024 + col); hv = hv * (1.0f / fmaxf(fabsf(DEN[(size_t)m * 4 + head]), 1.0f));
                const float ss = wave_sum((hv.x * hv.x + hv.y * hv.y) + (hv.z * hv.z + hv.w * hv.w));
                const float rs = 1.0f / sqrtf(ss * (1.0f / 256.0f) + 1e-6f);
                const f32x4 nw = *(const f32x4*)(ml_norm_w + col);
                float o[4];
#pragma unroll
                for (int j = 0; j < 4; ++j) o[j] = hv[j] * rs * nw[j] * sigmoidf_(bf2f(ur[5568 + col + j]));
                v2u p; p.x = cvt_pk_bf16(o[0], o[1]); p.y = cvt_pk_bf16(o[2], o[3]); *(v2u*)(Y + (size_t)m * DM + 1024 + col) = p;
            }
        }
    }
    SEAM(6);
    if (IN(7)) {
        pg8::Gemm g{Y, W_EVOUT, M_TOK, DM, DM}; pg8::StaticOrder S; S.init(M_TOK, DM, c.G, c.bid);
        pg8::EpiResF32 E{x, X1, DM};
        pg8::gemm_phase<pg8::EpiResF32, pg8::StaticOrder, false, true>(c.lds, g, S, E);
    }
    SEAM(7);
    if (IN(8)) rmsnorm_phase(c, X1, ev_norm2_w, XN);
    SEAM(8);
    if (IN(9)) {
        pg8::Gemm g{XN, W_FGU, M_TOK, 2 * FF, DM}; pg8::StaticOrder S; S.init(M_TOK, 2 * FF, c.G, c.bid);
        pg8::EpiSwiGLU E{ACT, FF};
        pg8::gemm_phase<pg8::EpiSwiGLU, pg8::StaticOrder, true, true>(c.lds, g, S, E);
    }
    SEAM(9);
    if (IN(10)) {
        pg8::Gemm g{ACT, W_FD, M_TOK, DM, FF}; pg8::StaticOrder S; S.init(M_TOK, DM, c.G, c.bid);
        pg8::EpiResF32 E{X1, X2, DM};
        pg8::gemm_phase<pg8::EpiResF32, pg8::StaticOrder, false, true>(c.lds, g, S, E);
    }
    SEAM(10);
    if (IN(11)) rmsnorm_phase(c, X2, od_norm1_w, XN);
    SEAM(11);
    if (IN(12)) {
        pg8::Gemm g{XN, W_ODIN, M_TOK, ODP, DM}; pg8::StaticOrder S; S.init(M_TOK, ODP, c.G, c.bid);
        pg8::EpiBf16 E{U, ODP};
        pg8::gemm_phase<pg8::EpiBf16, pg8::StaticOrder, true, true>(c.lds, g, S, E);
    }
    SEAM(12);
    if (IN(13)) {
        for (int m = c.bid; m < M_TOK; m += c.G) {
            const int tl = m & (SEQ - 1); const bf16* ur = U + (size_t)m * ODP;
            for (int ch = c.tid; ch < 2048; ch += 512) {
                float acc = mb_conv_b[ch];
#pragma unroll
                for (int j = 0; j < 4; ++j) { if (tl - 3 + j >= 0) acc += mb_conv_w[j * 2048 + ch] * bf2f(ur[(j - 3) * ODP + 5120 + ch]); }
                XBC[(size_t)m * 2048 + ch] = siluf_(acc);
            }
        }
    }
    SEAM(13);
    if (IN(14)) {
        for (int task = c.bid; task < 256; task += c.G) {
            if (task < 64) chunk_hgrn(c, task, U, hg_lb, ORAW);
            else if (task < 128) chunk_scan<false>(c, task - 64, U, XBC, mb_dt_bias, mb_A_log, mb_D, YRAW_O, nullptr);
        }
    }
    SEAM(14);
    if (IN(15)) {
        for (int m = c.bid; m < M_TOK; m += c.G) {
            const bf16* ur = U + (size_t)m * ODP;
            if (c.wave < 4) {
#pragma unroll
                for (int hh = 0; hh < 2; ++hh) {
                    const int head = c.wave * 2 + hh, col = head * 128 + 2 * c.lane;
                    const f32x2 ov = *(const f32x2*)(ORAW + (size_t)m * 1024 + col);
                    const float rs = 1.0f / sqrtf(wave_sum(ov.x * ov.x + ov.y * ov.y) * (1.0f / 128.0f) + 1e-6f);
                    const float o0 = ov.x * rs * hg_norm_w[col] * siluf_(bf2f(ur[3072 + col])), o1 = ov.y * rs * hg_norm_w[col + 1] * siluf_(bf2f(ur[3072 + col + 1]));
                    *(unsigned*)(Y + (size_t)m * DM + col) = cvt_pk_bf16(o0, o1);
                }
            } else {
                const int grp = c.wave - 4, col = grp * 256 + 4 * c.lane;
                const f32x4 yv = *(const f32x4*)(YRAW_O + (size_t)m * 1024 + col);
                float t[4]; float ss = 0.f;
#pragma unroll
                for (int j = 0; j < 4; ++j) { t[j] = yv[j] * siluf_(bf2f(ur[4096 + col + j])); ss += t[j] * t[j]; }
                const float rs = 1.0f / sqrtf(wave_sum(ss) * (1.0f / 256.0f) + 1e-6f);
                const f32x4 nw = *(const f32x4*)(mb_norm_w + col);
                v2u p; p.x = cvt_pk_bf16(t[0] * rs * nw[0], t[1] * rs * nw[1]); p.y = cvt_pk_bf16(t[2] * rs * nw[2], t[3] * rs * nw[3]); *(v2u*)(Y + (size_t)m * DM + 1024 + col) = p;
            }
        }
    }
    SEAM(15);
    if (IN(16)) {
        pg8::Gemm g{Y, W_ODOUT, M_TOK, DM, DM}; pg8::StaticOrder S; S.init(M_TOK, DM, c.G, c.bid);
        pg8::EpiResF32 E{X2, X1, DM};
        pg8::gemm_phase<pg8::EpiResF32, pg8::StaticOrder, false, true>(c.lds, g, S, E);
    }
    SEAM(16);
    if (IN(17)) {
        LAS float* RT = (LAS float*)c.lds;
        LAS int* lcnt = (LAS int*)(c.lds + 65536);
        for (int i = c.tid; i < 2048 * 8 / 4; i += 512) *(LAS f32x4*)(RT + 4 * i) = *(const f32x4*)(moe_router + 4 * i);
        __syncthreads();
        for (int blk = c.bid; blk < 256; blk += c.G) {
            if (c.tid < 8) lcnt[c.tid] = 0;
            __syncthreads();
            for (int q = 0; q < 4; ++q) {
                const int m = blk * 32 + c.wave * 4 + q;
                const float* xr = X1 + (size_t)m * DM;
                f32x4 v[8]; float ss = 0.f;
#pragma unroll
                for (int j = 0; j < 8; ++j) { v[j] = *(const f32x4*)(xr + 4 * c.lane + 256 * j); ss += (v[j].x * v[j].x + v[j].y * v[j].y) + (v[j].z * v[j].z + v[j].w * v[j].w); }
                const float rs = 1.0f / sqrtf(wave_sum(ss) * (1.0f / 2048.0f) + 1e-6f);
                float lg[8];
#pragma unroll
                for (int e = 0; e < 8; ++e) lg[e] = 0.f;
#pragma unroll
                for (int j = 0; j < 8; ++j) { const f32x4 wv = *(const f32x4*)(od_norm2_w + 4 * c.lane + 256 * j); const f32x4 hn = v[j] * rs * wv;
                    v2u p; p.x = cvt_pk_bf16(hn.x, hn.y); p.y = cvt_pk_bf16(hn.z, hn.w); *(v2u*)(XN + (size_t)m * DM + 4 * c.lane + 256 * j) = p;
#pragma unroll
                    for (int i = 0; i < 4; ++i) { const int ch = 4 * c.lane + 256 * j + i; const f32x4 r0 = *(const LAS f32x4*)(RT + ch * 8), r1 = *(const LAS f32x4*)(RT + ch * 8 + 4);
                        lg[0] += hn[i] * r0[0]; lg[1] += hn[i] * r0[1]; lg[2] += hn[i] * r0[2]; lg[3] += hn[i] * r0[3]; lg[4] += hn[i] * r1[0]; lg[5] += hn[i] * r1[1]; lg[6] += hn[i] * r1[2]; lg[7] += hn[i] * r1[3]; } }
#pragma unroll
                for (int e = 0; e < 8; ++e) lg[e] = wave_sum(lg[e]);
                int e0 = 0; float v0 = lg[0];
#pragma unroll
                for (int e = 1; e < 8; ++e) if (lg[e] > v0) { v0 = lg[e]; e0 = e; }
                int e1 = -1; float v1 = -3.0e38f;
#pragma unroll
                for (int e = 0; e < 8; ++e) if (e != e0 && lg[e] > v1) { v1 = lg[e]; e1 = e; }
                const float p0 = 1.0f / (1.0f + __expf(v1 - v0)), p1 = 1.0f - p0;
                if (c.lane == 0) { TOPK[m * 4] = e0; TOPK[m * 4 + 1] = e1; TOPK[m * 4 + 2] = __float_as_int(p0); TOPK[m * 4 + 3] = __float_as_int(p1); atomicAdd((int*)&lcnt[e0], 1); atomicAdd((int*)&lcnt[e1], 1); }
            }
            __syncthreads();
            if (c.tid < 8) CNT[blk * 8 + c.tid] = lcnt[c.tid];
            __syncthreads();
        }
    }
    SEAM(17);
    if (IN(18)) {
        LAS int* C8 = (LAS int*)c.lds;
        LAS int* tot = C8 + 2048; LAS int* pre = tot + 8; LAS int* segst = pre + 8; LAS int* ntl = segst + 8; LAS int* basee = ntl + 8; LAS int* lpos = basee + 8;
        for (int blk = c.bid; blk < 256; blk += c.G) {
            for (int i = c.tid; i < 2048; i += 512) C8[i] = CNT[i];
            __syncthreads();
            if (c.tid < 8) { int t = 0, p = 0; for (int b = 0; b < 256; ++b) { const int v = C8[b * 8 + c.tid]; t += v; if (b < blk) p += v; } tot[c.tid] = t; pre[c.tid] = p; }
            __syncthreads();
            if (c.tid == 0) {
                int seg = 0;
                for (int e = 0; e < 8; ++e) { segst[e] = seg; ntl[e] = (tot[e] + 255) >> 8; seg += ntl[e] * 256; basee[e] = seg - ntl[e] * 256 + pre[e]; }
                for (int i = 0; i < 32; ++i) { const int m = blk * 32 + i; const int e0 = TOPK[m * 4], e1 = TOPK[m * 4 + 1];
                    const int p0 = basee[e0]; basee[e0] = p0 + 1; const int p1 = basee[e1]; basee[e1] = p1 + 1;
                    POS[m * 2] = p0; POS[m * 2 + 1] = p1; lpos[2 * i] = p0; lpos[2 * i + 1] = p1; }
                if (blk == 0) { int t = 0; for (int e = 0; e < 8; ++e) for (int k = 0; k < ntl[e]; ++k) TILES[1 + t++] = e; TILES[0] = t; }
            }
            __syncthreads();
            for (int pr = c.wave; pr < 64; pr += 8) {
                const int m = blk * 32 + (pr >> 1); const int pos = lpos[pr];
                const v4u* src = (const v4u*)(XN + (size_t)m * DM); v4u* dst = (v4u*)(HS + (size_t)pos * DM);
#pragma unroll
                for (int j = 0; j < 4; ++j) dst[c.lane + 64 * j] = src[c.lane + 64 * j];
            }
            for (int e = 0; e < 8; ++e) {
                const int npad = ntl[e] * 256 - tot[e], r0 = segst[e] + tot[e];
                for (int p = blk; p < npad; p += 256) { v2u* dst = (v2u*)(HS + (size_t)(r0 + p) * DM); dst[c.tid] = (v2u){0u, 0u}; }
            }
            __syncthreads();
        }
    }
    SEAM(18);
    if (IN(19)) {
        const int NT = __builtin_amdgcn_readfirstlane(TILES[0]);
        pg8::Gemm g{HS, W_MGU, 0, 0, DM}; pg8::GroupedOrder S{TILES + 1, NT, 22, c.G, c.bid};
        pg8::EpiSwiGLU E{ACTS, FE};
        pg8::gemm_phase<pg8::EpiSwiGLU, pg8::GroupedOrder, true, true>(c.lds, g, S, E);
    }
    SEAM(19);
    if (IN(20)) {
        const int NT = __builtin_amdgcn_readfirstlane(TILES[0]);
        pg8::Gemm g{ACTS, W_MD, 0, 0, FE}; pg8::GroupedOrder S{TILES + 1, NT, 8, c.G, c.bid};
        pg8::EpiResF32 E{nullptr, OUTS, DM};
        pg8::gemm_phase<pg8::EpiResF32, pg8::GroupedOrder, true, true>(c.lds, g, S, E);
    }
    SEAM(20);
    if (IN(21)) {
        const int gw = c.bid * 8 + c.wave, NGW = c.G * 8;
        for (int m = gw; m < M_TOK; m += NGW) {
            const float p0 = __int_as_float(TOPK[m * 4 + 2]), p1 = __int_as_float(TOPK[m * 4 + 3]); const int q0 = POS[m * 2], q1 = POS[m * 2 + 1];
            const float* xr = X1 + (size_t)m * DM; const float* o0 = OUTS + (size_t)q0 * DM; const float* o1 = OUTS + (size_t)q1 * DM;
            f32x4 v[8]; float ss = 0.f;
#pragma unroll
            for (int j = 0; j < 8; ++j) { const int o = 4 * c.lane + 256 * j; v[j] = *(const f32x4*)(xr + o) + p0 * *(const f32x4*)(o0 + o) + p1 * *(const f32x4*)(o1 + o);
                ss += (v[j].x * v[j].x + v[j].y * v[j].y) + (v[j].z * v[j].z + v[j].w * v[j].w); }
            const float rs = 1.0f / sqrtf(wave_sum(ss) * (1.0f / 2048.0f) + 1e-6f);
#pragma unroll
            for (int j = 0; j < 8; ++j) { const int o = 4 * c.lane + 256 * j; *(f32x4*)(OUT + (size_t)m * DM + o) = v[j] * rs * *(const f32x4*)(final_norm_w + o); }
        }
    }
#undef IN
#undef SEAM
}

extern "C" void kernel_launch(void* const* d_in, const int* in_sizes, int n_in, void* d_out, int out_size, void* d_ws, size_t ws_size, hipStream_t stream) {
    static int grid = 0;
    if (grid == 0) {
        if (n_in != 41 || out_size != M_TOK * DM || ws_size < WS_END) { fprintf(stderr, "kernel_launch: unexpected problem (n_in %d, out %d, ws %zu < %zu)\n", n_in, out_size, ws_size, (size_t)WS_END); grid = -1; return; }
        int dev = 0, cus = 0, per_cu = 0;
        if (hipGetDevice(&dev) != hipSuccess || hipDeviceGetAttribute(&cus, hipDeviceAttributeMultiprocessorCount, dev) != hipSuccess) { grid = -1; return; }
        if (hipFuncSetAttribute((const void*)fwd, hipFuncAttributeMaxDynamicSharedMemorySize, LDS_BYTES) != hipSuccess) { fprintf(stderr, "kernel_launch: hipFuncSetAttribute failed\n"); grid = -1; return; }
        if (hipOccupancyMaxActiveBlocksPerMultiprocessor(&per_cu, (const void*)fwd, 512, LDS_BYTES) != hipSuccess || per_cu < 1) fprintf(stderr, "kernel_launch: occupancy query says %d\n", per_cu);
        (void)hipGetLastError();
        grid = cus;
    }
    if (grid < 0) return;
    (void)hipMemsetAsync((char*)d_ws + WS_CTL, 0, CTL_ZERO_BYTES, stream);
    Args a{};
    for (int i = 0; i < 41; ++i) a.in[i] = (const float*)d_in[i];
    a.out = (float*)d_out; a.ws = (unsigned char*)d_ws;
    if (MK_N_LAUNCHES == 1) { a.lo = 0; a.hi = NPHASE; hipLaunchKernelGGL(fwd, dim3(grid), dim3(512), LDS_BYTES, stream, a); }
    else { for (int p = 0; p < NPHASE; ++p) { a.lo = p; a.hi = p + 1; const int n = ((PROBE_DUP >> p) & 1u) ? 1 + PROBE_EXTRA : 1;
            for (int r = 0; r < n; ++r) hipLaunchKernelGGL(fwd, dim3(grid), dim3(512), LDS_BYTES, stream, a); } }
}
```

```cpp
#include <hip/hip_runtime.h>
#include <cstdio>
#include <cstdint>

#ifndef MK_N_LAUNCHES
#define MK_N_LAUNCHES 1
#endif

#ifndef PROBE_DUP
#define PROBE_DUP 0u
#endif
#ifndef PROBE_EXTRA
#define PROBE_EXTRA 1
#endif
#define GAS __attribute__((address_space(1)))
#define LAS __attribute__((address_space(3)))
typedef unsigned short bf16;
typedef unsigned v4u __attribute__((ext_vector_type(4)));
typedef unsigned v2u __attribute__((ext_vector_type(2)));
typedef float f32x4 __attribute__((ext_vector_type(4)));
typedef float f32x2 __attribute__((ext_vector_type(2)));
typedef short bf16x8 __attribute__((ext_vector_type(8)));

constexpr int M_TOK = 8192, SEQ = 2048, DM = 2048;
constexpr int EVP = 6656, ODP = 7424;
constexpr int FF = 5632, FE = 2816, NEXP = 8;
constexpr int NPHASE = 22;

constexpr size_t MiB = 1u << 20;
constexpr size_t WS_CTL = 0, CTL_ZERO_BYTES = 1 * MiB;
constexpr size_t WS_WLORA = 1 * MiB, WS_WEVIN = 4 * MiB, WS_WEVOUT = 30 * MiB, WS_WFGU = 38 * MiB, WS_WFD = 82 * MiB;
constexpr size_t WS_WODIN = 104 * MiB, WS_WODOUT = 133 * MiB, WS_WMGU = 141 * MiB, WS_WMD = 317 * MiB;
constexpr size_t WS_XN = 405 * MiB, WS_Y = 437 * MiB, WS_X1 = 469 * MiB, WS_SCR = 533 * MiB;
constexpr size_t SC_U = WS_SCR, SC_LW = WS_SCR + 104 * MiB, SC_LA = WS_SCR + 136 * MiB, SC_LG = WS_SCR + 168 * MiB, SC_ALORA = WS_SCR + 200 * MiB;
constexpr size_t SC_YRAW_E = WS_SCR + 208 * MiB, SC_MLQK = WS_SCR + 240 * MiB, SC_HRAW = WS_SCR + 272 * MiB;
constexpr size_t SC_DEN = WS_SCR + 304 * MiB;
constexpr size_t SC_ACT = WS_SCR;
constexpr size_t SC_XBC = WS_SCR + 116 * MiB, SC_ORAW = WS_SCR + 180 * MiB, SC_YRAW_O = WS_SCR + 212 * MiB;
constexpr int MOE_MAXROWS = 18432;
constexpr size_t SC_HS = WS_SCR, SC_ACTS = WS_SCR + 72 * MiB, SC_OUTS = WS_SCR + 171 * MiB;
constexpr size_t SC_TOPK = WS_SCR + 316 * MiB, SC_POS = SC_TOPK + 131072, SC_CNT = SC_POS + 65536, SC_TILES = SC_CNT + 8192;
constexpr size_t WS_END = WS_SCR + 317 * MiB;
static_assert(SC_OUTS + (size_t)MOE_MAXROWS * DM * 4 <= SC_TOPK, "moe map");
static_assert(WS_END <= 907708384ull, "d_ws map exceeds the guaranteed workspace");
constexpr int CW_BAR = 4096;

constexpr int RING_BYTES = 131072, MISC_OFF = RING_BYTES + 320, LDS_BYTES = 147456;

__device__ __forceinline__ float bf2f(bf16 b) { return __uint_as_float(((unsigned)b) << 16); }
__device__ __forceinline__ unsigned f2bf(float f) { unsigned u = __float_as_uint(f); return (u + 0x7fffu + ((u >> 16) & 1u)) >> 16; }
typedef __bf16 bf16v2 __attribute__((ext_vector_type(2)));
__device__ __forceinline__ unsigned cvt_pk_bf16(float lo, float hi) { const bf16v2 v = {(__bf16)lo, (__bf16)hi}; return __builtin_bit_cast(unsigned, v); }
__device__ __forceinline__ float sigmoidf_(float x) { return 1.0f / (1.0f + __expf(-x)); }
__device__ __forceinline__ float siluf_(float x) { return x / (1.0f + __expf(-x)); }
__device__ __forceinline__ float wave_sum(float v) {
#pragma unroll
    for (int o = 1; o < 64; o <<= 1) v += __shfl_xor(v, o);
    return v;
}
template <int CTRL> __device__ __forceinline__ float dppf(float v) { return __builtin_bit_cast(float, __builtin_amdgcn_mov_dpp(__builtin_bit_cast(int, v), CTRL, 0xf, 0xf, false)); }
__device__ __forceinline__ float allred16(float v) { v += dppf<0x128>(v); v += dppf<0x124>(v); v += dppf<0x122>(v); v += dppf<0x121>(v); return v; }

namespace pg8 {
#define PG8_LAS __attribute__((address_space(3)))
typedef unsigned short bf16_t;
typedef unsigned u32x4 __attribute__((ext_vector_type(4)));
constexpr int BM = 256, BK = 64, HALF = 128, HTB = HALF * BK * 2, STAGE_BYTES = 8 * HTB, NXCD = 8, WGM = 8;
__host__ __device__ __forceinline__ int lds_byte(int r, int c) { const int st = (r >> 4) * 2 + (c >> 5), rr = r & 15, cc = c & 31, ob = rr * 64 + cc * 2; return st * 1024 + (ob ^ (((ob >> 9) & 1) << 5)); }
__host__ __device__ __forceinline__ void stage_rc(int b, int& R, int& C) { const int st = b / 1024, sb = b % 1024, swz = sb ^ (((sb >> 9) & 1) << 5); R = (st >> 1) * 16 + swz / 64; C = (st & 1) * 32 + (swz % 64) / 2; }
__host__ __device__ __forceinline__ int perm32(int rho) { const int n = rho >> 4, i = rho & 15; return 8 * (i >> 2) + 4 * n + (i & 3); }

struct Unit { int pm, pn, pc; };
struct Gemm { const bf16_t* A; const bf16_t* Bt; int M, N, K; };

struct StaticOrder {
    int nM, nN, nwg, G, c;
    __device__ void init(int M, int N, int G_, int c_) { nM = M / BM; nN = N / BM; nwg = nM * nN; G = G_; c = c_; }
    __device__ bool next(int i, Unit& u) const {
        const long L = (long)i * G + c; if (L >= nwg) return false;
        int wgid = (int)L; { const int q = nwg / NXCD, r = nwg % NXCD, xcd = wgid % NXCD, off = wgid / NXCD; wgid = (xcd < r ? xcd * (q + 1) : r * (q + 1) + (xcd - r) * q) + off; }
        const int nig = WGM * nN, gid = wgid / nig, fm = gid * WGM, gsz = (nM - fm) < WGM ? (nM - fm) : WGM;
        u.pm = fm + ((wgid % nig) % gsz); u.pn = (wgid % nig) / gsz; u.pc = u.pn; return true;
    }
    __device__ __forceinline__ void a_ready(const Unit&) const {}
    __device__ __forceinline__ void done(const Unit&) const {}
};
struct GroupedOrder {
    const int* tile_e; int NT, npn, G, c;
    __device__ bool next(int i, Unit& u) const {
        const long L = (long)i * G + c; if (L >= (long)NT * npn) return false;
        const int t = (int)(L % NT), pnl = (int)(L / NT);
        const int e = __builtin_amdgcn_readfirstlane(tile_e[t]);
        u.pm = t; u.pn = e * npn + pnl; u.pc = pnl; return true;
    }
    __device__ __forceinline__ void a_ready(const Unit&) const {}
    __device__ __forceinline__ void done(const Unit&) const {}
};

struct EpiBf16 {
    static constexpr bool PERM = true;
    bf16_t* O; int ldc;
    __device__ __forceinline__ void operator()(const f32x4 (&acc)[2][2][4][2], const Unit& u, int wr, int wc, int fr, int fq) const {
        const int row0 = u.pm * BM + wr * 64 + fr, col0 = u.pc * BM + wc * 32 + 8 * fq;
#pragma unroll
        for (int ai = 0; ai < 2; ++ai)
#pragma unroll
            for (int m = 0; m < 4; ++m) { bf16_t* rowp = O + (size_t)(row0 + ai * HALF + m * 16) * ldc + col0;
#pragma unroll
                for (int bj = 0; bj < 2; ++bj) { const f32x4 v0 = acc[ai][bj][m][0], v1 = acc[ai][bj][m][1];
                    u32x4 w; w.x = cvt_pk_bf16(v0[0], v0[1]); w.y = cvt_pk_bf16(v0[2], v0[3]); w.z = cvt_pk_bf16(v1[0], v1[1]); w.w = cvt_pk_bf16(v1[2], v1[3]);
                    *(u32x4*)(rowp + bj * HALF) = w; } }
    }
};
struct EpiSwiGLU {
    static constexpr bool PERM = true;
    bf16_t* O; int ldc;
    __device__ __forceinline__ void operator()(const f32x4 (&acc)[2][2][4][2], const Unit& u, int wr, int wc, int fr, int fq) const {
        const int row0 = u.pm * BM + wr * 64 + fr, col0 = u.pc * HALF + wc * 32 + 8 * fq;
#pragma unroll
        for (int ai = 0; ai < 2; ++ai)
#pragma unroll
            for (int m = 0; m < 4; ++m) { bf16_t* rowp = O + (size_t)(row0 + ai * HALF + m * 16) * ldc + col0;
                float r[8];
#pragma unroll
                for (int n = 0; n < 2; ++n)
#pragma unroll
                    for (int j = 0; j < 4; ++j) { const float g = acc[ai][0][m][n][j], up = acc[ai][1][m][n][j]; r[n * 4 + j] = g * __builtin_amdgcn_rcpf(1.0f + __expf(-g)) * up; }
                u32x4 w; w.x = cvt_pk_bf16(r[0], r[1]); w.y = cvt_pk_bf16(r[2], r[3]); w.z = cvt_pk_bf16(r[4], r[5]); w.w = cvt_pk_bf16(r[6], r[7]);
                *(u32x4*)rowp = w; }
    }
};
struct EpiResF32 {
    static constexpr bool PERM = false;
    const float* res; float* out; int ldc;
    __device__ __forceinline__ void operator()(const f32x4 (&acc)[2][2][4][2], const Unit& u, int wr, int wc, int fr, int fq) const {
        const int row0 = u.pm * BM + wr * 64 + fr, col0 = u.pc * BM + wc * 32 + 4 * fq;
#pragma unroll
        for (int ai = 0; ai < 2; ++ai)
#pragma unroll
            for (int m = 0; m < 4; ++m) { const size_t off = (size_t)(row0 + ai * HALF + m * 16) * ldc + col0;
#pragma unroll
                for (int bj = 0; bj < 2; ++bj)
#pragma unroll
                    for (int n = 0; n < 2; ++n) { f32x4 v = acc[ai][bj][m][n]; if (res) v = v + *(const f32x4*)(res + off + bj * HALF + n * 16); *(f32x4*)(out + off + bj * HALF + n * 16) = v; } }
    }
};
struct EpiLora {
    static constexpr bool PERM = false;
    float* LWAG; const float* w0; const float* a0;
    __device__ __forceinline__ void operator()(const f32x4 (&acc)[2][2][4][2], const Unit& u, int wr, int wc, int fr, int fq) const {
        const int kind = u.pc >> 2; const int row0 = u.pm * BM + wr * 64 + fr, col0 = (u.pc & 3) * BM + wc * 32 + 4 * fq;
        float* dst = LWAG + (size_t)kind * ((size_t)8192 * 1024); const float* bias = kind == 0 ? w0 : a0;
#pragma unroll
        for (int bj = 0; bj < 2; ++bj)
#pragma unroll
            for (int n = 0; n < 2; ++n) { const int c = col0 + bj * HALF + n * 16; f32x4 bv = (f32x4){0.f, 0.f, 0.f, 0.f}; if (kind < 2) bv = *(const f32x4*)(bias + c);
#pragma unroll
                for (int ai = 0; ai < 2; ++ai)
#pragma unroll
                    for (int m = 0; m < 4; ++m) { f32x4 v = acc[ai][bj][m][n] + bv;
                        if (kind < 2) {
#pragma unroll
                            for (int j = 0; j < 4; ++j) { const float s = 1.0f / (1.0f + __expf(-v[j])); v[j] = kind == 0 ? (-0.6065306597126334f * s) : s; } }
                        *(f32x4*)(dst + (size_t)(row0 + ai * HALF + m * 16) * 1024 + c) = v; } }
    }
};

template <class Epi, class Sched, bool ALIGN_EPI, bool SP2>
__device__ __forceinline__ void gemm_phase(PG8_LAS unsigned char* lds, const Gemm g, const Sched& S, const Epi& E) {
    const int tid = threadIdx.x, wid = __builtin_amdgcn_readfirstlane(tid >> 6), lane = tid & 63, wr = wid >> 2, wc = wid & 3, fr = lane & 15, fq = lane >> 4;
    const int K = g.K, nt = K / BK;
    unsigned voffA[2], voffB[2];
#pragma unroll
    for (int i = 0; i < 2; ++i) { int R, C; stage_rc(tid * 16 + i * 8192, R, C); const int Rb = Epi::PERM ? ((R & ~31) + perm32(R & 31)) : R;
        voffA[i] = (unsigned)(R * K + C) * 2u; voffB[i] = (unsigned)(Rb * K + C) * 2u; }
    const size_t kstep = (size_t)(BK * 2);
    const size_t hstep = (size_t)HALF * K * 2;
    const size_t tstep = 2 * hstep;
    const unsigned ldsw = (unsigned)wid * 1024u;
    const int aoff = lds_byte(wr * 64 + fr, fq * 8), boff = lds_byte(wc * 32 + fr, fq * 8);
#define PG8_SA(b, h) (((b) * 2 + (h)) * HTB)
#define PG8_SB(b, h) ((4 + (b) * 2 + (h)) * HTB)
#define PG8_STAGE(bufoff, gbase, voff) do { _Pragma("unroll") for (int _i = 0; _i < 2; ++_i) \
        __builtin_amdgcn_global_load_lds((const unsigned*)((const char*)(gbase) + (voff)[_i]), (PG8_LAS unsigned*)(lds + (bufoff) + ldsw + _i * 8192), 16, 0, 0); } while (0)
#define PG8_LDA(dst, b, h) do { _Pragma("unroll") for (int m = 0; m < 4; ++m) _Pragma("unroll") for (int k = 0; k < 2; ++k) dst[m][k] = *(const PG8_LAS bf16x8*)(lds + PG8_SA(b, h) + aoff + m * 2048 + k * 1024); } while (0)
#define PG8_LDB(dst, b, h) do { _Pragma("unroll") for (int n = 0; n < 2; ++n) _Pragma("unroll") for (int k = 0; k < 2; ++k) dst[n][k] = *(const PG8_LAS bf16x8*)(lds + PG8_SB(b, h) + boff + n * 2048 + k * 1024); } while (0)
#define PG8_MMA(ai, bj, At, Bt) do { __builtin_amdgcn_s_setprio(1); _Pragma("unroll") for (int m = 0; m < 4; ++m) _Pragma("unroll") for (int n = 0; n < 2; ++n) _Pragma("unroll") for (int k = 0; k < 2; ++k) \
        acc[ai][bj][m][n] = __builtin_amdgcn_mfma_f32_16x16x32_bf16(Bt[n][k], At[m][k], acc[ai][bj][m][n], 0, 0, 0); __builtin_amdgcn_s_setprio(0); } while (0)
#define PG8_WAIT_V(n) asm volatile("s_waitcnt vmcnt(" #n ")" ::: "memory")
#define PG8_WAIT_L(n) asm volatile("s_waitcnt lgkmcnt(" #n ")" ::: "memory")
#define PG8_BAR __builtin_amdgcn_s_barrier()
#define PG8_SCHED __builtin_amdgcn_sched_barrier(0)
    Unit cur, nxt; int ui = 0;
    if (!S.next(0, cur)) return;
    f32x4 acc[2][2][4][2];
#pragma unroll
    for (int a = 0; a < 2; ++a)
#pragma unroll
        for (int b = 0; b < 2; ++b)
#pragma unroll
            for (int m = 0; m < 4; ++m)
#pragma unroll
                for (int n = 0; n < 2; ++n) acc[a][b][m][n] = (f32x4){0.f, 0.f, 0.f, 0.f};
    bf16x8 At[4][2], B0[2][2], B1[2][2];
    const char* cA = (const char*)g.A + (size_t)cur.pm * tstep; const char* cB = (const char*)g.Bt + (size_t)cur.pn * tstep;
    S.a_ready(cur);
    if constexpr (SP2) {
        PG8_STAGE(PG8_SB(0, 0), cB, voffB); PG8_STAGE(PG8_SB(0, 1), cB + hstep, voffB); PG8_STAGE(PG8_SA(0, 0), cA, voffA); PG8_STAGE(PG8_SA(0, 1), cA + hstep, voffA);
        if (wr == 1) PG8_BAR;
        PG8_WAIT_V(2); PG8_BAR;
        PG8_STAGE(PG8_SB(1, 0), cB + kstep, voffB); PG8_STAGE(PG8_SA(1, 0), cA + kstep, voffA); PG8_STAGE(PG8_SB(1, 1), cB + hstep + kstep, voffB);
        PG8_WAIT_V(6); PG8_BAR;
    } else {
        PG8_STAGE(PG8_SB(0, 0), cB, voffB); PG8_STAGE(PG8_SA(0, 0), cA, voffA); PG8_STAGE(PG8_SB(0, 1), cB + hstep, voffB); PG8_STAGE(PG8_SA(0, 1), cA + hstep, voffA);
        if (wr == 1) PG8_BAR;
        PG8_WAIT_V(4); PG8_BAR;
        PG8_STAGE(PG8_SB(1, 0), cB + kstep, voffB); PG8_STAGE(PG8_SA(1, 0), cA + kstep, voffA); PG8_STAGE(PG8_SB(1, 1), cB + hstep + kstep, voffB);
        PG8_WAIT_V(6); PG8_BAR;
    }
    for (;;) {
        const bool has_next = S.next(ui + 1, nxt);
        const char* nA = has_next ? (const char*)g.A + (size_t)nxt.pm * tstep : cA; const char* nB = has_next ? (const char*)g.Bt + (size_t)nxt.pn * tstep : cB;
        for (int t = 0; t < nt; t += 2) {
            const bool last = (t == nt - 2);
            const char* a1 = cA + (size_t)(t + 1) * kstep;
            const char* a2 = last ? nA : cA + (size_t)(t + 2) * kstep; const char* b2 = last ? nB : cB + (size_t)(t + 2) * kstep;
            const char* a3 = a2 + kstep; const char* b3 = b2 + kstep;
            if (last && has_next) S.a_ready(nxt);
            if constexpr (SP2) {
            PG8_LDB(B0, 0, 0); PG8_LDB(B1, 0, 1); PG8_SCHED; PG8_LDA(At, 0, 0); PG8_STAGE(PG8_SA(1, 1), a1 + hstep, voffA);
            PG8_WAIT_V(8); PG8_WAIT_L(0); PG8_BAR; PG8_MMA(0, 0, At, B0); PG8_MMA(0, 1, At, B1); PG8_BAR; PG8_SCHED;
            PG8_LDA(At, 0, 1); PG8_STAGE(PG8_SB(0, 0), b2, voffB); PG8_STAGE(PG8_SB(0, 1), b2 + hstep, voffB); PG8_STAGE(PG8_SA(0, 0), a2, voffA);
            PG8_WAIT_V(8); PG8_WAIT_L(0); PG8_BAR; PG8_MMA(1, 0, At, B0); PG8_MMA(1, 1, At, B1); PG8_BAR; PG8_SCHED;
            PG8_LDB(B0, 1, 0); PG8_LDB(B1, 1, 1); PG8_SCHED; PG8_LDA(At, 1, 0); PG8_STAGE(PG8_SA(0, 1), a2 + hstep, voffA);
            PG8_WAIT_V(8); PG8_WAIT_L(0); PG8_BAR; PG8_MMA(0, 0, At, B0); PG8_MMA(0, 1, At, B1); PG8_BAR; PG8_SCHED;
            PG8_LDA(At, 1, 1); PG8_STAGE(PG8_SB(1, 0), b3, voffB); PG8_STAGE(PG8_SB(1, 1), b3 + hstep, voffB); PG8_STAGE(PG8_SA(1, 0), a3, voffA);
            PG8_WAIT_V(8); PG8_WAIT_L(0); PG8_BAR; PG8_MMA(1, 0, At, B0); PG8_MMA(1, 1, At, B1); PG8_BAR; PG8_SCHED;
            } else {
            PG8_LDB(B0, 0, 0); PG8_SCHED; PG8_LDA(At, 0, 0); PG8_STAGE(PG8_SA(1, 1), a1 + hstep, voffA);
            PG8_WAIT_L(8); PG8_BAR; PG8_WAIT_L(0); PG8_MMA(0, 0, At, B0); PG8_BAR; PG8_SCHED;
            PG8_LDB(B1, 0, 1); PG8_STAGE(PG8_SB(0, 0), b2, voffB);
            PG8_BAR; PG8_WAIT_L(0); PG8_MMA(0, 1, At, B1); PG8_BAR;
            PG8_LDA(At, 0, 1); PG8_STAGE(PG8_SA(0, 0), a2, voffA);
            PG8_BAR; PG8_WAIT_L(0); PG8_MMA(1, 0, At, B0); PG8_BAR; PG8_SCHED;
            PG8_STAGE(PG8_SB(0, 1), b2 + hstep, voffB);
            PG8_WAIT_V(6); PG8_BAR; PG8_MMA(1, 1, At, B1); PG8_BAR;
            PG8_LDB(B0, 1, 0); PG8_SCHED; PG8_LDA(At, 1, 0); PG8_STAGE(PG8_SA(0, 1), a2 + hstep, voffA);
            PG8_WAIT_L(8); PG8_BAR; PG8_WAIT_L(0); PG8_MMA(0, 0, At, B0); PG8_BAR; PG8_SCHED;
            PG8_LDB(B1, 1, 1); PG8_STAGE(PG8_SB(1, 0), b3, voffB);
            PG8_BAR; PG8_WAIT_L(0); PG8_MMA(0, 1, At, B1); PG8_BAR;
            PG8_LDA(At, 1, 1); PG8_STAGE(PG8_SA(1, 0), a3, voffA);
            PG8_BAR; PG8_WAIT_L(0); PG8_MMA(1, 0, At, B0); PG8_BAR; PG8_SCHED;
            PG8_STAGE(PG8_SB(1, 1), b3 + hstep, voffB);
            PG8_WAIT_V(6); PG8_BAR; PG8_MMA(1, 1, At, B1); PG8_BAR;
            }
        }
        if constexpr (ALIGN_EPI) { if (wr == 0) PG8_BAR; }
        E(acc, cur, wr, wc, fr, fq); S.done(cur);
        if (!has_next) break;
#pragma unroll
        for (int a = 0; a < 2; ++a)
#pragma unroll
            for (int b = 0; b < 2; ++b)
#pragma unroll
                for (int m = 0; m < 4; ++m)
#pragma unroll
                    for (int n = 0; n < 2; ++n) acc[a][b][m][n] = (f32x4){0.f, 0.f, 0.f, 0.f};
        cur = nxt; cA = nA; cB = nB; ++ui;
        if constexpr (ALIGN_EPI) { if (wr == 1) PG8_BAR; }
    }
    PG8_WAIT_V(0);
    if constexpr (!ALIGN_EPI) { if (wr == 0) PG8_BAR; }
    PG8_BAR;
#undef PG8_SA
#undef PG8_SB
#undef PG8_STAGE
#undef PG8_LDA
#undef PG8_LDB
#undef PG8_MMA
#undef PG8_WAIT_V
#undef PG8_WAIT_L
#undef PG8_BAR
#undef PG8_SCHED
}
}

#define XB_TMO      128
#define XB_XCNT(j)  (256  + 64 * (j))
#define XB_XSUB(j)  (1280 + 64 * (j))
#define XB_XGEN(j)  (2304 + 64 * (j))
#define XB_TOP      3328
#define XB_TOPGEN   3392
#define XCD_BAR_WORDS 3456
#define XB_SPIN_CAP (1u << 18)
__device__ __forceinline__ unsigned xb_ld(unsigned* p)              { return __hip_atomic_load(p, __ATOMIC_RELAXED, __HIP_MEMORY_SCOPE_AGENT); }
__device__ __forceinline__ unsigned xb_add(unsigned* p, unsigned v) { return __hip_atomic_fetch_add(p, v, __ATOMIC_RELAXED, __HIP_MEMORY_SCOPE_AGENT); }
__device__ __forceinline__ unsigned xb_xcc_id() { return (unsigned)__builtin_amdgcn_s_getreg((3 << 11) | 20) & 0xFu; }
#define XB_SPIN(cond, bar) do { unsigned _sp = 0; while (cond) { __builtin_amdgcn_s_sleep(1); \
    if ((++_sp & 255u) == 0u) { if (xb_ld(&(bar)[XB_TMO])) break; if (_sp > XB_SPIN_CAP) { atomicAdd(&(bar)[XB_TMO], 1u); break; } } } } while (0)
struct XcdBarrier { unsigned* bar; unsigned x; volatile LAS unsigned* st; };
__device__ __forceinline__ XcdBarrier xcd_barrier_post(unsigned* bar, volatile LAS unsigned* st) {
    XcdBarrier b; b.bar = bar; b.x = xb_xcc_id(); b.st = st;
    if (threadIdx.x == 0) (void)xb_add(&bar[XB_XCNT(b.x)], 1u);
    return b;
}
__device__ __forceinline__ void xcd_barrier_complete(unsigned* bar, unsigned x, unsigned& nloc, unsigned& nx) {
    const unsigned G = gridDim.x * gridDim.y * gridDim.z;
    unsigned sum, cnt, mine, sp = 0u;
    for (;;) {
        sum = 0u; cnt = 0u; mine = 0u;
#pragma unroll
        for (unsigned j = 0; j < 16; ++j) { const unsigned c = xb_ld(&bar[XB_XCNT(j)]); sum += c; cnt += (c > 0u) ? 1u : 0u; mine = (j == x) ? c : mine; }
        if (sum == G) break;
        __builtin_amdgcn_s_sleep(1);
        if ((++sp & 255u) == 0u) { if (xb_ld(&bar[XB_TMO])) break; if (sp > XB_SPIN_CAP) { atomicAdd(&bar[XB_TMO], 1u); break; } }
    }
    nloc = mine > 0u ? mine : 1u; nx = cnt > 0u ? cnt : 1u;
}
__device__ __forceinline__ void xcd_barrier(const XcdBarrier& b) {
    asm volatile("s_waitcnt vmcnt(0)" ::: "memory");
    __syncthreads();
    if (threadIdx.x == 0) {
        unsigned* bar = b.bar;
        __builtin_amdgcn_s_waitcnt(0);
        unsigned nloc = b.st[0], nx = b.st[1];
        if (nloc == 0u) { xcd_barrier_complete(bar, b.x, nloc, nx); b.st[0] = nloc; b.st[1] = nx; }
        const unsigned old = xb_add(&bar[XB_XSUB(b.x)], 1u);
        const unsigned gen = old / nloc;
        if (old + 1u == (gen + 1u) * nloc) {
            __builtin_amdgcn_fence(__ATOMIC_RELEASE, "agent");
            asm volatile("s_waitcnt vmcnt(0)" ::: "memory");
            const unsigned og = xb_add(&bar[XB_TOP], 1u);
            const unsigned tg = og / nx;
            if (og + 1u == (tg + 1u) * nx) xb_add(&bar[XB_TOPGEN], 1u);
            else XB_SPIN(xb_ld(&bar[XB_TOPGEN]) == tg, bar);
            __builtin_amdgcn_fence(__ATOMIC_ACQUIRE, "agent");
            xb_add(&bar[XB_XGEN(b.x)], 1u);
            asm volatile("s_waitcnt vmcnt(0)" ::: "memory");
        } else {
            XB_SPIN(xb_ld(&bar[XB_XGEN(b.x)]) == gen, bar);
            __builtin_amdgcn_fence(__ATOMIC_ACQUIRE, "agent");
            asm volatile("s_waitcnt vmcnt(0)" ::: "memory");
        }
    }
    __syncthreads();
}

struct Ctx { LAS unsigned char* lds; int tid, lane, wave, bid, G; };

struct ConvTile { const float* W; bf16* WT; int K, N, mode, k0, n0; };
__device__ __forceinline__ void conv_load(const ConvTile& t, f32x4 (&rg)[4], int tid) {
    const int nc = (tid & 15) * 4, kr = tid >> 4;
#pragma unroll
    for (int i = 0; i < 4; ++i) rg[i] = (t.n0 + nc < t.N) ? *(const f32x4*)(t.W + (size_t)(t.k0 + kr + 32 * i) * t.N + t.n0 + nc) : (f32x4){0.f, 0.f, 0.f, 0.f};
}
__device__ __forceinline__ void conv_emit(const ConvTile& t, const f32x4 (&rg)[4], LAS float* scr, int tid) {
    { const int nc = (tid & 15) * 4, kr = tid >> 4;
#pragma unroll
      for (int i = 0; i < 4; ++i) { LAS float* d = scr + (kr + 32 * i) * 65 + nc; d[0] = rg[i].x; d[1] = rg[i].y; d[2] = rg[i].z; d[3] = rg[i].w; } }
    __syncthreads();
#pragma unroll
    for (int h = 0; h < 2; ++h) { const int id = tid + 512 * h, nn = id >> 4, kc = id & 15; float v[8];
#pragma unroll
        for (int j = 0; j < 8; ++j) v[j] = scr[(kc * 8 + j) * 65 + nn];
        const int ns = t.n0 + nn; const int drow = t.mode == 0 ? ns : ((ns >> 7) * 256 + (ns & 127) + (t.mode == 2 ? 128 : 0));
        v4u o; o.x = cvt_pk_bf16(v[0], v[1]); o.y = cvt_pk_bf16(v[2], v[3]); o.z = cvt_pk_bf16(v[4], v[5]); o.w = cvt_pk_bf16(v[6], v[7]);
        *(v4u*)(t.WT + (size_t)drow * t.K + t.k0 + kc * 8) = o; }
    __syncthreads();
}
struct ConvKind { const float* W; bf16* WT; int K, N, Npad, mode, nmat; size_t sstr, dstr; };
__device__ __forceinline__ bool conv_item(const ConvKind (&kinds)[10], int item, ConvTile& t) {
    bool found = false;
#pragma unroll
    for (int q = 0; q < 10; ++q) { const int nkt = kinds[q].K / 128, nnt = kinds[q].Npad / 64, per = nkt * nnt, cnt = per * kinds[q].nmat;
        if (!found && item < cnt) { const int mat = item / per, r = item % per; t.W = kinds[q].W + (size_t)mat * kinds[q].sstr; t.WT = kinds[q].WT + (size_t)mat * kinds[q].dstr; t.K = kinds[q].K; t.N = kinds[q].N; t.mode = kinds[q].mode;
            t.k0 = (r / nnt) * 128; t.n0 = (r % nnt) * 64; found = true; }
        if (!found) item -= cnt; }
    return found;
}
__device__ __forceinline__ void rmsnorm_row_bf16(const float* xr, const float* w, bf16* orow, int lane) {
    f32x4 v[8]; float ss = 0.f;
#pragma unroll
    for (int j = 0; j < 8; ++j) { v[j] = *(const f32x4*)(xr + 4 * lane + 256 * j); ss += (v[j].x * v[j].x + v[j].y * v[j].y) + (v[j].z * v[j].z + v[j].w * v[j].w); }
    const float rs = 1.0f / sqrtf(wave_sum(ss) * (1.0f / 2048.0f) + 1e-6f);
#pragma unroll
    for (int j = 0; j < 8; ++j) { const f32x4 wv = *(const f32x4*)(w + 4 * lane + 256 * j); const f32x4 o = v[j] * rs * wv;
        v2u p; p.x = cvt_pk_bf16(o.x, o.y); p.y = cvt_pk_bf16(o.z, o.w); *(v2u*)(orow + 4 * lane + 256 * j) = p; }
}
__device__ __forceinline__ void rmsnorm_phase(const Ctx& c, const float* X, const float* w, bf16* XN) {
    const int gw = c.bid * 8 + c.wave, NGW = c.G * 8;
    for (int m = gw; m < M_TOK; m += NGW) rmsnorm_row_bf16(X + (size_t)m * DM, w, XN + (size_t)m * DM, c.lane);
}

__device__ __forceinline__ LAS unsigned char* launder_lds(LAS unsigned char* p) {
#if defined(__HIP_DEVICE_COMPILE__)
    unsigned v = __builtin_bit_cast(unsigned, p); asm volatile("" : "+v"(v)); return __builtin_bit_cast(LAS unsigned char*, v);
#else
    return p;
#endif
}
__device__ __forceinline__ bf16x8 frag_row(const LAS bf16* img, int stride, int r0, int k0, int lane) { return *(const LAS bf16x8*)(img + (r0 + (lane & 15)) * stride + k0 + 8 * (lane >> 4)); }
typedef short s16x4 __attribute__((ext_vector_type(4)));
__device__ __forceinline__ bf16x8 frag_tr(const LAS bf16* img, int stride, int n0, int k0, int lane) {
    const int g = lane >> 4, qq = (lane & 15) >> 2, pp = lane & 3;
    const LAS bf16* p0 = img + (k0 + 8 * g + qq) * stride + n0 + 4 * pp;
#if defined(__HIP_DEVICE_COMPILE__)
    const s16x4 lo = __builtin_amdgcn_ds_read_tr16_b64_v4i16((LAS s16x4*)p0), hi = __builtin_amdgcn_ds_read_tr16_b64_v4i16((LAS s16x4*)(p0 + 4 * stride));
#else
    const s16x4 lo = (s16x4){0, 0, 0, 0}, hi = lo; (void)p0;
#endif
    return (bf16x8){lo.x, lo.y, lo.z, lo.w, hi.x, hi.y, hi.z, hi.w};
}
__device__ __forceinline__ v4u pack8(const f32x4 a, const f32x4 b) { v4u o; o.x = cvt_pk_bf16(a[0], a[1]); o.y = cvt_pk_bf16(a[2], a[3]); o.z = cvt_pk_bf16(b[0], b[1]); o.w = cvt_pk_bf16(b[2], b[3]); return o; }
__device__ __forceinline__ float softplusf_(float x) { return x > 20.0f ? x : log1pf(__expf(x)); }

template <bool ML>
__device__ __forceinline__ void chunk_scan(const Ctx& c, int task, const bf16* U, const float* SRC, const float* par0, const float* par1, const float* par2, float* OUTP, float* DEN) {
    constexpr int NP = ML ? 5 : 4, SX = 88, S1 = 136, SM = 72, UP = ML ? EVP : ODP;
    int batch, head, slice;
    if (ML) { slice = task & 3; head = (task >> 2) & 3; batch = task >> 4; } else { slice = 0; head = task & 15; batch = task >> 4; }
    const int lane = c.lane, w = c.wave, r = lane & 15, q = lane >> 4, trow = c.tid >> 3, part = c.tid & 7;
    const float g0 = ML ? par0[head] : par0[head];
    const float g1 = ML ? par1[head] : -__expf(par1[head]);
    const float Dh = ML ? 0.f : par2[head];
    const int qoff = ML ? head * 128 : 1536 + (head >> 2) * 128, koff = ML ? 512 + head * 128 : 1024 + (head >> 2) * 128, srcw = ML ? 1024 : 2048;
    f32x4 Hacc[NP];
#pragma unroll
    for (int i = 0; i < NP; ++i) Hacc[i] = (f32x4){0.f, 0.f, 0.f, 0.f};
    f32x4 rc[4], rb[4], rx[2]; v4u rv; float gr0, gr1;
#define CS_LOAD(ch) do { const size_t m_ = (size_t)batch * SEQ + (ch) * 64 + trow; const float* sr_ = SRC + m_ * srcw; \
        _Pragma("unroll") for (int i_ = 0; i_ < 4; ++i_) { rc[i_] = *(const f32x4*)(sr_ + qoff + 16 * part + 4 * i_); rb[i_] = *(const f32x4*)(sr_ + koff + 16 * part + 4 * i_); } \
        if (ML) rv = *(const v4u*)(U + m_ * UP + 4544 + head * 256 + slice * 64 + 8 * part); else { rx[0] = *(const f32x4*)(sr_ + head * 64 + 8 * part); rx[1] = *(const f32x4*)(sr_ + head * 64 + 8 * part + 4); } \
        const bf16* ug_ = U + ((size_t)batch * SEQ + (ch) * 64 + lane) * UP; \
        if (ML) { gr0 = bf2f(ug_[6592 + head]); gr1 = bf2f(ug_[6596 + head]); } else { gr0 = bf2f(ug_[7168 + head]); gr1 = 0.f; } } while (0)
    CS_LOAD(0);
    for (int ch = 0; ch < 32; ++ch) {
        LAS bf16* Cb = (LAS bf16*)launder_lds(c.lds); LAS bf16* Bb = Cb + 64 * S1; LAS bf16* Ce = Bb + 64 * S1; LAS bf16* Hb = Ce + 64 * S1; LAS bf16* Xs = Hb + 80 * S1; LAS bf16* Xw = Xs + 64 * SX; LAS bf16* Mm = Xw + 64 * SX;
        LAS float* cumL = (LAS float*)(Mm + 64 * SM); LAS float* wL = cumL + 64;
        float a_t, wgt;
        if (ML) { wgt = __expf(gr0 + g0); a_t = -softplusf_(-(gr1 + g1)); } else { wgt = softplusf_(gr0 + g0); a_t = g1 * wgt; }
        float cum = a_t;
#pragma unroll
        for (int o = 1; o < 64; o <<= 1) { const float v_ = __shfl_up(cum, o); if (lane >= o) cum += v_; }
        const float gtot = __shfl(cum, 63);
        const float cum_t = __shfl(cum, trow), w_t = __shfl(wgt, trow);
        { const float sc = ML ? 0.08838834764831845f : 1.0f; const float et = __expf(cum_t) * sc, wx = w_t * __expf(gtot - cum_t);
          *(v4u*)(Cb + trow * S1 + 16 * part) = pack8(rc[0] * sc, rc[1] * sc); *(v4u*)(Cb + trow * S1 + 16 * part + 8) = pack8(rc[2] * sc, rc[3] * sc);
          *(v4u*)(Ce + trow * S1 + 16 * part) = pack8(rc[0] * et, rc[1] * et); *(v4u*)(Ce + trow * S1 + 16 * part + 8) = pack8(rc[2] * et, rc[3] * et);
          *(v4u*)(Bb + trow * S1 + 16 * part) = pack8(rb[0], rb[1]); *(v4u*)(Bb + trow * S1 + 16 * part + 8) = pack8(rb[2], rb[3]);
          f32x4 x0, x1;
          if (ML) { x0 = (f32x4){__uint_as_float(rv.x << 16), __uint_as_float(rv.x & 0xffff0000u), __uint_as_float(rv.y << 16), __uint_as_float(rv.y & 0xffff0000u)};
                    x1 = (f32x4){__uint_as_float(rv.z << 16), __uint_as_float(rv.z & 0xffff0000u), __uint_as_float(rv.w << 16), __uint_as_float(rv.w & 0xffff0000u)}; }
          else { x0 = rx[0]; x1 = rx[1]; }
          *(v4u*)(Xs + trow * SX + 8 * part) = pack8(x0, x1); *(v4u*)(Xw + trow * SX + 8 * part) = pack8(x0 * wx, x1 * wx);
          if (ML && part == 0) { const f32x4 z = (f32x4){0.f, 0.f, 0.f, 0.f};
              *(v4u*)(Xs + trow * SX + 64) = pack8((f32x4){1.f, 0.f, 0.f, 0.f}, z); *(v4u*)(Xs + trow * SX + 72) = pack8(z, z);
              *(v4u*)(Xw + trow * SX + 64) = pack8((f32x4){wx, 0.f, 0.f, 0.f}, z); *(v4u*)(Xw + trow * SX + 72) = pack8(z, z); }
#pragma unroll
          for (int pt = 0; pt < NP; ++pt) { v2u hp; hp.x = cvt_pk_bf16(Hacc[pt][0], Hacc[pt][1]); hp.y = cvt_pk_bf16(Hacc[pt][2], Hacc[pt][3]); *(v2u*)(Hb + (16 * pt + r) * S1 + 16 * w + 4 * q) = hp; }
          if (w == 0) { cumL[lane] = cum; wL[lane] = wgt; } }
        if (ch + 1 < 32) CS_LOAD(ch + 1);
        __syncthreads();
        { const int tt = w >> 1;
#pragma unroll
          for (int i = 0; i < 2; ++i) { const int ts = 2 * (w & 1) + i; f32x4 acc = (f32x4){0.f, 0.f, 0.f, 0.f};
              if (ts <= tt) {
#pragma unroll
                  for (int kk = 0; kk < 4; ++kk) acc = __builtin_amdgcn_mfma_f32_16x16x32_bf16(frag_row(Bb, S1, 16 * ts, 32 * kk, lane), frag_row(Cb, S1, 16 * tt, 32 * kk, lane), acc, 0, 0, 0);
                  const int t = 16 * tt + r; const float ct = cumL[t];
#pragma unroll
                  for (int j = 0; j < 4; ++j) { const int sj = 16 * ts + 4 * q + j; acc[j] = (sj <= t) ? acc[j] * __expf(ct - cumL[sj]) * wL[sj] : 0.f; } }
              v2u mp; mp.x = cvt_pk_bf16(acc[0], acc[1]); mp.y = cvt_pk_bf16(acc[2], acc[3]); *(v2u*)(Mm + (16 * tt + r) * SM + 16 * ts + 4 * q) = mp; }
          const float eg = __expf(gtot);
#pragma unroll
          for (int pt = 0; pt < NP; ++pt) Hacc[pt] = Hacc[pt] * eg;
#pragma unroll
          for (int ks = 0; ks < 2; ++ks) { const bf16x8 af = frag_tr(Bb, S1, 16 * w, 32 * ks, lane);
#pragma unroll
              for (int pt = 0; pt < NP; ++pt) Hacc[pt] = __builtin_amdgcn_mfma_f32_16x16x32_bf16(af, frag_tr(Xw, SX, 16 * pt, 32 * ks, lane), Hacc[pt], 0, 0, 0); } }
        __syncthreads();
        { const int tt = w >> 1, half = w & 1; const size_t mrow = (size_t)batch * SEQ + ch * 64 + 16 * tt + r;
#pragma unroll
          for (int i = 0; i < 3; ++i) { const int pt = half ? 2 + i : (i < 2 ? i : 4); if ((half && i == 2) || (!ML && i == 2)) continue;
              f32x4 acc = (f32x4){0.f, 0.f, 0.f, 0.f};
#pragma unroll
              for (int ks = 0; ks < 2; ++ks) acc = __builtin_amdgcn_mfma_f32_16x16x32_bf16(frag_tr(Xs, SX, 16 * pt, 32 * ks, lane), frag_row(Mm, SM, 16 * tt, 32 * ks, lane), acc, 0, 0, 0);
#pragma unroll
              for (int kk = 0; kk < 4; ++kk) acc = __builtin_amdgcn_mfma_f32_16x16x32_bf16(frag_row(Hb, S1, 16 * pt, 32 * kk, lane), frag_row(Ce, S1, 16 * tt, 32 * kk, lane), acc, 0, 0, 0);
              if (ML) { if (pt < 4) *(f32x4*)(OUTP + mrow * 1024 + head * 256 + slice * 64 + 16 * pt + 4 * q) = acc; else if (q == 0 && slice == 0) DEN[mrow * 4 + head] = acc[0]; }
              else { const v2u xv = *(const LAS v2u*)(Xs + (16 * tt + r) * SX + 16 * pt + 4 * q);
                     acc[0] += Dh * __uint_as_float(xv.x << 16); acc[1] += Dh * __uint_as_float(xv.x & 0xffff0000u); acc[2] += Dh * __uint_as_float(xv.y << 16); acc[3] += Dh * __uint_as_float(xv.y & 0xffff0000u);
                     *(f32x4*)(OUTP + mrow * 1024 + head * 64 + 16 * pt + 4 * q) = acc; } } }
        __syncthreads();
    }
#undef CS_LOAD
}


__device__ __forceinline__ void chunk_hgrn(const Ctx& c, int task, const bf16* U, const float* lbl, float* ORAW) {
    constexpr int S1 = 136, SX = 72, SM = 72, LFS = 132;
    const int slice = task & 1, head = (task >> 1) & 7, batch = task >> 4;
    constexpr int LBL_OFF = (3 * 64 * S1 + 64 * SX + 64 * SM) * 2 + (64 * LFS + 512) * 4;
    { LAS float* LBL0 = (LAS float*)(c.lds + LBL_OFF); if (c.tid < 128) { const int a = head * 128 + c.tid; LBL0[c.tid] = 1.0f / (1.0f + __expf(lbl[a] - lbl[1024 + a])); } }
    const int lane = c.lane, w = c.wave, r = lane & 15, q = lane >> 4, trow = c.tid >> 3, part = c.tid & 7;
    f32x4 Hacc[4];
#pragma unroll
    for (int i = 0; i < 4; ++i) Hacc[i] = (f32x4){0.f, 0.f, 0.f, 0.f};
    v4u rq[2], rf[2], ri;
#define HG_LOAD(ch) do { const bf16* ur_ = U + ((size_t)batch * SEQ + (ch) * 64 + trow) * ODP; \
        rq[0] = *(const v4u*)(ur_ + head * 128 + 16 * part); rq[1] = *(const v4u*)(ur_ + head * 128 + 16 * part + 8); \
        rf[0] = *(const v4u*)(ur_ + 1024 + head * 128 + 16 * part); rf[1] = *(const v4u*)(ur_ + 1024 + head * 128 + 16 * part + 8); \
        ri = *(const v4u*)(ur_ + 2048 + head * 128 + slice * 64 + 8 * part); } while (0)
#define HG_UNPK(dst, src) do { dst[0] = __uint_as_float((src).x << 16); dst[1] = __uint_as_float((src).x & 0xffff0000u); dst[2] = __uint_as_float((src).y << 16); dst[3] = __uint_as_float((src).y & 0xffff0000u); \
        dst[4] = __uint_as_float((src).z << 16); dst[5] = __uint_as_float((src).z & 0xffff0000u); dst[6] = __uint_as_float((src).w << 16); dst[7] = __uint_as_float((src).w & 0xffff0000u); } while (0)
    HG_LOAD(0);
    __syncthreads();
    for (int ch = 0; ch < 32; ++ch) {
        LAS bf16* Qi = (LAS bf16*)launder_lds(c.lds); LAS bf16* Ki = Qi + 64 * S1; LAS bf16* Hb = Ki + 64 * S1; LAS bf16* Xs = Hb + 64 * S1; LAS bf16* Mm = Xs + 64 * SX;
        LAS float* LF = (LAS float*)(Mm + 64 * SM); LAS float* SEGT = LF + 64 * LFS; LAS float* LBL = SEGT + 512;
#pragma unroll
        for (int h2 = 0; h2 < 2; ++h2) { float fp[8]; HG_UNPK(fp, rf[h2]);
            const f32x4 b0 = *(const LAS f32x4*)(LBL + 16 * part + 8 * h2), b1 = *(const LAS f32x4*)(LBL + 16 * part + 8 * h2 + 4); float lf[8];
#pragma unroll
            for (int j = 0; j < 8; ++j) { const float lbv = j < 4 ? b0[j & 3] : b1[j & 3]; lf[j] = __logf(lbv + (1.0f - lbv) * sigmoidf_(fp[j])); }
            *(LAS f32x4*)(LF + trow * LFS + 16 * part + 8 * h2) = (f32x4){lf[0], lf[1], lf[2], lf[3]}; *(LAS f32x4*)(LF + trow * LFS + 16 * part + 8 * h2 + 4) = (f32x4){lf[4], lf[5], lf[6], lf[7]}; }
        __syncthreads();
        { const int k = c.tid & 127, seg = c.tid >> 7; float run = 0.f;
#pragma unroll
          for (int i = 0; i < 16; ++i) { run += LF[(16 * seg + i) * LFS + k]; LF[(16 * seg + i) * LFS + k] = run; }
          SEGT[seg * 128 + k] = run; }
        __syncthreads();
        { const int seg = trow >> 4;
#pragma unroll
          for (int h2 = 0; h2 < 2; ++h2) { float fp[8], qr[8], qt[8], kt[8]; HG_UNPK(fp, rf[h2]); HG_UNPK(qr, rq[h2]);
#pragma unroll
              for (int j4 = 0; j4 < 2; ++j4) { const int kb = 16 * part + 8 * h2 + 4 * j4;
                  const f32x4 l = *(const LAS f32x4*)(LF + trow * LFS + kb), l31 = *(const LAS f32x4*)(LF + 31 * LFS + kb), bb = *(const LAS f32x4*)(LBL + kb);
                  const f32x4 s0 = *(const LAS f32x4*)(SEGT + kb), s1 = *(const LAS f32x4*)(SEGT + 128 + kb), s2 = *(const LAS f32x4*)(SEGT + 256 + kb);
#pragma unroll
                  for (int e = 0; e < 4; ++e) { float off = 0.f; if (seg > 0) off += s0[e]; if (seg > 1) off += s1[e]; if (seg > 2) off += s2[e];
                      const float d = (l[e] + off) - (l31[e] + s0[e]); const int j = 4 * j4 + e;
                      qt[j] = siluf_(qr[j]) * __expf(d); kt[j] = (1.0f - bb[e]) * (1.0f - sigmoidf_(fp[j])) * __expf(-d); } }
              *(v4u*)(Qi + trow * S1 + 16 * part + 8 * h2) = pack8((f32x4){qt[0], qt[1], qt[2], qt[3]}, (f32x4){qt[4], qt[5], qt[6], qt[7]});
              *(v4u*)(Ki + trow * S1 + 16 * part + 8 * h2) = pack8((f32x4){kt[0], kt[1], kt[2], kt[3]}, (f32x4){kt[4], kt[5], kt[6], kt[7]}); }
          *(v4u*)(Xs + trow * SX + 8 * part) = ri; }
        float eg[4], egr[4];
        { const int kb = 16 * w + 4 * q;
          const f32x4 l31 = *(const LAS f32x4*)(LF + 31 * LFS + kb), l63 = *(const LAS f32x4*)(LF + 63 * LFS + kb);
          const f32x4 s0 = *(const LAS f32x4*)(SEGT + kb), s1 = *(const LAS f32x4*)(SEGT + 128 + kb), s2 = *(const LAS f32x4*)(SEGT + 256 + kb);
          float er[4];
#pragma unroll
          for (int j = 0; j < 4; ++j) { const float rf_ = l31[j] + s0[j], g_ = l63[j] + s0[j] + s1[j] + s2[j]; er[j] = __expf(rf_); eg[j] = __expf(g_); egr[j] = __expf(g_ - rf_); }
#pragma unroll
          for (int pt = 0; pt < 4; ++pt) { v2u hp; hp.x = cvt_pk_bf16(Hacc[pt][0] * er[0], Hacc[pt][1] * er[1]); hp.y = cvt_pk_bf16(Hacc[pt][2] * er[2], Hacc[pt][3] * er[3]); *(v2u*)(Hb + (16 * pt + r) * S1 + 16 * w + 4 * q) = hp; } }
        if (ch + 1 < 32) HG_LOAD(ch + 1);
        __syncthreads();
        { const int tt = w >> 1;
#pragma unroll
          for (int i = 0; i < 2; ++i) { const int ts = 2 * (w & 1) + i; f32x4 acc = (f32x4){0.f, 0.f, 0.f, 0.f};
              if (ts <= tt) {
#pragma unroll
                  for (int k4 = 0; k4 < 4; ++k4) acc = __builtin_amdgcn_mfma_f32_16x16x32_bf16(frag_row(Ki, S1, 16 * ts, 32 * k4, lane), frag_row(Qi, S1, 16 * tt, 32 * k4, lane), acc, 0, 0, 0);
                  const int t = 16 * tt + r;
#pragma unroll
                  for (int j = 0; j < 4; ++j) { const int sj = 16 * ts + 4 * q + j; acc[j] = (sj <= t) ? acc[j] : 0.f; } }
              v2u mp; mp.x = cvt_pk_bf16(acc[0], acc[1]); mp.y = cvt_pk_bf16(acc[2], acc[3]); *(v2u*)(Mm + (16 * tt + r) * SM + 16 * ts + 4 * q) = mp; }
          f32x4 tmp[4];
#pragma unroll
          for (int pt = 0; pt < 4; ++pt) tmp[pt] = (f32x4){0.f, 0.f, 0.f, 0.f};
#pragma unroll
          for (int ks = 0; ks < 2; ++ks) { const bf16x8 af = frag_tr(Ki, S1, 16 * w, 32 * ks, lane);
#pragma unroll
              for (int pt = 0; pt < 4; ++pt) tmp[pt] = __builtin_amdgcn_mfma_f32_16x16x32_bf16(af, frag_tr(Xs, SX, 16 * pt, 32 * ks, lane), tmp[pt], 0, 0, 0); }
#pragma unroll
          for (int pt = 0; pt < 4; ++pt)
#pragma unroll
              for (int j = 0; j < 4; ++j) Hacc[pt][j] = eg[j] * Hacc[pt][j] + egr[j] * tmp[pt][j]; }
        __syncthreads();
        { const int tt = w >> 1; const size_t mrow = (size_t)batch * SEQ + ch * 64 + 16 * tt + r;
#pragma unroll
          for (int i = 0; i < 2; ++i) { const int pt = 2 * (w & 1) + i; f32x4 acc = (f32x4){0.f, 0.f, 0.f, 0.f};
#pragma unroll
              for (int ks = 0; ks < 2; ++ks) acc = __builtin_amdgcn_mfma_f32_16x16x32_bf16(frag_tr(Xs, SX, 16 * pt, 32 * ks, lane), frag_row(Mm, SM, 16 * tt, 32 * ks, lane), acc, 0, 0, 0);
#pragma unroll
              for (int k4 = 0; k4 < 4; ++k4) acc = __builtin_amdgcn_mfma_f32_16x16x32_bf16(frag_row(Hb, S1, 16 * pt, 32 * k4, lane), frag_row(Qi, S1, 16 * tt, 32 * k4, lane), acc, 0, 0, 0);
              *(f32x4*)(ORAW + mrow * 1024 + head * 128 + slice * 64 + 16 * pt + 4 * q) = acc; } }
        __syncthreads();
    }
#undef HG_LOAD
#undef HG_UNPK
}


constexpr int RST = 72;
__device__ __forceinline__ void tile_store(LAS bf16* img, int rt, int ct, const f32x4 a, int lane) { v2u p; p.x = cvt_pk_bf16(a[0], a[1]); p.y = cvt_pk_bf16(a[2], a[3]); *(LAS v2u*)(img + (16 * rt + (lane & 15)) * RST + 16 * ct + 4 * (lane >> 4)) = p; }
__device__ __forceinline__ f32x4 tile_load(const LAS bf16* img, int rt, int ct, int lane) { const v2u p = *(const LAS v2u*)(img + (16 * rt + (lane & 15)) * RST + 16 * ct + 4 * (lane >> 4));
    return (f32x4){__uint_as_float(p.x << 16), __uint_as_float(p.x & 0xffff0000u), __uint_as_float(p.y << 16), __uint_as_float(p.y & 0xffff0000u)}; }
__device__ __forceinline__ f32x4 mm_xy(const LAS bf16* X, const LAS bf16* Y, int rt, int ct, f32x4 acc, int lane) {
#pragma unroll
    for (int ks = 0; ks < 2; ++ks) acc = __builtin_amdgcn_mfma_f32_16x16x32_bf16(frag_tr(Y, RST, 16 * ct, 32 * ks, lane), frag_row(X, RST, 16 * rt, 32 * ks, lane), acc, 0, 0, 0);
    return acc; }
__device__ __forceinline__ f32x4 mm_xty(const LAS bf16* X, const LAS bf16* Y, int rt, int ct, f32x4 acc, int lane) {
#pragma unroll
    for (int ks = 0; ks < 2; ++ks) acc = __builtin_amdgcn_mfma_f32_16x16x32_bf16(frag_tr(Y, RST, 16 * ct, 32 * ks, lane), frag_tr(X, RST, 16 * rt, 32 * ks, lane), acc, 0, 0, 0);
    return acc; }
__device__ __forceinline__ f32x4 mm_xyt(const LAS bf16* X, const LAS bf16* Y, int rt, int ct, f32x4 acc, int lane) {
#pragma unroll
    for (int ks = 0; ks < 2; ++ks) acc = __builtin_amdgcn_mfma_f32_16x16x32_bf16(frag_row(Y, RST, 16 * ct, 32 * ks, lane), frag_row(X, RST, 16 * rt, 32 * ks, lane), acc, 0, 0, 0);
    return acc; }
__device__ __forceinline__ void gtile_store(bf16* g, int rt, int ct, const f32x4 a, int lane) { v2u p; p.x = cvt_pk_bf16(a[0], a[1]); p.y = cvt_pk_bf16(a[2], a[3]); *(v2u*)(g + (16 * rt + (lane & 15)) * 64 + 16 * ct + 4 * (lane >> 4)) = p; }
__device__ __forceinline__ f32x4 gtile_load(const bf16* g, int rt, int ct, int lane) { const v2u p = *(const v2u*)(g + (16 * rt + (lane & 15)) * 64 + 16 * ct + 4 * (lane >> 4));
    return (f32x4){__uint_as_float(p.x << 16), __uint_as_float(p.x & 0xffff0000u), __uint_as_float(p.y << 16), __uint_as_float(p.y & 0xffff0000u)}; }

__device__ __forceinline__ void rwkv_prep_unit(const Ctx& c, int unit, const bf16* U, const float* LW, const float* LA, const float* mu, const float* k_k, const float* k_a, bf16* PHI, bf16* RAP, bf16* PSI, bf16* YVB) {
    const int chunk = unit & 31, head = (unit >> 5) & 15, batch = unit >> 9;
    LAS unsigned char* base = launder_lds(c.lds);
#define RIMG(n) ((LAS bf16*)(base + (n) * 9216))
    LAS bf16* Ai = RIMG(0); LAS bf16* Ri = RIMG(1); LAS bf16* Bi = RIMG(2); LAS bf16* Ki = RIMG(3); LAS bf16* Vi = RIMG(4); LAS bf16* Aak = RIMG(5); LAS bf16* Arb = RIMG(6); LAS bf16* Ark = RIMG(7);
    LAS bf16* PA = RIMG(8); LAS bf16* PB = RIMG(9); LAS bf16* T0 = RIMG(10); LAS bf16* T1 = RIMG(11);
    LAS float* LF = (LAS float*)(base + 10 * 9216);
    LAS float* SEGT = (LAS float*)(base + 12 * 9216); LAS float* ER = SEGT + 512; LAS float* EG = ER + 64; LAS float* EGR = EG + 64;
    const int lane = c.lane, w = c.wave, r = lane & 15, q = lane >> 4, trow = c.tid >> 3, part = c.tid & 7;
    const int rt = w >> 1, ct0 = 2 * (w & 1);
    { const int j0 = 8 * part, col = head * 64 + j0, tl = chunk * 64 + trow; const size_t m = (size_t)batch * SEQ + tl; const bf16* ur = U + m * EVP;
      const v4u r8 = *(const v4u*)(ur + col), k8 = *(const v4u*)(ur + 1024 + col), v8 = *(const v4u*)(ur + 2048 + col);
      v4u rp = (v4u){0u, 0u, 0u, 0u}, kp = rp, vp = rp;
      if (tl > 0) { rp = *(const v4u*)(ur - EVP + col); kp = *(const v4u*)(ur - EVP + 1024 + col); vp = *(const v4u*)(ur - EVP + 2048 + col); }
      const f32x4 lw0 = *(const f32x4*)(LW + m * 1024 + col), lw1 = *(const f32x4*)(LW + m * 1024 + col + 4), al0 = *(const f32x4*)(LA + m * 1024 + col), al1 = *(const f32x4*)(LA + m * 1024 + col + 4);
      float rr[8], kk[8], vv[8], rq[8], kq[8], vq[8], lw[8], al[8];
#define RW_UNPK(dst, src) do { dst[0] = __uint_as_float((src).x << 16); dst[1] = __uint_as_float((src).x & 0xffff0000u); dst[2] = __uint_as_float((src).y << 16); dst[3] = __uint_as_float((src).y & 0xffff0000u); \
        dst[4] = __uint_as_float((src).z << 16); dst[5] = __uint_as_float((src).z & 0xffff0000u); dst[6] = __uint_as_float((src).w << 16); dst[7] = __uint_as_float((src).w & 0xffff0000u); } while (0)
      RW_UNPK(rr, r8); RW_UNPK(kk, k8); RW_UNPK(vv, v8); RW_UNPK(rq, rp); RW_UNPK(kq, kp); RW_UNPK(vq, vp);
#pragma unroll
      for (int e = 0; e < 4; ++e) { lw[e] = lw0[e]; lw[4 + e] = lw1[e]; al[e] = al0[e]; al[4 + e] = al1[e]; }
      float kn[8], ss = 0.f;
#pragma unroll
      for (int e = 0; e < 8; ++e) { rr[e] += (rq[e] - rr[e]) * mu[col + e]; kk[e] += (kq[e] - kk[e]) * mu[1024 + col + e]; vv[e] += (vq[e] - vv[e]) * mu[2048 + col + e]; kn[e] = kk[e] * k_k[col + e]; ss += kn[e] * kn[e]; }
      ss += __shfl_xor(ss, 1); ss += __shfl_xor(ss, 2); ss += __shfl_xor(ss, 4);
      const float rn = 1.0f / sqrtf(fmaxf(ss, 1e-12f));
      *(LAS f32x4*)(LF + trow * 68 + j0) = (f32x4){lw[0], lw[1], lw[2], lw[3]}; *(LAS f32x4*)(LF + trow * 68 + j0 + 4) = (f32x4){lw[4], lw[5], lw[6], lw[7]};
      __syncthreads();
      { const int j = c.tid & 63, seg = c.tid >> 6; float run = 0.f;
#pragma unroll
        for (int i = 0; i < 8; ++i) { run += LF[(8 * seg + i) * 68 + j]; LF[(8 * seg + i) * 68 + j] = run; }
        SEGT[seg * 64 + j] = run; }
      __syncthreads();
      const int segt = trow >> 3; float ai[8], ri[8], bi[8], ki[8];
#pragma unroll
      for (int h2 = 0; h2 < 2; ++h2) { f32x4 cum = *(const LAS f32x4*)(LF + trow * 68 + j0 + 4 * h2), ref = *(const LAS f32x4*)(LF + 31 * 68 + j0 + 4 * h2), g = *(const LAS f32x4*)(LF + 63 * 68 + j0 + 4 * h2);
#pragma unroll
          for (int sgi = 0; sgi < 7; ++sgi) { const f32x4 sv = *(const LAS f32x4*)(SEGT + sgi * 64 + j0 + 4 * h2); if (sgi < segt) cum = cum + sv; if (sgi < 3) ref = ref + sv; g = g + sv; }
#pragma unroll
          for (int e4 = 0; e4 < 4; ++e4) { const int e = 4 * h2 + e4; const float d = cum[e4] - ref[e4], ed = __expf(d), edi = __expf(-d); const float kkn = kn[e] * rn;
              ai[e] = -kkn * __expf(d - lw[e]); ri[e] = rr[e] * ed; bi[e] = kkn * al[e] * edi; ki[e] = kk[e] * (1.0f + (al[e] - 1.0f) * k_a[col + e]) * edi;
              if (trow == 0) { ER[j0 + e] = __expf(ref[e4]); EG[j0 + e] = __expf(g[e4]); EGR[j0 + e] = __expf(g[e4] - ref[e4]); } } }
      *(LAS v4u*)(Ai + trow * RST + j0) = pack8((f32x4){ai[0], ai[1], ai[2], ai[3]}, (f32x4){ai[4], ai[5], ai[6], ai[7]});
      *(LAS v4u*)(Ri + trow * RST + j0) = pack8((f32x4){ri[0], ri[1], ri[2], ri[3]}, (f32x4){ri[4], ri[5], ri[6], ri[7]});
      *(LAS v4u*)(Bi + trow * RST + j0) = pack8((f32x4){bi[0], bi[1], bi[2], bi[3]}, (f32x4){bi[4], bi[5], bi[6], bi[7]});
      *(LAS v4u*)(Ki + trow * RST + j0) = pack8((f32x4){ki[0], ki[1], ki[2], ki[3]}, (f32x4){ki[4], ki[5], ki[6], ki[7]});
      *(LAS v4u*)(Vi + trow * RST + j0) = pack8((f32x4){vv[0], vv[1], vv[2], vv[3]}, (f32x4){vv[4], vv[5], vv[6], vv[7]});
#undef RW_UNPK
    }
    __syncthreads();
    f32x4 Tacc[2];
#pragma unroll
    for (int i = 0; i < 2; ++i) { const int ct = ct0 + i; const f32x4 z = (f32x4){0.f, 0.f, 0.f, 0.f}; f32x4 ab = z, ak = z, rb = z, rk = z;
        if (ct <= rt) { ab = mm_xyt(Ai, Bi, rt, ct, z, lane); ak = mm_xyt(Ai, Ki, rt, ct, z, lane); rb = mm_xyt(Ri, Bi, rt, ct, z, lane); rk = mm_xyt(Ri, Ki, rt, ct, z, lane);
            const int t = 16 * rt + r;
#pragma unroll
            for (int j = 0; j < 4; ++j) { const int sj = 16 * ct + 4 * q + j; if (sj >= t) { ab[j] = 0.f; ak[j] = 0.f; } if (sj > t) { rb[j] = 0.f; rk[j] = 0.f; } } }
        tile_store(PA, rt, ct, ab, lane); tile_store(Aak, rt, ct, ak, lane); tile_store(Arb, rt, ct, rb, lane); tile_store(Ark, rt, ct, rk, lane);
        Tacc[i] = ab;
#pragma unroll
        for (int j = 0; j < 4; ++j) if (16 * ct + 4 * q + j == 16 * rt + r) Tacc[i][j] += 1.0f;
        tile_store(T0, rt, ct, Tacc[i], lane); }
    __syncthreads();
#pragma unroll
    for (int i = 0; i < 2; ++i) { const int ct = ct0 + i; f32x4 pz = (f32x4){0.f, 0.f, 0.f, 0.f}; if (ct <= rt) pz = mm_xy(PA, PA, rt, ct, pz, lane); tile_store(PB, rt, ct, pz, lane); }
    __syncthreads();
#pragma unroll
    for (int lv = 1; lv <= 5; ++lv) {
        LAS bf16* Pc = (lv & 1) ? PB : PA; LAS bf16* Pn = (lv & 1) ? PA : PB; LAS bf16* Tc = (lv & 1) ? T0 : T1; LAS bf16* Tn = (lv & 1) ? T1 : T0;
#pragma unroll
        for (int i = 0; i < 2; ++i) { const int ct = ct0 + i;
            if (ct <= rt) Tacc[i] = mm_xy(Pc, Tc, rt, ct, Tacc[i], lane);
            tile_store(Tn, rt, ct, Tacc[i], lane);
            if (lv < 5) { f32x4 pz = (f32x4){0.f, 0.f, 0.f, 0.f}; if (ct <= rt) pz = mm_xy(Pc, Pc, rt, ct, pz, lane); tile_store(Pn, rt, ct, pz, lane); } }
        __syncthreads();
    }
#pragma unroll
    for (int i = 0; i < 2; ++i) { const int ct = ct0 + i; const f32x4 z = (f32x4){0.f, 0.f, 0.f, 0.f};
        tile_store(PA, rt, ct, mm_xy(Aak, Vi, rt, ct, z, lane), lane); tile_store(PB, rt, ct, mm_xy(T1, Ai, rt, ct, z, lane), lane); }
    __syncthreads();
    const size_t ub = (size_t)unit * 4096;
#pragma unroll
    for (int i = 0; i < 2; ++i) { const int ct = ct0 + i; const f32x4 z = (f32x4){0.f, 0.f, 0.f, 0.f};
        tile_store(T0, rt, ct, mm_xy(T1, PA, rt, ct, z, lane), lane);
        f32x4 ra = mm_xy(Arb, PB, rt, ct, tile_load(Ri, rt, ct, lane), lane); const f32x4 er = *(const LAS f32x4*)(ER + 16 * ct + 4 * q);
        gtile_store(RAP + ub, rt, ct, ra * er, lane);
        f32x4 gph = mm_xty(Bi, PB, rt, ct, z, lane); const float egr = EGR[16 * rt + r], egj = EG[16 * rt + r];
#pragma unroll
        for (int j = 0; j < 4; ++j) { gph[j] = gph[j] * egr * er[j]; if (16 * ct + 4 * q + j == 16 * rt + r) gph[j] += egj; }
        gtile_store(PHI + ub, rt, ct, gph, lane); }
    __syncthreads();
#pragma unroll
    for (int i = 0; i < 2; ++i) { const int ct = ct0 + i; const f32x4 z = (f32x4){0.f, 0.f, 0.f, 0.f};
        gtile_store(YVB + ub, rt, ct, mm_xy(Ark, Vi, rt, ct, mm_xy(Arb, T0, rt, ct, z, lane), lane), lane);
        const f32x4 ps = mm_xty(Ki, Vi, rt, ct, mm_xty(Bi, T0, rt, ct, z, lane), lane);
        gtile_store(PSI + ub, rt, ct, ps * EGR[16 * rt + r], lane); }
    __syncthreads();
#undef RIMG
}

__device__ __forceinline__ void rwkv_chain(const Ctx& c, int task, const bf16* PHI, const bf16* RAP, const bf16* PSI, const bf16* YVB, float* YRAW) {
    const int head = task & 15, batch = task >> 4;
    const int lane = c.lane, w = c.wave, r = lane & 15, q = lane >> 4, trow = c.tid >> 3, part = c.tid & 7;
    const int it = w >> 1, x0 = 2 * (w & 1);
    { LAS bf16* H0 = (LAS bf16*)c.lds; for (int i = c.tid; i < 64 * RST / 2; i += 512) ((LAS unsigned*)H0)[i] = 0u; }
    const size_t u0 = (size_t)(batch * 16 + head) * 32;
    v4u pphi = *(const v4u*)(PHI + u0 * 4096 + trow * 64 + 8 * part), prap = *(const v4u*)(RAP + u0 * 4096 + trow * 64 + 8 * part);
    __syncthreads();
    for (int ch = 0; ch < 32; ++ch) {
        LAS unsigned char* base = launder_lds(c.lds);
        LAS bf16* Hc = (LAS bf16*)(base + (ch & 1) * 9216); LAS bf16* Hn = (LAS bf16*)(base + ((ch & 1) ^ 1) * 9216); LAS bf16* PHi = (LAS bf16*)(base + 2 * 9216); LAS bf16* RAi = (LAS bf16*)(base + 3 * 9216);
        const size_t ub = (u0 + ch) * 4096;
        *(LAS v4u*)(PHi + trow * RST + 8 * part) = pphi; *(LAS v4u*)(RAi + trow * RST + 8 * part) = prap;
        if (ch + 1 < 32) { pphi = *(const v4u*)(PHI + ub + 4096 + trow * 64 + 8 * part); prap = *(const v4u*)(RAP + ub + 4096 + trow * 64 + 8 * part); }
        f32x4 yv[2], ps[2];
#pragma unroll
        for (int i = 0; i < 2; ++i) { yv[i] = gtile_load(YVB + ub, x0 + i, it, lane); ps[i] = gtile_load(PSI + ub, x0 + i, it, lane); }
        __syncthreads();
#pragma unroll
        for (int i = 0; i < 2; ++i) { const int xt = x0 + i;
            const f32x4 y = mm_xy(RAi, Hc, xt, it, yv[i], lane);
            *(f32x4*)(YRAW + ((size_t)batch * SEQ + ch * 64 + 16 * xt + r) * 1024 + head * 64 + 16 * it + 4 * q) = y;
            const f32x4 hn = mm_xy(PHi, Hc, xt, it, ps[i], lane);
            tile_store(Hn, xt, it, hn, lane); }
        __syncthreads();
    }
}

#define UNPK8(dst, src) do { dst[0] = __uint_as_float((src).x << 16); dst[1] = __uint_as_float((src).x & 0xffff0000u); dst[2] = __uint_as_float((src).y << 16); dst[3] = __uint_as_float((src).y & 0xffff0000u); \
        dst[4] = __uint_as_float((src).z << 16); dst[5] = __uint_as_float((src).z & 0xffff0000u); dst[6] = __uint_as_float((src).w << 16); dst[7] = __uint_as_float((src).w & 0xffff0000u); } while (0)
struct Args { const float* in[41]; float* out; unsigned char* ws; int lo, hi; };

__global__ void __launch_bounds__(512, 2) fwd(Args args) {
    extern __shared__ __attribute__((aligned(16))) unsigned char lds_raw[];
    Ctx c; c.lds = (LAS unsigned char*)lds_raw; c.tid = threadIdx.x; c.lane = c.tid & 63; c.wave = __builtin_amdgcn_readfirstlane(c.tid >> 6); c.bid = blockIdx.x; c.G = gridDim.x;
    volatile LAS unsigned* MISC = (volatile LAS unsigned*)(c.lds + MISC_OFF);
    unsigned char* ws = args.ws;
    for (int u = c.tid; u < (LDS_BYTES - RING_BYTES) / 4; u += 512) ((LAS unsigned*)(c.lds + RING_BYTES))[u] = 0u;
    __syncthreads();
    const int lo = args.lo, hi = args.hi;
    XcdBarrier bar; bar.bar = (unsigned*)(ws + WS_CTL) + CW_BAR; bar.x = 0; bar.st = nullptr;
    if (hi - lo > 1) bar = xcd_barrier_post((unsigned*)(ws + WS_CTL) + CW_BAR, MISC + 8);
#define IN(k) (lo <= (k) && (k) < hi)
#define SEAM(k) do { if (IN(k) && IN((k) + 1)) xcd_barrier(bar); } while (0)

    const float* x = args.in[0]; const float* final_norm_w = args.in[1]; const float* hg_lb = args.in[2];
    const float* ev_norm1_w = args.in[3]; const float* ev_w_in = args.in[4]; const float* ev_w_out = args.in[5];
    const float* rw_mu = args.in[6]; const float* rw_w0 = args.in[7]; const float* rw_w2 = args.in[8]; const float* rw_a0 = args.in[9]; const float* rw_a2 = args.in[10]; const float* rw_g2 = args.in[11];
    const float* rw_k_k = args.in[12]; const float* rw_k_a = args.in[13]; const float* rw_r_k = args.in[14]; const float* rw_ln_w = args.in[15]; const float* rw_ln_b = args.in[16];
    const float* ml_conv_w = args.in[17]; const float* ml_conv_b = args.in[18]; const float* ml_i_b = args.in[19]; const float* ml_f_b = args.in[20]; const float* ml_norm_w = args.in[21];
    const float* ev_norm2_w = args.in[22]; const float* ffn_w_gate = args.in[23]; const float* ffn_w_up = args.in[24]; const float* ffn_w_down = args.in[25];
    const float* od_norm1_w = args.in[26]; const float* od_w_in = args.in[27]; const float* od_w_out = args.in[28]; const float* hg_norm_w = args.in[29];
    const float* mb_conv_w = args.in[30]; const float* mb_conv_b = args.in[31]; const float* mb_dt_bias = args.in[32]; const float* mb_A_log = args.in[33]; const float* mb_D = args.in[34]; const float* mb_norm_w = args.in[35];
    const float* od_norm2_w = args.in[36]; const float* moe_router = args.in[37]; const float* moe_w_gate = args.in[38]; const float* moe_w_up = args.in[39]; const float* moe_w_down = args.in[40];
    float* OUT = args.out;
    bf16* W_LORA = (bf16*)(ws + WS_WLORA); bf16* W_EVIN = (bf16*)(ws + WS_WEVIN); bf16* W_EVOUT = (bf16*)(ws + WS_WEVOUT); bf16* W_FGU = (bf16*)(ws + WS_WFGU); bf16* W_FD = (bf16*)(ws + WS_WFD);
    bf16* W_ODIN = (bf16*)(ws + WS_WODIN); bf16* W_ODOUT = (bf16*)(ws + WS_WODOUT); bf16* W_MGU = (bf16*)(ws + WS_WMGU); bf16* W_MD = (bf16*)(ws + WS_WMD);
    bf16* XN = (bf16*)(ws + WS_XN); bf16* Y = (bf16*)(ws + WS_Y); float* X1 = (float*)(ws + WS_X1);
    bf16* U = (bf16*)(ws + SC_U); float* LW = (float*)(ws + SC_LW); float* LA = (float*)(ws + SC_LA); float* LG = (float*)(ws + SC_LG); bf16* ALORA = (bf16*)(ws + SC_ALORA);
    bf16* RW_PHI = (bf16*)(ws + WS_X1); bf16* RW_RAP = RW_PHI + (size_t)2048 * 4096; bf16* RW_PSI = RW_RAP + (size_t)2048 * 4096; bf16* RW_YV = RW_PSI + (size_t)2048 * 4096;
    float* YRAW_E = (float*)(ws + SC_YRAW_E); float* MLQK = (float*)(ws + SC_MLQK); float* HRAW = (float*)(ws + SC_HRAW); float* DEN = (float*)(ws + SC_DEN);
    bf16* ACT = (bf16*)(ws + SC_ACT);
    float* XBC = (float*)(ws + SC_XBC); float* ORAW = (float*)(ws + SC_ORAW); float* YRAW_O = (float*)(ws + SC_YRAW_O);
    bf16* HS = (bf16*)(ws + SC_HS); bf16* ACTS = (bf16*)(ws + SC_ACTS); float* OUTS = (float*)(ws + SC_OUTS);
    int* TOPK = (int*)(ws + SC_TOPK); int* POS = (int*)(ws + SC_POS); int* CNT = (int*)(ws + SC_CNT); int* TILES = (int*)(ws + SC_TILES);
    float* X2 = OUT;

    if (IN(0)) {
        { LAS float* scr = (LAS float*)c.lds;
          const ConvKind kinds[10] = {
              ConvKind{ev_w_in, W_EVIN, DM, 6600, EVP, 0, 1, 0, 0}, ConvKind{ev_w_out, W_EVOUT, DM, DM, DM, 0, 1, 0, 0},
              ConvKind{ffn_w_gate, W_FGU, DM, FF, FF, 1, 1, 0, 0}, ConvKind{ffn_w_up, W_FGU, DM, FF, FF, 2, 1, 0, 0}, ConvKind{ffn_w_down, W_FD, FF, DM, DM, 0, 1, 0, 0},
              ConvKind{od_w_in, W_ODIN, DM, 7184, ODP, 0, 1, 0, 0}, ConvKind{od_w_out, W_ODOUT, DM, DM, DM, 0, 1, 0, 0},
              ConvKind{moe_w_gate, W_MGU, DM, FE, FE, 1, NEXP, (size_t)DM * FE, (size_t)2 * FE * DM}, ConvKind{moe_w_up, W_MGU, DM, FE, FE, 2, NEXP, (size_t)DM * FE, (size_t)2 * FE * DM},
              ConvKind{moe_w_down, W_MD, FE, DM, DM, 0, NEXP, (size_t)FE * DM, (size_t)DM * FE} };
          ConvTile cur, nxt; f32x4 ra[4], rb[4];
          int item = c.bid; bool have = conv_item(kinds, item, cur);
          if (have) conv_load(cur, ra, c.tid);
          while (have) {
              item += c.G; const bool hn = conv_item(kinds, item, nxt);
              if (hn) conv_load(nxt, rb, c.tid);
              conv_emit(cur, ra, scr, c.tid);
              have = hn; cur = nxt;
#pragma unroll
              for (int i = 0; i < 4; ++i) ra[i] = rb[i];
          } }
        for (int idx = c.bid * 512 + c.tid; idx < 3072 * 512; idx += c.G * 512) {
            const int k = idx / 3072, n = idx % 3072; float v = 0.f;
            if (n < 1024) { if (k < 96) v = rw_w2[k * 1024 + n]; }
            else if (n < 2048) { if (k >= 96 && k < 192) v = rw_a2[(k - 96) * 1024 + (n - 1024)]; }
            else { if (k >= 192 && k < 448) v = rw_g2[(k - 192) * 1024 + (n - 2048)]; }
            W_LORA[(size_t)n * 512 + k] = (bf16)f2bf(v);
        }
        rmsnorm_phase(c, x, ev_norm1_w, XN);
    }
    SEAM(0);
    if (IN(1)) {
        pg8::Gemm g{XN, W_EVIN, M_TOK, EVP, DM}; pg8::StaticOrder S; S.init(M_TOK, EVP, c.G, c.bid);
        pg8::EpiBf16 E{U, EVP};
        pg8::gemm_phase<pg8::EpiBf16, pg8::StaticOrder, true, true>(c.lds, g, S, E);
    }
    SEAM(1);
    if (IN(2)) {
        for (int blk = c.bid; blk < 256; blk += c.G) {
            const int m0 = blk * 32;
            {
              const int ch0 = 8 * (c.tid & 127); float w[4][8], bb[8];
#pragma unroll
              for (int j = 0; j < 4; ++j) { const f32x4 a = *(const f32x4*)(ml_conv_w + j * 1024 + ch0), b = *(const f32x4*)(ml_conv_w + j * 1024 + ch0 + 4);
#pragma unroll
                  for (int e = 0; e < 4; ++e) { w[j][e] = a[e]; w[j][4 + e] = b[e]; } }
              { const f32x4 a = *(const f32x4*)(ml_conv_b + ch0), b = *(const f32x4*)(ml_conv_b + ch0 + 4);
#pragma unroll
                for (int e = 0; e < 4; ++e) { bb[e] = a[e]; bb[4 + e] = b[e]; } }
#pragma unroll 2
              for (int i = 0; i < 8; ++i) { const int m = m0 + (c.tid >> 7) + 4 * i, tl = m & (SEQ - 1); float acc[8];
#pragma unroll
                  for (int e = 0; e < 8; ++e) acc[e] = bb[e];
#pragma unroll
                  for (int j = 0; j < 4; ++j) if (tl - 3 + j >= 0) { const v4u raw = *(const v4u*)(U + (size_t)(m - 3 + j) * EVP + 3520 + ch0); float xv[8]; UNPK8(xv, raw);
#pragma unroll
                      for (int e = 0; e < 8; ++e) acc[e] += w[j][e] * xv[e]; }
                  *(f32x4*)(MLQK + (size_t)m * 1024 + ch0) = (f32x4){siluf_(acc[0]), siluf_(acc[1]), siluf_(acc[2]), siluf_(acc[3])};
                  *(f32x4*)(MLQK + (size_t)m * 1024 + ch0 + 4) = (f32x4){siluf_(acc[4]), siluf_(acc[5]), siluf_(acc[6]), siluf_(acc[7])}; } }
            {
              const int idx0 = 8 * (c.tid & 63), col0 = 3072 + idx0; float mu8[8];
#pragma unroll
              for (int e = 0; e < 8; ++e) mu8[e] = idx0 < 448 ? rw_mu[col0 + e] : 0.f;
#pragma unroll 2
              for (int i = 0; i < 4; ++i) { const int m = m0 + (c.tid >> 6) + 8 * i, tl = m & (SEQ - 1); v4u o = (v4u){0u, 0u, 0u, 0u};
                  if (idx0 < 448) { const v4u cr = *(const v4u*)(U + (size_t)m * EVP + col0); v4u pr = (v4u){0u, 0u, 0u, 0u}; if (tl) pr = *(const v4u*)(U + (size_t)(m - 1) * EVP + col0);
                      float cv[8], pv[8], xv[8]; UNPK8(cv, cr); UNPK8(pv, pr);
#pragma unroll
                      for (int e = 0; e < 8; ++e) { const float x = cv[e] + (pv[e] - cv[e]) * mu8[e]; xv[e] = idx0 < 96 ? tanhf(x) : (idx0 < 192 ? x : sigmoidf_(x)); }
                      o = pack8((f32x4){xv[0], xv[1], xv[2], xv[3]}, (f32x4){xv[4], xv[5], xv[6], xv[7]}); }
                  *(v4u*)(ALORA + (size_t)m * 512 + idx0) = o; } }
        }
    }
    SEAM(2);
    if (IN(3)) {
        pg8::Gemm g{ALORA, W_LORA, M_TOK, 3072, 512}; pg8::StaticOrder S; S.init(M_TOK, 3072, c.G, c.bid);
        pg8::EpiLora E{LW, rw_w0, rw_a0};
        pg8::gemm_phase<pg8::EpiLora, pg8::StaticOrder, true, true>(c.lds, g, S, E);
    }
    SEAM(3);
    if (IN(4)) {
        for (int unit = c.bid; unit < 2048; unit += c.G) rwkv_prep_unit(c, unit, U, LW, LA, rw_mu, rw_k_k, rw_k_a, RW_PHI, RW_RAP, RW_PSI, RW_YV);
    }
    SEAM(4);
    if (IN(5)) {
        for (int task = c.bid; task < 128; task += c.G) {
            if (task < 64) rwkv_chain(c, task, RW_PHI, RW_RAP, RW_PSI, RW_YV, YRAW_E);
            else chunk_scan<true>(c, task - 64, U, MLQK, ml_i_b, ml_f_b, nullptr, HRAW, DEN);
        }
    }
    SEAM(5);
    if (IN(6)) {
        for (int blk = c.bid; blk < 256; blk += c.G) {
            const int m0 = blk * 32;
            for (int hh = 0; hh < 2; ++hh) { const int col = (2 * c.wave + hh) * 64 + 8 * (c.lane & 7);
                float mur[8], muk[8], muv[8], kac[8], rkc[8], lnw[8], lnb[8];
#pragma unroll
                for (int e = 0; e < 8; ++e) { mur[e] = rw_mu[col + e]; muk[e] = rw_mu[1024 + col + e]; muv[e] = rw_mu[2048 + col + e]; kac[e] = rw_k_a[col + e]; rkc[e] = rw_r_k[col + e]; lnw[e] = rw_ln_w[col + e]; lnb[e] = rw_ln_b[col + e]; }
#pragma unroll 2
                for (int i = 0; i < 4; ++i) { const int m = m0 + 8 * i + (c.lane >> 3), tl = m & (SEQ - 1); const bf16* ur = U + (size_t)m * EVP;
                    const v4u r8 = *(const v4u*)(ur + col), k8 = *(const v4u*)(ur + 1024 + col), v8 = *(const v4u*)(ur + 2048 + col);
                    v4u rp8 = (v4u){0u, 0u, 0u, 0u}, kp8 = rp8, vp8 = rp8;
                    if (tl) { rp8 = *(const v4u*)(ur - EVP + col); kp8 = *(const v4u*)(ur - EVP + 1024 + col); vp8 = *(const v4u*)(ur - EVP + 2048 + col); }
                    const f32x4 y0 = *(const f32x4*)(YRAW_E + (size_t)m * 1024 + col), y1 = *(const f32x4*)(YRAW_E + (size_t)m * 1024 + col + 4);
                    const f32x4 a0 = *(const f32x4*)(LA + (size_t)m * 1024 + col), a1 = *(const f32x4*)(LA + (size_t)m * 1024 + col + 4);
                    const f32x4 g0 = *(const f32x4*)(LG + (size_t)m * 1024 + col), g1 = *(const f32x4*)(LG + (size_t)m * 1024 + col + 4);
                    float rr[8], kk[8], vv[8], rq[8], kq[8], vq[8]; UNPK8(rr, r8); UNPK8(kk, k8); UNPK8(vv, v8); UNPK8(rq, rp8); UNPK8(kq, kp8); UNPK8(vq, vp8);
                    float yv[8], av[8], gv[8];
#pragma unroll
                    for (int e = 0; e < 4; ++e) { yv[e] = y0[e]; yv[4 + e] = y1[e]; av[e] = a0[e]; av[4 + e] = a1[e]; gv[e] = g0[e]; gv[4 + e] = g1[e]; }
                    float sy = 0.f, sb = 0.f;
#pragma unroll
                    for (int e = 0; e < 8; ++e) { rr[e] += (rq[e] - rr[e]) * mur[e]; kk[e] += (kq[e] - kk[e]) * muk[e]; vv[e] += (vq[e] - vv[e]) * muv[e];
                        sy += yv[e]; sb += rr[e] * kk[e] * (1.0f + (av[e] - 1.0f) * kac[e]) * rkc[e]; }
                    sy += __shfl_xor(sy, 1); sy += __shfl_xor(sy, 2); sy += __shfl_xor(sy, 4); sb += __shfl_xor(sb, 1); sb += __shfl_xor(sb, 2); sb += __shfl_xor(sb, 4);
                    const float mean = sy * (1.0f / 64.0f); float sq = 0.f;
#pragma unroll
                    for (int e = 0; e < 8; ++e) { yv[e] -= mean; sq += yv[e] * yv[e]; }
                    sq += __shfl_xor(sq, 1); sq += __shfl_xor(sq, 2); sq += __shfl_xor(sq, 4);
                    const float rstd = 1.0f / sqrtf(sq * (1.0f / 64.0f) + 64e-5f); float o[8];
#pragma unroll
                    for (int e = 0; e < 8; ++e) o[e] = (yv[e] * rstd * lnw[e] + lnb[e] + sb * vv[e]) * gv[e];
                    *(v4u*)(Y + (size_t)m * DM + col) = pack8((f32x4){o[0], o[1], o[2], o[3]}, (f32x4){o[4], o[5], o[6], o[7]}); } }
            { const int head = c.wave & 3, col = head * 256 + 4 * c.lane; const f32x4 nw = *(const f32x4*)(ml_norm_w + col);
#pragma unroll 4
              for (int i = 0; i < 16; ++i) { const int m = m0 + (c.wave >> 2) + 2 * i;
                  f32x4 hv = *(const f32x4*)(HRAW + (size_t)m * 1024 + col); hv = hv * (1.0f / fmaxf(fabsf(DEN[(size_t)m * 4 + head]), 1.0f));
                  const v2u ov = *(const v2u*)(U + (size_t)m * EVP + 5568 + col);
                  const float ss = wave_sum((hv.x * hv.x + hv.y * hv.y) + (hv.z * hv.z + hv.w * hv.w));
                  const float rs = 1.0f / sqrtf(ss * (1.0f / 256.0f) + 1e-6f);
                  const float o0 = hv.x * rs * nw.x * sigmoidf_(__uint_as_float(ov.x << 16)), o1 = hv.y * rs * nw.y * sigmoidf_(__uint_as_float(ov.x & 0xffff0000u));
                  const float o2 = hv.z * rs * nw.z * sigmoidf_(__uint_as_float(ov.y << 16)), o3 = hv.w * rs * nw.w * sigmoidf_(__uint_as_float(ov.y & 0xffff0000u));
                  v2u pk; pk.x = cvt_pk_bf16(o0, o1); pk.y = cvt_pk_bf16(o2, o3); *(v2u*)(Y + (size_t)m * DM + 1024 + col) = pk; } }
        }
    }
    SEAM(6);
    if (IN(7)) {
        pg8::Gemm g{Y, W_EVOUT, M_TOK, DM, DM}; pg8::StaticOrder S; S.init(M_TOK, DM, c.G, c.bid);
        pg8::EpiResF32 E{x, X1, DM};
        pg8::gemm_phase<pg8::EpiResF32, pg8::StaticOrder, false, true>(c.lds, g, S, E);
    }
    SEAM(7);
    if (IN(8)) rmsnorm_phase(c, X1, ev_norm2_w, XN);
    SEAM(8);
    if (IN(9)) {
        pg8::Gemm g{XN, W_FGU, M_TOK, 2 * FF, DM}; pg8::StaticOrder S; S.init(M_TOK, 2 * FF, c.G, c.bid);
        pg8::EpiSwiGLU E{ACT, FF};
        pg8::gemm_phase<pg8::EpiSwiGLU, pg8::StaticOrder, true, true>(c.lds, g, S, E);
    }
    SEAM(9);
    if (IN(10)) {
        pg8::Gemm g{ACT, W_FD, M_TOK, DM, FF}; pg8::StaticOrder S; S.init(M_TOK, DM, c.G, c.bid);
        pg8::EpiResF32 E{X1, X2, DM};
        pg8::gemm_phase<pg8::EpiResF32, pg8::StaticOrder, false, true>(c.lds, g, S, E);
    }
    SEAM(10);
    if (IN(11)) rmsnorm_phase(c, X2, od_norm1_w, XN);
    SEAM(11);
    if (IN(12)) {
        pg8::Gemm g{XN, W_ODIN, M_TOK, ODP, DM}; pg8::StaticOrder S; S.init(M_TOK, ODP, c.G, c.bid);
        pg8::EpiBf16 E{U, ODP};
        pg8::gemm_phase<pg8::EpiBf16, pg8::StaticOrder, true, true>(c.lds, g, S, E);
    }
    SEAM(12);
    if (IN(13)) {
        for (int blk = c.bid; blk < 256; blk += c.G) {
            const int m0 = blk * 32, ch0 = 8 * (c.tid & 255); float w[4][8], bb[8];
#pragma unroll
            for (int j = 0; j < 4; ++j) { const f32x4 a = *(const f32x4*)(mb_conv_w + j * 2048 + ch0), b = *(const f32x4*)(mb_conv_w + j * 2048 + ch0 + 4);
#pragma unroll
                for (int e = 0; e < 4; ++e) { w[j][e] = a[e]; w[j][4 + e] = b[e]; } }
            { const f32x4 a = *(const f32x4*)(mb_conv_b + ch0), b = *(const f32x4*)(mb_conv_b + ch0 + 4);
#pragma unroll
              for (int e = 0; e < 4; ++e) { bb[e] = a[e]; bb[4 + e] = b[e]; } }
#pragma unroll 2
            for (int i = 0; i < 16; ++i) { const int m = m0 + (c.tid >> 8) + 2 * i, tl = m & (SEQ - 1); float acc[8];
#pragma unroll
                for (int e = 0; e < 8; ++e) acc[e] = bb[e];
#pragma unroll
                for (int j = 0; j < 4; ++j) if (tl - 3 + j >= 0) { const v4u raw = *(const v4u*)(U + (size_t)(m - 3 + j) * ODP + 5120 + ch0); float xv[8]; UNPK8(xv, raw);
#pragma unroll
                    for (int e = 0; e < 8; ++e) acc[e] += w[j][e] * xv[e]; }
                *(f32x4*)(XBC + (size_t)m * 2048 + ch0) = (f32x4){siluf_(acc[0]), siluf_(acc[1]), siluf_(acc[2]), siluf_(acc[3])};
                *(f32x4*)(XBC + (size_t)m * 2048 + ch0 + 4) = (f32x4){siluf_(acc[4]), siluf_(acc[5]), siluf_(acc[6]), siluf_(acc[7])}; }
        }
    }
    SEAM(13);
    if (IN(14)) {
        for (int task = c.bid; task < 256; task += c.G) {
            if (task < 64) chunk_hgrn(c, task, U, hg_lb, ORAW);
            else if (task < 128) chunk_scan<false>(c, task - 64, U, XBC, mb_dt_bias, mb_A_log, mb_D, YRAW_O, nullptr);
        }
    }
    SEAM(14);
    if (IN(15)) {
        for (int blk = c.bid; blk < 256; blk += c.G) {
            const int m0 = blk * 32;
            {
              const int col = c.wave * 128 + 2 * c.lane; const float nw0 = hg_norm_w[col], nw1 = hg_norm_w[col + 1];
#pragma unroll 4
              for (int i = 0; i < 32; ++i) { const int m = m0 + i; const f32x2 ov = *(const f32x2*)(ORAW + (size_t)m * 1024 + col); const unsigned gz = *(const unsigned*)(U + (size_t)m * ODP + 3072 + col);
                  const float rs = 1.0f / sqrtf(wave_sum(ov.x * ov.x + ov.y * ov.y) * (1.0f / 128.0f) + 1e-6f);
                  *(unsigned*)(Y + (size_t)m * DM + col) = cvt_pk_bf16(ov.x * rs * nw0 * siluf_(__uint_as_float(gz << 16)), ov.y * rs * nw1 * siluf_(__uint_as_float(gz & 0xffff0000u))); } }
            {
              const int grp = c.wave & 3, col = grp * 256 + 4 * c.lane; const f32x4 nw = *(const f32x4*)(mb_norm_w + col);
#pragma unroll 4
              for (int i = 0; i < 16; ++i) { const int m = m0 + (c.wave >> 2) + 2 * i;
                  const f32x4 yv = *(const f32x4*)(YRAW_O + (size_t)m * 1024 + col); const v2u zv = *(const v2u*)(U + (size_t)m * ODP + 4096 + col);
                  const float t0 = yv.x * siluf_(__uint_as_float(zv.x << 16)), t1 = yv.y * siluf_(__uint_as_float(zv.x & 0xffff0000u)), t2 = yv.z * siluf_(__uint_as_float(zv.y << 16)), t3 = yv.w * siluf_(__uint_as_float(zv.y & 0xffff0000u));
                  const float rs = 1.0f / sqrtf(wave_sum((t0 * t0 + t1 * t1) + (t2 * t2 + t3 * t3)) * (1.0f / 256.0f) + 1e-6f);
                  v2u pk; pk.x = cvt_pk_bf16(t0 * rs * nw.x, t1 * rs * nw.y); pk.y = cvt_pk_bf16(t2 * rs * nw.z, t3 * rs * nw.w); *(v2u*)(Y + (size_t)m * DM + 1024 + col) = pk; } }
        }
    }
    SEAM(15);
    if (IN(16)) {
        pg8::Gemm g{Y, W_ODOUT, M_TOK, DM, DM}; pg8::StaticOrder S; S.init(M_TOK, DM, c.G, c.bid);
        pg8::EpiResF32 E{X2, X1, DM};
        pg8::gemm_phase<pg8::EpiResF32, pg8::StaticOrder, false, true>(c.lds, g, S, E);
    }
    SEAM(16);
    if (IN(17)) {
        LAS float* RT = (LAS float*)c.lds;
        LAS int* lcnt = (LAS int*)(c.lds + 65536);
        for (int i = c.tid; i < 2048 * 8 / 4; i += 512) *(LAS f32x4*)(RT + 4 * i) = *(const f32x4*)(moe_router + 4 * i);
        __syncthreads();
        for (int blk = c.bid; blk < 256; blk += c.G) {
            if (c.tid < 8) lcnt[c.tid] = 0;
            __syncthreads();
            for (int q = 0; q < 4; ++q) {
                const int m = blk * 32 + c.wave * 4 + q;
                const float* xr = X1 + (size_t)m * DM;
                f32x4 v[8]; float ss = 0.f;
#pragma unroll
                for (int j = 0; j < 8; ++j) { v[j] = *(const f32x4*)(xr + 4 * c.lane + 256 * j); ss += (v[j].x * v[j].x + v[j].y * v[j].y) + (v[j].z * v[j].z + v[j].w * v[j].w); }
                const float rs = 1.0f / sqrtf(wave_sum(ss) * (1.0f / 2048.0f) + 1e-6f);
                float lg[8];
#pragma unroll
                for (int e = 0; e < 8; ++e) lg[e] = 0.f;
#pragma unroll
                for (int j = 0; j < 8; ++j) { const f32x4 wv = *(const f32x4*)(od_norm2_w + 4 * c.lane + 256 * j); const f32x4 hn = v[j] * rs * wv;
                    v2u p; p.x = cvt_pk_bf16(hn.x, hn.y); p.y = cvt_pk_bf16(hn.z, hn.w); *(v2u*)(XN + (size_t)m * DM + 4 * c.lane + 256 * j) = p;
#pragma unroll
                    for (int i = 0; i < 4; ++i) { const int ch = 4 * c.lane + 256 * j + i; const f32x4 r0 = *(const LAS f32x4*)(RT + ch * 8), r1 = *(const LAS f32x4*)(RT + ch * 8 + 4);
                        lg[0] += hn[i] * r0[0]; lg[1] += hn[i] * r0[1]; lg[2] += hn[i] * r0[2]; lg[3] += hn[i] * r0[3]; lg[4] += hn[i] * r1[0]; lg[5] += hn[i] * r1[1]; lg[6] += hn[i] * r1[2]; lg[7] += hn[i] * r1[3]; } }
#pragma unroll
                for (int e = 0; e < 8; ++e) lg[e] = wave_sum(lg[e]);
                int e0 = 0; float v0 = lg[0];
#pragma unroll
                for (int e = 1; e < 8; ++e) if (lg[e] > v0) { v0 = lg[e]; e0 = e; }
                int e1 = -1; float v1 = -3.0e38f;
#pragma unroll
                for (int e = 0; e < 8; ++e) if (e != e0 && lg[e] > v1) { v1 = lg[e]; e1 = e; }
                const float p0 = 1.0f / (1.0f + __expf(v1 - v0)), p1 = 1.0f - p0;
                if (c.lane == 0) { TOPK[m * 4] = e0; TOPK[m * 4 + 1] = e1; TOPK[m * 4 + 2] = __float_as_int(p0); TOPK[m * 4 + 3] = __float_as_int(p1); atomicAdd((int*)&lcnt[e0], 1); atomicAdd((int*)&lcnt[e1], 1); }
            }
            __syncthreads();
            if (c.tid < 8) CNT[blk * 8 + c.tid] = lcnt[c.tid];
            __syncthreads();
        }
    }
    SEAM(17);
    if (IN(18)) {
        LAS int* C8 = (LAS int*)c.lds;
        LAS int* tot = C8 + 2048; LAS int* pre = tot + 8; LAS int* segst = pre + 8; LAS int* ntl = segst + 8; LAS int* basee = ntl + 8; LAS int* lpos = basee + 8;
        LAS int* ltop = lpos + 64; LAS int* part = ltop + 64;
        for (int blk = c.bid; blk < 256; blk += c.G) {
            for (int i = c.tid; i < 2048; i += 512) C8[i] = CNT[i];
            if (c.tid < 64) ltop[c.tid] = TOPK[(blk * 32 + (c.tid >> 1)) * 4 + (c.tid & 1)];
            __syncthreads();
            { const int e = c.tid & 7, bq = c.tid >> 3; int t = 0, pp = 0;
#pragma unroll
              for (int j = 0; j < 4; ++j) { const int b = 4 * bq + j, v = C8[b * 8 + e]; t += v; if (b < blk) pp += v; }
              part[bq * 8 + e] = t; part[512 + bq * 8 + e] = pp; }
            __syncthreads();
            if (c.tid < 8) { int t = 0, pp = 0; for (int b = 0; b < 64; ++b) { t += part[b * 8 + c.tid]; pp += part[512 + b * 8 + c.tid]; } tot[c.tid] = t; pre[c.tid] = pp; }
            __syncthreads();
            if (c.tid == 0) {
                int seg = 0;
                for (int e = 0; e < 8; ++e) { segst[e] = seg; ntl[e] = (tot[e] + 255) >> 8; seg += ntl[e] * 256; basee[e] = seg - ntl[e] * 256 + pre[e]; }
                for (int i = 0; i < 32; ++i) { const int e0 = ltop[2 * i], e1 = ltop[2 * i + 1];
                    const int p0 = basee[e0]; basee[e0] = p0 + 1; const int p1 = basee[e1]; basee[e1] = p1 + 1; lpos[2 * i] = p0; lpos[2 * i + 1] = p1; }
                if (blk == 0) { int t = 0; for (int e = 0; e < 8; ++e) for (int k = 0; k < ntl[e]; ++k) TILES[1 + t++] = e; TILES[0] = t; }
            }
            __syncthreads();
            if (c.tid < 64) POS[blk * 64 + c.tid] = lpos[c.tid];
            for (int pr = c.wave; pr < 64; pr += 8) {
                const int m = blk * 32 + (pr >> 1); const int pos = lpos[pr];
                const v4u* src = (const v4u*)(XN + (size_t)m * DM); v4u* dst = (v4u*)(HS + (size_t)pos * DM);
#pragma unroll
                for (int j = 0; j < 4; ++j) dst[c.lane + 64 * j] = src[c.lane + 64 * j];
            }
            for (int e = 0; e < 8; ++e) {
                const int npad = ntl[e] * 256 - tot[e], r0 = segst[e] + tot[e];
                for (int pq = blk; pq < npad; pq += 256) { v2u* dst = (v2u*)(HS + (size_t)(r0 + pq) * DM); dst[c.tid] = (v2u){0u, 0u}; }
            }
            __syncthreads();
        }
    }
    SEAM(18);
    if (IN(19)) {
        const int NT = __builtin_amdgcn_readfirstlane(TILES[0]);
        pg8::Gemm g{HS, W_MGU, 0, 0, DM}; pg8::GroupedOrder S{TILES + 1, NT, 22, c.G, c.bid};
        pg8::EpiSwiGLU E{ACTS, FE};
        pg8::gemm_phase<pg8::EpiSwiGLU, pg8::GroupedOrder, true, true>(c.lds, g, S, E);
    }
    SEAM(19);
    if (IN(20)) {
        const int NT = __builtin_amdgcn_readfirstlane(TILES[0]);
        pg8::Gemm g{ACTS, W_MD, 0, 0, FE}; pg8::GroupedOrder S{TILES + 1, NT, 8, c.G, c.bid};
        pg8::EpiResF32 E{nullptr, OUTS, DM};
        pg8::gemm_phase<pg8::EpiResF32, pg8::GroupedOrder, true, true>(c.lds, g, S, E);
    }
    SEAM(20);
    if (IN(21)) {
        const int gw = c.bid * 8 + c.wave, NGW = c.G * 8;
        for (int m = gw; m < M_TOK; m += NGW) {
            const float p0 = __int_as_float(TOPK[m * 4 + 2]), p1 = __int_as_float(TOPK[m * 4 + 3]); const int q0 = POS[m * 2], q1 = POS[m * 2 + 1];
            const float* xr = X1 + (size_t)m * DM; const float* o0 = OUTS + (size_t)q0 * DM; const float* o1 = OUTS + (size_t)q1 * DM;
            f32x4 v[8]; float ss = 0.f;
#pragma unroll
            for (int j = 0; j < 8; ++j) { const int o = 4 * c.lane + 256 * j; v[j] = *(const f32x4*)(xr + o) + p0 * *(const f32x4*)(o0 + o) + p1 * *(const f32x4*)(o1 + o);
                ss += (v[j].x * v[j].x + v[j].y * v[j].y) + (v[j].z * v[j].z + v[j].w * v[j].w); }
            const float rs = 1.0f / sqrtf(wave_sum(ss) * (1.0f / 2048.0f) + 1e-6f);
#pragma unroll
            for (int j = 0; j < 8; ++j) { const int o = 4 * c.lane + 256 * j; *(f32x4*)(OUT + (size_t)m * DM + o) = v[j] * rs * *(const f32x4*)(final_norm_w + o); }
        }
    }
#undef IN
#undef SEAM
}

extern "C" void kernel_launch(void* const* d_in, const int* in_sizes, int n_in, void* d_out, int out_size, void* d_ws, size_t ws_size, hipStream_t stream) {
    static int grid = 0;
    if (grid == 0) {
        if (n_in != 41 || out_size != M_TOK * DM || ws_size < WS_END) { fprintf(stderr, "kernel_launch: unexpected problem (n_in %d, out %d, ws %zu < %zu)\n", n_in, out_size, ws_size, (size_t)WS_END); grid = -1; return; }
        int dev = 0, cus = 0, per_cu = 0;
        if (hipGetDevice(&dev) != hipSuccess || hipDeviceGetAttribute(&cus, hipDeviceAttributeMultiprocessorCount, dev) != hipSuccess) { grid = -1; return; }
        if (hipFuncSetAttribute((const void*)fwd, hipFuncAttributeMaxDynamicSharedMemorySize, LDS_BYTES) != hipSuccess) { fprintf(stderr, "kernel_launch: hipFuncSetAttribute failed\n"); grid = -1; return; }
        if (hipOccupancyMaxActiveBlocksPerMultiprocessor(&per_cu, (const void*)fwd, 512, LDS_BYTES) != hipSuccess || per_cu < 1) fprintf(stderr, "kernel_launch: occupancy query says %d\n", per_cu);
        (void)hipGetLastError();
        grid = cus;
    }
    if (grid < 0) return;
    (void)hipMemsetAsync((char*)d_ws + WS_CTL, 0, CTL_ZERO_BYTES, stream);
    Args a{};
    for (int i = 0; i < 41; ++i) a.in[i] = (const float*)d_in[i];
    a.out = (float*)d_out; a.ws = (unsigned char*)d_ws;
    if (MK_N_LAUNCHES == 1) { a.lo = 0; a.hi = NPHASE; hipLaunchKernelGGL(fwd, dim3(grid), dim3(512), LDS_BYTES, stream, a); }
    else { for (int p = 0; p < NPHASE; ++p) { a.lo = p; a.hi = p + 1; const int n = ((PROBE_DUP >> p) & 1u) ? 1 + PROBE_EXTRA : 1;
            for (int r = 0; r < n; ++r) hipLaunchKernelGGL(fwd, dim3(grid), dim3(512), LDS_BYTES, stream, a); } }
}
```

```cpp
#include <hip/hip_runtime.h>
#include <cstdio>
#include <cstdint>

#ifndef MK_N_LAUNCHES
#define MK_N_LAUNCHES 1
#endif

#ifndef PROBE_DUP
#define PROBE_DUP 0u
#endif
#ifndef PROBE_EXTRA
#define PROBE_EXTRA 1
#endif
#define GAS __attribute__((address_space(1)))
#define LAS __attribute__((address_space(3)))
typedef unsigned short bf16;
typedef unsigned v4u __attribute__((ext_vector_type(4)));
typedef unsigned v2u __attribute__((ext_vector_type(2)));
typedef float f32x4 __attribute__((ext_vector_type(4)));
typedef float f32x2 __attribute__((ext_vector_type(2)));
typedef short bf16x8 __attribute__((ext_vector_type(8)));

constexpr int M_TOK = 8192, SEQ = 2048, DM = 2048;
constexpr int EVP = 6656, ODP = 7424;
constexpr int FF = 5632, FE = 2816, NEXP = 8;
constexpr int NPHASE = 22;

constexpr size_t MiB = 1u << 20;
constexpr size_t WS_CTL = 0, CTL_ZERO_BYTES = 1 * MiB;
constexpr size_t WS_WLORA = 1 * MiB, WS_WEVIN = 4 * MiB, WS_WEVOUT = 30 * MiB, WS_WFGU = 38 * MiB, WS_WFD = 82 * MiB;
constexpr size_t WS_WODIN = 104 * MiB, WS_WODOUT = 133 * MiB, WS_WMGU = 141 * MiB, WS_WMD = 317 * MiB;
constexpr size_t WS_XN = 405 * MiB, WS_Y = 437 * MiB, WS_X1 = 469 * MiB, WS_SCR = 533 * MiB;
constexpr size_t SC_U = WS_SCR, SC_LW = WS_SCR + 104 * MiB, SC_LA = WS_SCR + 136 * MiB, SC_LG = WS_SCR + 168 * MiB, SC_ALORA = WS_SCR + 200 * MiB;
constexpr size_t SC_YRAW_E = WS_SCR + 208 * MiB, SC_MLQK = WS_SCR + 240 * MiB, SC_HRAW = WS_SCR + 272 * MiB;
constexpr size_t SC_DEN = WS_SCR + 304 * MiB;
constexpr size_t SC_ACT = WS_SCR;
constexpr size_t SC_XBC = WS_SCR + 116 * MiB, SC_ORAW = WS_SCR + 180 * MiB, SC_YRAW_O = WS_SCR + 212 * MiB;
constexpr int MOE_MAXROWS = 18432;
constexpr size_t SC_HS = WS_SCR, SC_ACTS = WS_SCR + 72 * MiB, SC_OUTS = WS_SCR + 171 * MiB;
constexpr size_t SC_TOPK = WS_SCR + 316 * MiB, SC_POS = SC_TOPK + 131072, SC_CNT = SC_POS + 65536, SC_TILES = SC_CNT + 8192;
constexpr size_t WS_END = WS_SCR + 317 * MiB;
static_assert(SC_OUTS + (size_t)MOE_MAXROWS * DM * 4 <= SC_TOPK, "moe map");
static_assert(WS_END <= 907708384ull, "d_ws map exceeds the guaranteed workspace");
constexpr int CW_BAR = 4096;

constexpr int RING_BYTES = 131072, MISC_OFF = RING_BYTES + 320, LDS_BYTES = 147456;

__device__ __forceinline__ float bf2f(bf16 b) { return __uint_as_float(((unsigned)b) << 16); }
__device__ __forceinline__ unsigned f2bf(float f) { unsigned u = __float_as_uint(f); return (u + 0x7fffu + ((u >> 16) & 1u)) >> 16; }
typedef __bf16 bf16v2 __attribute__((ext_vector_type(2)));
__device__ __forceinline__ unsigned cvt_pk_bf16(float lo, float hi) { const bf16v2 v = {(__bf16)lo, (__bf16)hi}; return __builtin_bit_cast(unsigned, v); }
__device__ __forceinline__ float sigmoidf_(float x) { return 1.0f / (1.0f + __expf(-x)); }
__device__ __forceinline__ float siluf_(float x) { return x / (1.0f + __expf(-x)); }
__device__ __forceinline__ float wave_sum(float v) {
#pragma unroll
    for (int o = 1; o < 64; o <<= 1) v += __shfl_xor(v, o);
    return v;
}
template <int CTRL> __device__ __forceinline__ float dppf(float v) { return __builtin_bit_cast(float, __builtin_amdgcn_mov_dpp(__builtin_bit_cast(int, v), CTRL, 0xf, 0xf, false)); }
__device__ __forceinline__ float allred16(float v) { v += dppf<0x128>(v); v += dppf<0x124>(v); v += dppf<0x122>(v); v += dppf<0x121>(v); return v; }

namespace pg8 {
#define PG8_LAS __attribute__((address_space(3)))
typedef unsigned short bf16_t;
typedef unsigned u32x4 __attribute__((ext_vector_type(4)));
constexpr int BM = 256, BK = 64, HALF = 128, HTB = HALF * BK * 2, STAGE_BYTES = 8 * HTB, NXCD = 8, WGM = 8;
__host__ __device__ __forceinline__ int lds_byte(int r, int c) { const int st = (r >> 4) * 2 + (c >> 5), rr = r & 15, cc = c & 31, ob = rr * 64 + cc * 2; return st * 1024 + (ob ^ (((ob >> 9) & 1) << 5)); }
__host__ __device__ __forceinline__ void stage_rc(int b, int& R, int& C) { const int st = b / 1024, sb = b % 1024, swz = sb ^ (((sb >> 9) & 1) << 5); R = (st >> 1) * 16 + swz / 64; C = (st & 1) * 32 + (swz % 64) / 2; }
__host__ __device__ __forceinline__ int perm32(int rho) { const int n = rho >> 4, i = rho & 15; return 8 * (i >> 2) + 4 * n + (i & 3); }

struct Unit { int pm, pn, pc; };
struct Gemm { const bf16_t* A; const bf16_t* Bt; int M, N, K; };

struct StaticOrder {
    int nM, nN, nwg, G, c;
    __device__ void init(int M, int N, int G_, int c_) { nM = M / BM; nN = N / BM; nwg = nM * nN; G = G_; c = c_; }
    __device__ bool next(int i, Unit& u) const {
        const long L = (long)i * G + c; if (L >= nwg) return false;
        int wgid = (int)L; { const int q = nwg / NXCD, r = nwg % NXCD, xcd = wgid % NXCD, off = wgid / NXCD; wgid = (xcd < r ? xcd * (q + 1) : r * (q + 1) + (xcd - r) * q) + off; }
        const int nig = WGM * nN, gid = wgid / nig, fm = gid * WGM, gsz = (nM - fm) < WGM ? (nM - fm) : WGM;
        u.pm = fm + ((wgid % nig) % gsz); u.pn = (wgid % nig) / gsz; u.pc = u.pn; return true;
    }
    __device__ __forceinline__ void a_ready(const Unit&) const {}
    __device__ __forceinline__ void done(const Unit&) const {}
};
struct GroupedOrder {
    const int* tile_e; int NT, npn, G, c;
    __device__ bool next(int i, Unit& u) const {
        const long L = (long)i * G + c; if (L >= (long)NT * npn) return false;
        const int t = (int)(L % NT), pnl = (int)(L / NT);
        const int e = __builtin_amdgcn_readfirstlane(tile_e[t]);
        u.pm = t; u.pn = e * npn + pnl; u.pc = pnl; return true;
    }
    __device__ __forceinline__ void a_ready(const Unit&) const {}
    __device__ __forceinline__ void done(const Unit&) const {}
};

struct EpiBf16 {
    static constexpr bool PERM = true;
    bf16_t* O; int ldc;
    __device__ __forceinline__ void operator()(const f32x4 (&acc)[2][2][4][2], const Unit& u, int wr, int wc, int fr, int fq) const {
        const int row0 = u.pm * BM + wr * 64 + fr, col0 = u.pc * BM + wc * 32 + 8 * fq;
#pragma unroll
        for (int ai = 0; ai < 2; ++ai)
#pragma unroll
            for (int m = 0; m < 4; ++m) { bf16_t* rowp = O + (size_t)(row0 + ai * HALF + m * 16) * ldc + col0;
#pragma unroll
                for (int bj = 0; bj < 2; ++bj) { const f32x4 v0 = acc[ai][bj][m][0], v1 = acc[ai][bj][m][1];
                    u32x4 w; w.x = cvt_pk_bf16(v0[0], v0[1]); w.y = cvt_pk_bf16(v0[2], v0[3]); w.z = cvt_pk_bf16(v1[0], v1[1]); w.w = cvt_pk_bf16(v1[2], v1[3]);
                    *(u32x4*)(rowp + bj * HALF) = w; } }
    }
};
struct EpiSwiGLU {
    static constexpr bool PERM = true;
    bf16_t* O; int ldc;
    __device__ __forceinline__ void operator()(const f32x4 (&acc)[2][2][4][2], const Unit& u, int wr, int wc, int fr, int fq) const {
        const int row0 = u.pm * BM + wr * 64 + fr, col0 = u.pc * HALF + wc * 32 + 8 * fq;
#pragma unroll
        for (int ai = 0; ai < 2; ++ai)
#pragma unroll
            for (int m = 0; m < 4; ++m) { bf16_t* rowp = O + (size_t)(row0 + ai * HALF + m * 16) * ldc + col0;
                float r[8];
#pragma unroll
                for (int n = 0; n < 2; ++n)
#pragma unroll
                    for (int j = 0; j < 4; ++j) { const float g = acc[ai][0][m][n][j], up = acc[ai][1][m][n][j]; r[n * 4 + j] = g * __builtin_amdgcn_rcpf(1.0f + __expf(-g)) * up; }
                u32x4 w; w.x = cvt_pk_bf16(r[0], r[1]); w.y = cvt_pk_bf16(r[2], r[3]); w.z = cvt_pk_bf16(r[4], r[5]); w.w = cvt_pk_bf16(r[6], r[7]);
                *(u32x4*)rowp = w; }
    }
};
struct EpiResF32 {
    static constexpr bool PERM = false;
    const float* res; float* out; int ldc;
    __device__ __forceinline__ void operator()(const f32x4 (&acc)[2][2][4][2], const Unit& u, int wr, int wc, int fr, int fq) const {
        const int row0 = u.pm * BM + wr * 64 + fr, col0 = u.pc * BM + wc * 32 + 4 * fq;
#pragma unroll
        for (int ai = 0; ai < 2; ++ai)
#pragma unroll
            for (int m = 0; m < 4; ++m) { const size_t off = (size_t)(row0 + ai * HALF + m * 16) * ldc + col0;
#pragma unroll
                for (int bj = 0; bj < 2; ++bj)
#pragma unroll
                    for (int n = 0; n < 2; ++n) { f32x4 v = acc[ai][bj][m][n]; if (res) v = v + *(const f32x4*)(res + off + bj * HALF + n * 16); *(f32x4*)(out + off + bj * HALF + n * 16) = v; } }
    }
};
struct EpiLora {
    static constexpr bool PERM = false;
    float* LWAG; const float* w0; const float* a0;
    __device__ __forceinline__ void operator()(const f32x4 (&acc)[2][2][4][2], const Unit& u, int wr, int wc, int fr, int fq) const {
        const int kind = u.pc >> 2; const int row0 = u.pm * BM + wr * 64 + fr, col0 = (u.pc & 3) * BM + wc * 32 + 4 * fq;
        float* dst = LWAG + (size_t)kind * ((size_t)8192 * 1024); const float* bias = kind == 0 ? w0 : a0;
#pragma unroll
        for (int bj = 0; bj < 2; ++bj)
#pragma unroll
            for (int n = 0; n < 2; ++n) { const int c = col0 + bj * HALF + n * 16; f32x4 bv = (f32x4){0.f, 0.f, 0.f, 0.f}; if (kind < 2) bv = *(const f32x4*)(bias + c);
#pragma unroll
                for (int ai = 0; ai < 2; ++ai)
#pragma unroll
                    for (int m = 0; m < 4; ++m) { f32x4 v = acc[ai][bj][m][n] + bv;
                        if (kind < 2) {
#pragma unroll
                            for (int j = 0; j < 4; ++j) { const float s = 1.0f / (1.0f + __expf(-v[j])); v[j] = kind == 0 ? (-0.6065306597126334f * s) : s; } }
                        *(f32x4*)(dst + (size_t)(row0 + ai * HALF + m * 16) * 1024 + c) = v; } }
    }
};

template <class Epi, class Sched, bool ALIGN_EPI, bool SP2>
__device__ __forceinline__ void gemm_phase(PG8_LAS unsigned char* lds, const Gemm g, const Sched& S, const Epi& E) {
    const int tid = threadIdx.x, wid = __builtin_amdgcn_readfirstlane(tid >> 6), lane = tid & 63, wr = wid >> 2, wc = wid & 3, fr = lane & 15, fq = lane >> 4;
    const int K = g.K, nt = K / BK;
    unsigned voffA[2], voffB[2];
#pragma unroll
    for (int i = 0; i < 2; ++i) { int R, C; stage_rc(tid * 16 + i * 8192, R, C); const int Rb = Epi::PERM ? ((R & ~31) + perm32(R & 31)) : R;
        voffA[i] = (unsigned)(R * K + C) * 2u; voffB[i] = (unsigned)(Rb * K + C) * 2u; }
    const size_t kstep = (size_t)(BK * 2);
    const size_t hstep = (size_t)HALF * K * 2;
    const size_t tstep = 2 * hstep;
    const unsigned ldsw = (unsigned)wid * 1024u;
    const int aoff = lds_byte(wr * 64 + fr, fq * 8), boff = lds_byte(wc * 32 + fr, fq * 8);
#define PG8_SA(b, h) (((b) * 2 + (h)) * HTB)
#define PG8_SB(b, h) ((4 + (b) * 2 + (h)) * HTB)
#define PG8_STAGE(bufoff, gbase, voff) do { _Pragma("unroll") for (int _i = 0; _i < 2; ++_i) \
        __builtin_amdgcn_global_load_lds((const unsigned*)((const char*)(gbase) + (voff)[_i]), (PG8_LAS unsigned*)(lds + (bufoff) + ldsw + _i * 8192), 16, 0, 0); } while (0)
#define PG8_LDA(dst, b, h) do { _Pragma("unroll") for (int m = 0; m < 4; ++m) _Pragma("unroll") for (int k = 0; k < 2; ++k) dst[m][k] = *(const PG8_LAS bf16x8*)(lds + PG8_SA(b, h) + aoff + m * 2048 + k * 1024); } while (0)
#define PG8_LDB(dst, b, h) do { _Pragma("unroll") for (int n = 0; n < 2; ++n) _Pragma("unroll") for (int k = 0; k < 2; ++k) dst[n][k] = *(const PG8_LAS bf16x8*)(lds + PG8_SB(b, h) + boff + n * 2048 + k * 1024); } while (0)
#define PG8_MMA(ai, bj, At, Bt) do { __builtin_amdgcn_s_setprio(1); _Pragma("unroll") for (int m = 0; m < 4; ++m) _Pragma("unroll") for (int n = 0; n < 2; ++n) _Pragma("unroll") for (int k = 0; k < 2; ++k) \
        acc[ai][bj][m][n] = __builtin_amdgcn_mfma_f32_16x16x32_bf16(Bt[n][k], At[m][k], acc[ai][bj][m][n], 0, 0, 0); __builtin_amdgcn_s_setprio(0); } while (0)
#define PG8_WAIT_V(n) asm volatile("s_waitcnt vmcnt(" #n ")" ::: "memory")
#define PG8_WAIT_L(n) asm volatile("s_waitcnt lgkmcnt(" #n ")" ::: "memory")
#define PG8_BAR __builtin_amdgcn_s_barrier()
#define PG8_SCHED __builtin_amdgcn_sched_barrier(0)
    Unit cur, nxt; int ui = 0;
    if (!S.next(0, cur)) return;
    f32x4 acc[2][2][4][2];
#pragma unroll
    for (int a = 0; a < 2; ++a)
#pragma unroll
        for (int b = 0; b < 2; ++b)
#pragma unroll
            for (int m = 0; m < 4; ++m)
#pragma unroll
                for (int n = 0; n < 2; ++n) acc[a][b][m][n] = (f32x4){0.f, 0.f, 0.f, 0.f};
    bf16x8 At[4][2], B0[2][2], B1[2][2];
    const char* cA = (const char*)g.A + (size_t)cur.pm * tstep; const char* cB = (const char*)g.Bt + (size_t)cur.pn * tstep;
    S.a_ready(cur);
    if constexpr (SP2) {
        PG8_STAGE(PG8_SB(0, 0), cB, voffB); PG8_STAGE(PG8_SB(0, 1), cB + hstep, voffB); PG8_STAGE(PG8_SA(0, 0), cA, voffA); PG8_STAGE(PG8_SA(0, 1), cA + hstep, voffA);
        if (wr == 1) PG8_BAR;
        PG8_WAIT_V(2); PG8_BAR;
        PG8_STAGE(PG8_SB(1, 0), cB + kstep, voffB); PG8_STAGE(PG8_SA(1, 0), cA + kstep, voffA); PG8_STAGE(PG8_SB(1, 1), cB + hstep + kstep, voffB);
        PG8_WAIT_V(6); PG8_BAR;
    } else {
        PG8_STAGE(PG8_SB(0, 0), cB, voffB); PG8_STAGE(PG8_SA(0, 0), cA, voffA); PG8_STAGE(PG8_SB(0, 1), cB + hstep, voffB); PG8_STAGE(PG8_SA(0, 1), cA + hstep, voffA);
        if (wr == 1) PG8_BAR;
        PG8_WAIT_V(4); PG8_BAR;
        PG8_STAGE(PG8_SB(1, 0), cB + kstep, voffB); PG8_STAGE(PG8_SA(1, 0), cA + kstep, voffA); PG8_STAGE(PG8_SB(1, 1), cB + hstep + kstep, voffB);
        PG8_WAIT_V(6); PG8_BAR;
    }
    for (;;) {
        const bool has_next = S.next(ui + 1, nxt);
        const char* nA = has_next ? (const char*)g.A + (size_t)nxt.pm * tstep : cA; const char* nB = has_next ? (const char*)g.Bt + (size_t)nxt.pn * tstep : cB;
        for (int t = 0; t < nt; t += 2) {
            const bool last = (t == nt - 2);
            const char* a1 = cA + (size_t)(t + 1) * kstep;
            const char* a2 = last ? nA : cA + (size_t)(t + 2) * kstep; const char* b2 = last ? nB : cB + (size_t)(t + 2) * kstep;
            const char* a3 = a2 + kstep; const char* b3 = b2 + kstep;
            if (last && has_next) S.a_ready(nxt);
            if constexpr (SP2) {
            PG8_LDB(B0, 0, 0); PG8_LDB(B1, 0, 1); PG8_SCHED; PG8_LDA(At, 0, 0); PG8_STAGE(PG8_SA(1, 1), a1 + hstep, voffA);
            PG8_WAIT_V(8); PG8_WAIT_L(0); PG8_BAR; PG8_MMA(0, 0, At, B0); PG8_MMA(0, 1, At, B1); PG8_BAR; PG8_SCHED;
            PG8_LDA(At, 0, 1); PG8_STAGE(PG8_SB(0, 0), b2, voffB); PG8_STAGE(PG8_SB(0, 1), b2 + hstep, voffB); PG8_STAGE(PG8_SA(0, 0), a2, voffA);
            PG8_WAIT_V(8); PG8_WAIT_L(0); PG8_BAR; PG8_MMA(1, 0, At, B0); PG8_MMA(1, 1, At, B1); PG8_BAR; PG8_SCHED;
            PG8_LDB(B0, 1, 0); PG8_LDB(B1, 1, 1); PG8_SCHED; PG8_LDA(At, 1, 0); PG8_STAGE(PG8_SA(0, 1), a2 + hstep, voffA);
            PG8_WAIT_V(8); PG8_WAIT_L(0); PG8_BAR; PG8_MMA(0, 0, At, B0); PG8_MMA(0, 1, At, B1); PG8_BAR; PG8_SCHED;
            PG8_LDA(At, 1, 1); PG8_STAGE(PG8_SB(1, 0), b3, voffB); PG8_STAGE(PG8_SB(1, 1), b3 + hstep, voffB); PG8_STAGE(PG8_SA(1, 0), a3, voffA);
            PG8_WAIT_V(8); PG8_WAIT_L(0); PG8_BAR; PG8_MMA(1, 0, At, B0); PG8_MMA(1, 1, At, B1); PG8_BAR; PG8_SCHED;
            } else {
            PG8_LDB(B0, 0, 0); PG8_SCHED; PG8_LDA(At, 0, 0); PG8_STAGE(PG8_SA(1, 1), a1 + hstep, voffA);
            PG8_WAIT_L(8); PG8_BAR; PG8_WAIT_L(0); PG8_MMA(0, 0, At, B0); PG8_BAR; PG8_SCHED;
            PG8_LDB(B1, 0, 1); PG8_STAGE(PG8_SB(0, 0), b2, voffB);
            PG8_BAR; PG8_WAIT_L(0); PG8_MMA(0, 1, At, B1); PG8_BAR;
            PG8_LDA(At, 0, 1); PG8_STAGE(PG8_SA(0, 0), a2, voffA);
            PG8_BAR; PG8_WAIT_L(0); PG8_MMA(1, 0, At, B0); PG8_BAR; PG8_SCHED;
            PG8_STAGE(PG8_SB(0, 1), b2 + hstep, voffB);
            PG8_WAIT_V(6); PG8_BAR; PG8_MMA(1, 1, At, B1); PG8_BAR;
            PG8_LDB(B0, 1, 0); PG8_SCHED; PG8_LDA(At, 1, 0); PG8_STAGE(PG8_SA(0, 1), a2 + hstep, voffA);
            PG8_WAIT_L(8); PG8_BAR; PG8_WAIT_L(0); PG8_MMA(0, 0, At, B0); PG8_BAR; PG8_SCHED;
            PG8_LDB(B1, 1, 1); PG8_STAGE(PG8_SB(1, 0), b3, voffB);
            PG8_BAR; PG8_WAIT_L(0); PG8_MMA(0, 1, At, B1); PG8_BAR;
            PG8_LDA(At, 1, 1); PG8_STAGE(PG8_SA(1, 0), a3, voffA);
            PG8_BAR; PG8_WAIT_L(0); PG8_MMA(1, 0, At, B0); PG8_BAR; PG8_SCHED;
            PG8_STAGE(PG8_SB(1, 1), b3 + hstep, voffB);
            PG8_WAIT_V(6); PG8_BAR; PG8_MMA(1, 1, At, B1); PG8_BAR;
            }
        }
        if constexpr (ALIGN_EPI) { if (wr == 0) PG8_BAR; }
        E(acc, cur, wr, wc, fr, fq); S.done(cur);
        if (!has_next) break;
#pragma unroll
        for (int a = 0; a < 2; ++a)
#pragma unroll
            for (int b = 0; b < 2; ++b)
#pragma unroll
                for (int m = 0; m < 4; ++m)
#pragma unroll
                    for (int n = 0; n < 2; ++n) acc[a][b][m][n] = (f32x4){0.f, 0.f, 0.f, 0.f};
        cur = nxt; cA = nA; cB = nB; ++ui;
        if constexpr (ALIGN_EPI) { if (wr == 1) PG8_BAR; }
    }
    PG8_WAIT_V(0);
    if constexpr (!ALIGN_EPI) { if (wr == 0) PG8_BAR; }
    PG8_BAR;
#undef PG8_SA
#undef PG8_SB
#undef PG8_STAGE
#undef PG8_LDA
#undef PG8_LDB
#undef PG8_MMA
#undef PG8_WAIT_V
#undef PG8_WAIT_L
#undef PG8_BAR
#undef PG8_SCHED
}
}

#define XB_TMO      128
#define XB_XCNT(j)  (256  + 64 * (j))
#define XB_XSUB(j)  (1280 + 64 * (j))
#define XB_XGEN(j)  (2304 + 64 * (j))
#define XB_TOP      3328
#define XB_TOPGEN   3392
#define XCD_BAR_WORDS 3456
#define XB_SPIN_CAP (1u << 18)
__device__ __forceinline__ unsigned xb_ld(unsigned* p)              { return __hip_atomic_load(p, __ATOMIC_RELAXED, __HIP_MEMORY_SCOPE_AGENT); }
__device__ __forceinline__ unsigned xb_add(unsigned* p, unsigned v) { return __hip_atomic_fetch_add(p, v, __ATOMIC_RELAXED, __HIP_MEMORY_SCOPE_AGENT); }
__device__ __forceinline__ unsigned xb_xcc_id() { return (unsigned)__builtin_amdgcn_s_getreg((3 << 11) | 20) & 0xFu; }
#define XB_SPIN(cond, bar) do { unsigned _sp = 0; while (cond) { __builtin_amdgcn_s_sleep(1); \
    if ((++_sp & 255u) == 0u) { if (xb_ld(&(bar)[XB_TMO])) break; if (_sp > XB_SPIN_CAP) { atomicAdd(&(bar)[XB_TMO], 1u); break; } } } } while (0)
struct XcdBarrier { unsigned* bar; unsigned x; volatile LAS unsigned* st; };
__device__ __forceinline__ XcdBarrier xcd_barrier_post(unsigned* bar, volatile LAS unsigned* st) {
    XcdBarrier b; b.bar = bar; b.x = xb_xcc_id(); b.st = st;
    if (threadIdx.x == 0) (void)xb_add(&bar[XB_XCNT(b.x)], 1u);
    return b;
}
__device__ __forceinline__ void xcd_barrier_complete(unsigned* bar, unsigned x, unsigned& nloc, unsigned& nx) {
    const unsigned G = gridDim.x * gridDim.y * gridDim.z;
    unsigned sum, cnt, mine, sp = 0u;
    for (;;) {
        sum = 0u; cnt = 0u; mine = 0u;
#pragma unroll
        for (unsigned j = 0; j < 16; ++j) { const unsigned c = xb_ld(&bar[XB_XCNT(j)]); sum += c; cnt += (c > 0u) ? 1u : 0u; mine = (j == x) ? c : mine; }
        if (sum == G) break;
        __builtin_amdgcn_s_sleep(1);
        if ((++sp & 255u) == 0u) { if (xb_ld(&bar[XB_TMO])) break; if (sp > XB_SPIN_CAP) { atomicAdd(&bar[XB_TMO], 1u); break; } }
    }
    nloc = mine > 0u ? mine : 1u; nx = cnt > 0u ? cnt : 1u;
}
__device__ __forceinline__ void xcd_barrier(const XcdBarrier& b) {
    asm volatile("s_waitcnt vmcnt(0)" ::: "memory");
    __syncthreads();
    if (threadIdx.x == 0) {
        unsigned* bar = b.bar;
        __builtin_amdgcn_s_waitcnt(0);
        unsigned nloc = b.st[0], nx = b.st[1];
        if (nloc == 0u) { xcd_barrier_complete(bar, b.x, nloc, nx); b.st[0] = nloc; b.st[1] = nx; }
        const unsigned old = xb_add(&bar[XB_XSUB(b.x)], 1u);
        const unsigned gen = old / nloc;
        if (old + 1u == (gen + 1u) * nloc) {
            __builtin_amdgcn_fence(__ATOMIC_RELEASE, "agent");
            asm volatile("s_waitcnt vmcnt(0)" ::: "memory");
            const unsigned og = xb_add(&bar[XB_TOP], 1u);
            const unsigned tg = og / nx;
            if (og + 1u == (tg + 1u) * nx) xb_add(&bar[XB_TOPGEN], 1u);
            else XB_SPIN(xb_ld(&bar[XB_TOPGEN]) == tg, bar);
            __builtin_amdgcn_fence(__ATOMIC_ACQUIRE, "agent");
            xb_add(&bar[XB_XGEN(b.x)], 1u);
            asm volatile("s_waitcnt vmcnt(0)" ::: "memory");
        } else {
            XB_SPIN(xb_ld(&bar[XB_XGEN(b.x)]) == gen, bar);
            __builtin_amdgcn_fence(__ATOMIC_ACQUIRE, "agent");
            asm volatile("s_waitcnt vmcnt(0)" ::: "memory");
        }
    }
    __syncthreads();
}

struct Ctx { LAS unsigned char* lds; int tid, lane, wave, bid, G; };

struct ConvTile { const float* W; bf16* WT; int K, N, mode, k0, n0; };
__device__ __forceinline__ void conv_load(const ConvTile& t, f32x4 (&rg)[4], int tid) {
    const int nc = (tid & 15) * 4, kr = tid >> 4;
#pragma unroll
    for (int i = 0; i < 4; ++i) rg[i] = (t.n0 + nc < t.N) ? *(const f32x4*)(t.W + (size_t)(t.k0 + kr + 32 * i) * t.N + t.n0 + nc) : (f32x4){0.f, 0.f, 0.f, 0.f};
}
__device__ __forceinline__ void conv_emit(const ConvTile& t, const f32x4 (&rg)[4], LAS float* scr, int tid) {
    { const int nc = (tid & 15) * 4, kr = tid >> 4;
#pragma unroll
      for (int i = 0; i < 4; ++i) { LAS float* d = scr + (kr + 32 * i) * 65 + nc; d[0] = rg[i].x; d[1] = rg[i].y; d[2] = rg[i].z; d[3] = rg[i].w; } }
    __syncthreads();
#pragma unroll
    for (int h = 0; h < 2; ++h) { const int id = tid + 512 * h, nn = id >> 4, kc = id & 15; float v[8];
#pragma unroll
        for (int j = 0; j < 8; ++j) v[j] = scr[(kc * 8 + j) * 65 + nn];
        const int ns = t.n0 + nn; const int drow = t.mode == 0 ? ns : ((ns >> 7) * 256 + (ns & 127) + (t.mode == 2 ? 128 : 0));
        v4u o; o.x = cvt_pk_bf16(v[0], v[1]); o.y = cvt_pk_bf16(v[2], v[3]); o.z = cvt_pk_bf16(v[4], v[5]); o.w = cvt_pk_bf16(v[6], v[7]);
        *(v4u*)(t.WT + (size_t)drow * t.K + t.k0 + kc * 8) = o; }
    __syncthreads();
}
struct ConvKind { const float* W; bf16* WT; int K, N, Npad, mode, nmat; size_t sstr, dstr; };
__device__ __forceinline__ bool conv_item(const ConvKind (&kinds)[10], int item, ConvTile& t) {
    bool found = false;
#pragma unroll
    for (int q = 0; q < 10; ++q) { const int nkt = kinds[q].K / 128, nnt = kinds[q].Npad / 64, per = nkt * nnt, cnt = per * kinds[q].nmat;
        if (!found && item < cnt) { const int mat = item / per, r = item % per; t.W = kinds[q].W + (size_t)mat * kinds[q].sstr; t.WT = kinds[q].WT + (size_t)mat * kinds[q].dstr; t.K = kinds[q].K; t.N = kinds[q].N; t.mode = kinds[q].mode;
            t.k0 = (r / nnt) * 128; t.n0 = (r % nnt) * 64; found = true; }
        if (!found) item -= cnt; }
    return found;
}
__device__ __forceinline__ void conv_run(const ConvKind (&kinds)[10], int lo, int hi, int wk, int nw, LAS float* scr, int tid) {
    ConvTile cur, nxt; f32x4 ra[4], rb[4];
    int item = lo + wk; bool have = item < hi && conv_item(kinds, item, cur);
    if (have) conv_load(cur, ra, tid);
    while (have) {
        item += nw; const bool hn = item < hi && conv_item(kinds, item, nxt);
        if (hn) conv_load(nxt, rb, tid);
        conv_emit(cur, ra, scr, tid);
        have = hn; cur = nxt;
#pragma unroll
        for (int i = 0; i < 4; ++i) ra[i] = rb[i];
    }
}
constexpr int CV_P0 = 5564, CV_P1 = 10300, CV_P5 = 16950, CV_P9 = 20150, CV_P12 = 22550, CV_ALL = 25664;
__device__ __forceinline__ void rmsnorm_row_bf16(const float* xr, const float* w, bf16* orow, int lane) {
    f32x4 v[8]; float ss = 0.f;
#pragma unroll
    for (int j = 0; j < 8; ++j) { v[j] = *(const f32x4*)(xr + 4 * lane + 256 * j); ss += (v[j].x * v[j].x + v[j].y * v[j].y) + (v[j].z * v[j].z + v[j].w * v[j].w); }
    const float rs = 1.0f / sqrtf(wave_sum(ss) * (1.0f / 2048.0f) + 1e-6f);
#pragma unroll
    for (int j = 0; j < 8; ++j) { const f32x4 wv = *(const f32x4*)(w + 4 * lane + 256 * j); const f32x4 o = v[j] * rs * wv;
        v2u p; p.x = cvt_pk_bf16(o.x, o.y); p.y = cvt_pk_bf16(o.z, o.w); *(v2u*)(orow + 4 * lane + 256 * j) = p; }
}
__device__ __forceinline__ void rmsnorm_phase(const Ctx& c, const float* X, const float* w, bf16* XN) {
    const int gw = c.bid * 8 + c.wave, NGW = c.G * 8;
    for (int m = gw; m < M_TOK; m += NGW) rmsnorm_row_bf16(X + (size_t)m * DM, w, XN + (size_t)m * DM, c.lane);
}

__device__ __forceinline__ LAS unsigned char* launder_lds(LAS unsigned char* p) {
#if defined(__HIP_DEVICE_COMPILE__)
    unsigned v = __builtin_bit_cast(unsigned, p); asm volatile("" : "+v"(v)); return __builtin_bit_cast(LAS unsigned char*, v);
#else
    return p;
#endif
}
__device__ __forceinline__ bf16x8 frag_row(const LAS bf16* img, int stride, int r0, int k0, int lane) { return *(const LAS bf16x8*)(img + (r0 + (lane & 15)) * stride + k0 + 8 * (lane >> 4)); }
typedef short s16x4 __attribute__((ext_vector_type(4)));
__device__ __forceinline__ bf16x8 frag_tr(const LAS bf16* img, int stride, int n0, int k0, int lane) {
    const int g = lane >> 4, qq = (lane & 15) >> 2, pp = lane & 3;
    const LAS bf16* p0 = img + (k0 + 8 * g + qq) * stride + n0 + 4 * pp;
#if defined(__HIP_DEVICE_COMPILE__)
    const s16x4 lo = __builtin_amdgcn_ds_read_tr16_b64_v4i16((LAS s16x4*)p0), hi = __builtin_amdgcn_ds_read_tr16_b64_v4i16((LAS s16x4*)(p0 + 4 * stride));
#else
    const s16x4 lo = (s16x4){0, 0, 0, 0}, hi = lo; (void)p0;
#endif
    return (bf16x8){lo.x, lo.y, lo.z, lo.w, hi.x, hi.y, hi.z, hi.w};
}
__device__ __forceinline__ v4u pack8(const f32x4 a, const f32x4 b) { v4u o; o.x = cvt_pk_bf16(a[0], a[1]); o.y = cvt_pk_bf16(a[2], a[3]); o.z = cvt_pk_bf16(b[0], b[1]); o.w = cvt_pk_bf16(b[2], b[3]); return o; }
__device__ __forceinline__ float softplusf_(float x) { return x > 20.0f ? x : log1pf(__expf(x)); }

template <bool ML>
__device__ __forceinline__ void chunk_scan(const Ctx& c, int task, const bf16* U, const float* SRC, const float* par0, const float* par1, const float* par2, float* OUTP, float* DEN) {
    constexpr int NP = ML ? 5 : 4, SX = 88, S1 = 136, SM = 72, UP = ML ? EVP : ODP;
    int batch, head, slice;
    if (ML) { slice = task & 3; head = (task >> 2) & 3; batch = task >> 4; } else { slice = 0; head = task & 15; batch = task >> 4; }
    const int lane = c.lane, w = c.wave, r = lane & 15, q = lane >> 4, trow = c.tid >> 3, part = c.tid & 7;
    const float g0 = ML ? par0[head] : par0[head];
    const float g1 = ML ? par1[head] : -__expf(par1[head]);
    const float Dh = ML ? 0.f : par2[head];
    const int qoff = ML ? head * 128 : 1536 + (head >> 2) * 128, koff = ML ? 512 + head * 128 : 1024 + (head >> 2) * 128, srcw = ML ? 1024 : 2048;
    f32x4 Hacc[NP];
#pragma unroll
    for (int i = 0; i < NP; ++i) Hacc[i] = (f32x4){0.f, 0.f, 0.f, 0.f};
    f32x4 rc[4], rb[4], rx[2]; v4u rv; float gr0, gr1;
#define CS_LOAD(ch) do { const size_t m_ = (size_t)batch * SEQ + (ch) * 64 + trow; const float* sr_ = SRC + m_ * srcw; \
        _Pragma("unroll") for (int i_ = 0; i_ < 4; ++i_) { rc[i_] = *(const f32x4*)(sr_ + qoff + 16 * part + 4 * i_); rb[i_] = *(const f32x4*)(sr_ + koff + 16 * part + 4 * i_); } \
        if (ML) rv = *(const v4u*)(U + m_ * UP + 4544 + head * 256 + slice * 64 + 8 * part); else { rx[0] = *(const f32x4*)(sr_ + head * 64 + 8 * part); rx[1] = *(const f32x4*)(sr_ + head * 64 + 8 * part + 4); } \
        const bf16* ug_ = U + ((size_t)batch * SEQ + (ch) * 64 + lane) * UP; \
        if (ML) { gr0 = bf2f(ug_[6592 + head]); gr1 = bf2f(ug_[6596 + head]); } else { gr0 = bf2f(ug_[7168 + head]); gr1 = 0.f; } } while (0)
    CS_LOAD(0);
    for (int ch = 0; ch < 32; ++ch) {
        LAS bf16* Cb = (LAS bf16*)launder_lds(c.lds); LAS bf16* Bb = Cb + 64 * S1; LAS bf16* Ce = Bb + 64 * S1; LAS bf16* Hb = Ce + 64 * S1; LAS bf16* Xs = Hb + 80 * S1; LAS bf16* Xw = Xs + 64 * SX; LAS bf16* Mm = Xw + 64 * SX;
        LAS float* cumL = (LAS float*)(Mm + 64 * SM); LAS float* wL = cumL + 64;
        float a_t, wgt;
        if (ML) { wgt = __expf(gr0 + g0); a_t = -softplusf_(-(gr1 + g1)); } else { wgt = softplusf_(gr0 + g0); a_t = g1 * wgt; }
        float cum = a_t;
#pragma unroll
        for (int o = 1; o < 64; o <<= 1) { const float v_ = __shfl_up(cum, o); if (lane >= o) cum += v_; }
        const float gtot = __shfl(cum, 63);
        const float cum_t = __shfl(cum, trow), w_t = __shfl(wgt, trow);
        { const float sc = ML ? 0.08838834764831845f : 1.0f; const float et = __expf(cum_t) * sc, wx = w_t * __expf(gtot - cum_t);
          *(v4u*)(Cb + trow * S1 + 16 * part) = pack8(rc[0] * sc, rc[1] * sc); *(v4u*)(Cb + trow * S1 + 16 * part + 8) = pack8(rc[2] * sc, rc[3] * sc);
          *(v4u*)(Ce + trow * S1 + 16 * part) = pack8(rc[0] * et, rc[1] * et); *(v4u*)(Ce + trow * S1 + 16 * part + 8) = pack8(rc[2] * et, rc[3] * et);
          *(v4u*)(Bb + trow * S1 + 16 * part) = pack8(rb[0], rb[1]); *(v4u*)(Bb + trow * S1 + 16 * part + 8) = pack8(rb[2], rb[3]);
          f32x4 x0, x1;
          if (ML) { x0 = (f32x4){__uint_as_float(rv.x << 16), __uint_as_float(rv.x & 0xffff0000u), __uint_as_float(rv.y << 16), __uint_as_float(rv.y & 0xffff0000u)};
                    x1 = (f32x4){__uint_as_float(rv.z << 16), __uint_as_float(rv.z & 0xffff0000u), __uint_as_float(rv.w << 16), __uint_as_float(rv.w & 0xffff0000u)}; }
          else { x0 = rx[0]; x1 = rx[1]; }
          *(v4u*)(Xs + trow * SX + 8 * part) = pack8(x0, x1); *(v4u*)(Xw + trow * SX + 8 * part) = pack8(x0 * wx, x1 * wx);
          if (ML && part == 0) { const f32x4 z = (f32x4){0.f, 0.f, 0.f, 0.f};
              *(v4u*)(Xs + trow * SX + 64) = pack8((f32x4){1.f, 0.f, 0.f, 0.f}, z); *(v4u*)(Xs + trow * SX + 72) = pack8(z, z);
              *(v4u*)(Xw + trow * SX + 64) = pack8((f32x4){wx, 0.f, 0.f, 0.f}, z); *(v4u*)(Xw + trow * SX + 72) = pack8(z, z); }
#pragma unroll
          for (int pt = 0; pt < NP; ++pt) { v2u hp; hp.x = cvt_pk_bf16(Hacc[pt][0], Hacc[pt][1]); hp.y = cvt_pk_bf16(Hacc[pt][2], Hacc[pt][3]); *(v2u*)(Hb + (16 * pt + r) * S1 + 16 * w + 4 * q) = hp; }
          if (w == 0) { cumL[lane] = cum; wL[lane] = wgt; } }
        if (ch + 1 < 32) CS_LOAD(ch + 1);
        __syncthreads();
        { const int tt = w >> 1;
#pragma unroll
          for (int i = 0; i < 2; ++i) { const int ts = 2 * (w & 1) + i; f32x4 acc = (f32x4){0.f, 0.f, 0.f, 0.f};
              if (ts <= tt) {
#pragma unroll
                  for (int kk = 0; kk < 4; ++kk) acc = __builtin_amdgcn_mfma_f32_16x16x32_bf16(frag_row(Bb, S1, 16 * ts, 32 * kk, lane), frag_row(Cb, S1, 16 * tt, 32 * kk, lane), acc, 0, 0, 0);
                  const int t = 16 * tt + r; const float ct = cumL[t];
#pragma unroll
                  for (int j = 0; j < 4; ++j) { const int sj = 16 * ts + 4 * q + j; acc[j] = (sj <= t) ? acc[j] * __expf(ct - cumL[sj]) * wL[sj] : 0.f; } }
              v2u mp; mp.x = cvt_pk_bf16(acc[0], acc[1]); mp.y = cvt_pk_bf16(acc[2], acc[3]); *(v2u*)(Mm + (16 * tt + r) * SM + 16 * ts + 4 * q) = mp; }
          const float eg = __expf(gtot);
#pragma unroll
          for (int pt = 0; pt < NP; ++pt) Hacc[pt] = Hacc[pt] * eg;
#pragma unroll
          for (int ks = 0; ks < 2; ++ks) { const bf16x8 af = frag_tr(Bb, S1, 16 * w, 32 * ks, lane);
#pragma unroll
              for (int pt = 0; pt < NP; ++pt) Hacc[pt] = __builtin_amdgcn_mfma_f32_16x16x32_bf16(af, frag_tr(Xw, SX, 16 * pt, 32 * ks, lane), Hacc[pt], 0, 0, 0); } }
        __syncthreads();
        { const int tt = w >> 1, half = w & 1; const size_t mrow = (size_t)batch * SEQ + ch * 64 + 16 * tt + r;
#pragma unroll
          for (int i = 0; i < 3; ++i) { const int pt = half ? 2 + i : (i < 2 ? i : 4); if ((half && i == 2) || (!ML && i == 2)) continue;
              f32x4 acc = (f32x4){0.f, 0.f, 0.f, 0.f};
#pragma unroll
              for (int ks = 0; ks < 2; ++ks) acc = __builtin_amdgcn_mfma_f32_16x16x32_bf16(frag_tr(Xs, SX, 16 * pt, 32 * ks, lane), frag_row(Mm, SM, 16 * tt, 32 * ks, lane), acc, 0, 0, 0);
#pragma unroll
              for (int kk = 0; kk < 4; ++kk) acc = __builtin_amdgcn_mfma_f32_16x16x32_bf16(frag_row(Hb, S1, 16 * pt, 32 * kk, lane), frag_row(Ce, S1, 16 * tt, 32 * kk, lane), acc, 0, 0, 0);
              if (ML) { if (pt < 4) *(f32x4*)(OUTP + mrow * 1024 + head * 256 + slice * 64 + 16 * pt + 4 * q) = acc; else if (q == 0 && slice == 0) DEN[mrow * 4 + head] = acc[0]; }
              else { const v2u xv = *(const LAS v2u*)(Xs + (16 * tt + r) * SX + 16 * pt + 4 * q);
                     acc[0] += Dh * __uint_as_float(xv.x << 16); acc[1] += Dh * __uint_as_float(xv.x & 0xffff0000u); acc[2] += Dh * __uint_as_float(xv.y << 16); acc[3] += Dh * __uint_as_float(xv.y & 0xffff0000u);
                     *(f32x4*)(OUTP + mrow * 1024 + head * 64 + 16 * pt + 4 * q) = acc; } } }
        __syncthreads();
    }
#undef CS_LOAD
}


__device__ __forceinline__ void chunk_hgrn(const Ctx& c, int task, const bf16* U, const float* lbl, float* ORAW) {
    constexpr int S1 = 136, SX = 72, SM = 72, LFS = 132;
    const int slice = task & 1, head = (task >> 1) & 7, batch = task >> 4;
    constexpr int LBL_OFF = (3 * 64 * S1 + 64 * SX + 64 * SM) * 2 + (64 * LFS + 512) * 4;
    { LAS float* LBL0 = (LAS float*)(c.lds + LBL_OFF); if (c.tid < 128) { const int a = head * 128 + c.tid; LBL0[c.tid] = 1.0f / (1.0f + __expf(lbl[a] - lbl[1024 + a])); } }
    const int lane = c.lane, w = c.wave, r = lane & 15, q = lane >> 4, trow = c.tid >> 3, part = c.tid & 7;
    f32x4 Hacc[4];
#pragma unroll
    for (int i = 0; i < 4; ++i) Hacc[i] = (f32x4){0.f, 0.f, 0.f, 0.f};
    v4u rq[2], rf[2], ri;
#define HG_LOAD(ch) do { const bf16* ur_ = U + ((size_t)batch * SEQ + (ch) * 64 + trow) * ODP; \
        rq[0] = *(const v4u*)(ur_ + head * 128 + 16 * part); rq[1] = *(const v4u*)(ur_ + head * 128 + 16 * part + 8); \
        rf[0] = *(const v4u*)(ur_ + 1024 + head * 128 + 16 * part); rf[1] = *(const v4u*)(ur_ + 1024 + head * 128 + 16 * part + 8); \
        ri = *(const v4u*)(ur_ + 2048 + head * 128 + slice * 64 + 8 * part); } while (0)
#define HG_UNPK(dst, src) do { dst[0] = __uint_as_float((src).x << 16); dst[1] = __uint_as_float((src).x & 0xffff0000u); dst[2] = __uint_as_float((src).y << 16); dst[3] = __uint_as_float((src).y & 0xffff0000u); \
        dst[4] = __uint_as_float((src).z << 16); dst[5] = __uint_as_float((src).z & 0xffff0000u); dst[6] = __uint_as_float((src).w << 16); dst[7] = __uint_as_float((src).w & 0xffff0000u); } while (0)
    HG_LOAD(0);
    __syncthreads();
    for (int ch = 0; ch < 32; ++ch) {
        LAS bf16* Qi = (LAS bf16*)launder_lds(c.lds); LAS bf16* Ki = Qi + 64 * S1; LAS bf16* Hb = Ki + 64 * S1; LAS bf16* Xs = Hb + 64 * S1; LAS bf16* Mm = Xs + 64 * SX;
        LAS float* LF = (LAS float*)(Mm + 64 * SM); LAS float* SEGT = LF + 64 * LFS; LAS float* LBL = SEGT + 512;
#pragma unroll
        for (int h2 = 0; h2 < 2; ++h2) { float fp[8]; HG_UNPK(fp, rf[h2]);
            const f32x4 b0 = *(const LAS f32x4*)(LBL + 16 * part + 8 * h2), b1 = *(const LAS f32x4*)(LBL + 16 * part + 8 * h2 + 4); float lf[8];
#pragma unroll
            for (int j = 0; j < 8; ++j) { const float lbv = j < 4 ? b0[j & 3] : b1[j & 3]; lf[j] = __logf(lbv + (1.0f - lbv) * sigmoidf_(fp[j])); }
            *(LAS f32x4*)(LF + trow * LFS + 16 * part + 8 * h2) = (f32x4){lf[0], lf[1], lf[2], lf[3]}; *(LAS f32x4*)(LF + trow * LFS + 16 * part + 8 * h2 + 4) = (f32x4){lf[4], lf[5], lf[6], lf[7]}; }
        __syncthreads();
        { const int k = c.tid & 127, seg = c.tid >> 7; float run = 0.f;
#pragma unroll
          for (int i = 0; i < 16; ++i) { run += LF[(16 * seg + i) * LFS + k]; LF[(16 * seg + i) * LFS + k] = run; }
          SEGT[seg * 128 + k] = run; }
        __syncthreads();
        { const int seg = trow >> 4;
#pragma unroll
          for (int h2 = 0; h2 < 2; ++h2) { float fp[8], qr[8], qt[8], kt[8]; HG_UNPK(fp, rf[h2]); HG_UNPK(qr, rq[h2]);
#pragma unroll
              for (int j4 = 0; j4 < 2; ++j4) { const int kb = 16 * part + 8 * h2 + 4 * j4;
                  const f32x4 l = *(const LAS f32x4*)(LF + trow * LFS + kb), l31 = *(const LAS f32x4*)(LF + 31 * LFS + kb), bb = *(const LAS f32x4*)(LBL + kb);
                  const f32x4 s0 = *(const LAS f32x4*)(SEGT + kb), s1 = *(const LAS f32x4*)(SEGT + 128 + kb), s2 = *(const LAS f32x4*)(SEGT + 256 + kb);
#pragma unroll
                  for (int e = 0; e < 4; ++e) { float off = 0.f; if (seg > 0) off += s0[e]; if (seg > 1) off += s1[e]; if (seg > 2) off += s2[e];
                      const float d = (l[e] + off) - (l31[e] + s0[e]); const int j = 4 * j4 + e;
                      qt[j] = siluf_(qr[j]) * __expf(d); kt[j] = (1.0f - bb[e]) * (1.0f - sigmoidf_(fp[j])) * __expf(-d); } }
              *(v4u*)(Qi + trow * S1 + 16 * part + 8 * h2) = pack8((f32x4){qt[0], qt[1], qt[2], qt[3]}, (f32x4){qt[4], qt[5], qt[6], qt[7]});
              *(v4u*)(Ki + trow * S1 + 16 * part + 8 * h2) = pack8((f32x4){kt[0], kt[1], kt[2], kt[3]}, (f32x4){kt[4], kt[5], kt[6], kt[7]}); }
          *(v4u*)(Xs + trow * SX + 8 * part) = ri; }
        float eg[4], egr[4];
        { const int kb = 16 * w + 4 * q;
          const f32x4 l31 = *(const LAS f32x4*)(LF + 31 * LFS + kb), l63 = *(const LAS f32x4*)(LF + 63 * LFS + kb);
          const f32x4 s0 = *(const LAS f32x4*)(SEGT + kb), s1 = *(const LAS f32x4*)(SEGT + 128 + kb), s2 = *(const LAS f32x4*)(SEGT + 256 + kb);
          float er[4];
#pragma unroll
          for (int j = 0; j < 4; ++j) { const float rf_ = l31[j] + s0[j], g_ = l63[j] + s0[j] + s1[j] + s2[j]; er[j] = __expf(rf_); eg[j] = __expf(g_); egr[j] = __expf(g_ - rf_); }
#pragma unroll
          for (int pt = 0; pt < 4; ++pt) { v2u hp; hp.x = cvt_pk_bf16(Hacc[pt][0] * er[0], Hacc[pt][1] * er[1]); hp.y = cvt_pk_bf16(Hacc[pt][2] * er[2], Hacc[pt][3] * er[3]); *(v2u*)(Hb + (16 * pt + r) * S1 + 16 * w + 4 * q) = hp; } }
        if (ch + 1 < 32) HG_LOAD(ch + 1);
        __syncthreads();
        { const int tt = w >> 1;
#pragma unroll
          for (int i = 0; i < 2; ++i) { const int ts = 2 * (w & 1) + i; f32x4 acc = (f32x4){0.f, 0.f, 0.f, 0.f};
              if (ts <= tt) {
#pragma unroll
                  for (int k4 = 0; k4 < 4; ++k4) acc = __builtin_amdgcn_mfma_f32_16x16x32_bf16(frag_row(Ki, S1, 16 * ts, 32 * k4, lane), frag_row(Qi, S1, 16 * tt, 32 * k4, lane), acc, 0, 0, 0);
                  const int t = 16 * tt + r;
#pragma unroll
                  for (int j = 0; j < 4; ++j) { const int sj = 16 * ts + 4 * q + j; acc[j] = (sj <= t) ? acc[j] : 0.f; } }
              v2u mp; mp.x = cvt_pk_bf16(acc[0], acc[1]); mp.y = cvt_pk_bf16(acc[2], acc[3]); *(v2u*)(Mm + (16 * tt + r) * SM + 16 * ts + 4 * q) = mp; }
          f32x4 tmp[4];
#pragma unroll
          for (int pt = 0; pt < 4; ++pt) tmp[pt] = (f32x4){0.f, 0.f, 0.f, 0.f};
#pragma unroll
          for (int ks = 0; ks < 2; ++ks) { const bf16x8 af = frag_tr(Ki, S1, 16 * w, 32 * ks, lane);
#pragma unroll
              for (int pt = 0; pt < 4; ++pt) tmp[pt] = __builtin_amdgcn_mfma_f32_16x16x32_bf16(af, frag_tr(Xs, SX, 16 * pt, 32 * ks, lane), tmp[pt], 0, 0, 0); }
#pragma unroll
          for (int pt = 0; pt < 4; ++pt)
#pragma unroll
              for (int j = 0; j < 4; ++j) Hacc[pt][j] = eg[j] * Hacc[pt][j] + egr[j] * tmp[pt][j]; }
        __syncthreads();
        { const int tt = w >> 1; const size_t mrow = (size_t)batch * SEQ + ch * 64 + 16 * tt + r;
#pragma unroll
          for (int i = 0; i < 2; ++i) { const int pt = 2 * (w & 1) + i; f32x4 acc = (f32x4){0.f, 0.f, 0.f, 0.f};
#pragma unroll
              for (int ks = 0; ks < 2; ++ks) acc = __builtin_amdgcn_mfma_f32_16x16x32_bf16(frag_tr(Xs, SX, 16 * pt, 32 * ks, lane), frag_row(Mm, SM, 16 * tt, 32 * ks, lane), acc, 0, 0, 0);
#pragma unroll
              for (int k4 = 0; k4 < 4; ++k4) acc = __builtin_amdgcn_mfma_f32_16x16x32_bf16(frag_row(Hb, S1, 16 * pt, 32 * k4, lane), frag_row(Qi, S1, 16 * tt, 32 * k4, lane), acc, 0, 0, 0);
              *(f32x4*)(ORAW + mrow * 1024 + head * 128 + slice * 64 + 16 * pt + 4 * q) = acc; } }
        __syncthreads();
    }
#undef HG_LOAD
#undef HG_UNPK
}


constexpr int RST = 72;
__device__ __forceinline__ void tile_store(LAS bf16* img, int rt, int ct, const f32x4 a, int lane) { v2u p; p.x = cvt_pk_bf16(a[0], a[1]); p.y = cvt_pk_bf16(a[2], a[3]); *(LAS v2u*)(img + (16 * rt + (lane & 15)) * RST + 16 * ct + 4 * (lane >> 4)) = p; }
__device__ __forceinline__ f32x4 tile_load(const LAS bf16* img, int rt, int ct, int lane) { const v2u p = *(const LAS v2u*)(img + (16 * rt + (lane & 15)) * RST + 16 * ct + 4 * (lane >> 4));
    return (f32x4){__uint_as_float(p.x << 16), __uint_as_float(p.x & 0xffff0000u), __uint_as_float(p.y << 16), __uint_as_float(p.y & 0xffff0000u)}; }
__device__ __forceinline__ f32x4 mm_xy(const LAS bf16* X, const LAS bf16* Y, int rt, int ct, f32x4 acc, int lane) {
#pragma unroll
    for (int ks = 0; ks < 2; ++ks) acc = __builtin_amdgcn_mfma_f32_16x16x32_bf16(frag_tr(Y, RST, 16 * ct, 32 * ks, lane), frag_row(X, RST, 16 * rt, 32 * ks, lane), acc, 0, 0, 0);
    return acc; }
__device__ __forceinline__ f32x4 mm_xty(const LAS bf16* X, const LAS bf16* Y, int rt, int ct, f32x4 acc, int lane) {
#pragma unroll
    for (int ks = 0; ks < 2; ++ks) acc = __builtin_amdgcn_mfma_f32_16x16x32_bf16(frag_tr(Y, RST, 16 * ct, 32 * ks, lane), frag_tr(X, RST, 16 * rt, 32 * ks, lane), acc, 0, 0, 0);
    return acc; }
__device__ __forceinline__ f32x4 mm_xyt(const LAS bf16* X, const LAS bf16* Y, int rt, int ct, f32x4 acc, int lane) {
#pragma unroll
    for (int ks = 0; ks < 2; ++ks) acc = __builtin_amdgcn_mfma_f32_16x16x32_bf16(frag_row(Y, RST, 16 * ct, 32 * ks, lane), frag_row(X, RST, 16 * rt, 32 * ks, lane), acc, 0, 0, 0);
    return acc; }
__device__ __forceinline__ void gtile_store(bf16* g, int rt, int ct, const f32x4 a, int lane) { v2u p; p.x = cvt_pk_bf16(a[0], a[1]); p.y = cvt_pk_bf16(a[2], a[3]); *(v2u*)(g + (16 * rt + (lane & 15)) * 64 + 16 * ct + 4 * (lane >> 4)) = p; }
__device__ __forceinline__ f32x4 gtile_load(const bf16* g, int rt, int ct, int lane) { const v2u p = *(const v2u*)(g + (16 * rt + (lane & 15)) * 64 + 16 * ct + 4 * (lane >> 4));
    return (f32x4){__uint_as_float(p.x << 16), __uint_as_float(p.x & 0xffff0000u), __uint_as_float(p.y << 16), __uint_as_float(p.y & 0xffff0000u)}; }

__device__ __forceinline__ void rwkv_prep_unit(const Ctx& c, int unit, const bf16* U, const float* LW, const float* LA, const float* mu, const float* k_k, const float* k_a, bf16* PHI, bf16* RAP, bf16* PSI, bf16* YVB) {
    const int chunk = unit & 31, head = (unit >> 5) & 15, batch = unit >> 9;
    LAS unsigned char* base = launder_lds(c.lds);
#define RIMG(n) ((LAS bf16*)(base + (n) * 9216))
    LAS bf16* Ai = RIMG(0); LAS bf16* Ri = RIMG(1); LAS bf16* Bi = RIMG(2); LAS bf16* Ki = RIMG(3); LAS bf16* Vi = RIMG(4); LAS bf16* Aak = RIMG(5); LAS bf16* Arb = RIMG(6); LAS bf16* Ark = RIMG(7);
    LAS bf16* PA = RIMG(8); LAS bf16* PB = RIMG(9); LAS bf16* T0 = RIMG(10); LAS bf16* T1 = RIMG(11);
    LAS float* LF = (LAS float*)(base + 10 * 9216);
    LAS float* SEGT = (LAS float*)(base + 12 * 9216); LAS float* ER = SEGT + 512; LAS float* EG = ER + 64; LAS float* EGR = EG + 64;
    const int lane = c.lane, w = c.wave, r = lane & 15, q = lane >> 4, trow = c.tid >> 3, part = c.tid & 7;
    const int rt = w >> 1, ct0 = 2 * (w & 1);
    { const int j0 = 8 * part, col = head * 64 + j0, tl = chunk * 64 + trow; const size_t m = (size_t)batch * SEQ + tl; const bf16* ur = U + m * EVP;
      const v4u r8 = *(const v4u*)(ur + col), k8 = *(const v4u*)(ur + 1024 + col), v8 = *(const v4u*)(ur + 2048 + col);
      v4u rp = (v4u){0u, 0u, 0u, 0u}, kp = rp, vp = rp;
      if (tl > 0) { rp = *(const v4u*)(ur - EVP + col); kp = *(const v4u*)(ur - EVP + 1024 + col); vp = *(const v4u*)(ur - EVP + 2048 + col); }
      const f32x4 lw0 = *(const f32x4*)(LW + m * 1024 + col), lw1 = *(const f32x4*)(LW + m * 1024 + col + 4), al0 = *(const f32x4*)(LA + m * 1024 + col), al1 = *(const f32x4*)(LA + m * 1024 + col + 4);
      float rr[8], kk[8], vv[8], rq[8], kq[8], vq[8], lw[8], al[8];
#define RW_UNPK(dst, src) do { dst[0] = __uint_as_float((src).x << 16); dst[1] = __uint_as_float((src).x & 0xffff0000u); dst[2] = __uint_as_float((src).y << 16); dst[3] = __uint_as_float((src).y & 0xffff0000u); \
        dst[4] = __uint_as_float((src).z << 16); dst[5] = __uint_as_float((src).z & 0xffff0000u); dst[6] = __uint_as_float((src).w << 16); dst[7] = __uint_as_float((src).w & 0xffff0000u); } while (0)
      RW_UNPK(rr, r8); RW_UNPK(kk, k8); RW_UNPK(vv, v8); RW_UNPK(rq, rp); RW_UNPK(kq, kp); RW_UNPK(vq, vp);
#pragma unroll
      for (int e = 0; e < 4; ++e) { lw[e] = lw0[e]; lw[4 + e] = lw1[e]; al[e] = al0[e]; al[4 + e] = al1[e]; }
      float kn[8], ss = 0.f;
#pragma unroll
      for (int e = 0; e < 8; ++e) { rr[e] += (rq[e] - rr[e]) * mu[col + e]; kk[e] += (kq[e] - kk[e]) * mu[1024 + col + e]; vv[e] += (vq[e] - vv[e]) * mu[2048 + col + e]; kn[e] = kk[e] * k_k[col + e]; ss += kn[e] * kn[e]; }
      ss += __shfl_xor(ss, 1); ss += __shfl_xor(ss, 2); ss += __shfl_xor(ss, 4);
      const float rn = 1.0f / sqrtf(fmaxf(ss, 1e-12f));
      *(LAS f32x4*)(LF + trow * 68 + j0) = (f32x4){lw[0], lw[1], lw[2], lw[3]}; *(LAS f32x4*)(LF + trow * 68 + j0 + 4) = (f32x4){lw[4], lw[5], lw[6], lw[7]};
      __syncthreads();
      { const int j = c.tid & 63, seg = c.tid >> 6; float run = 0.f;
#pragma unroll
        for (int i = 0; i < 8; ++i) { run += LF[(8 * seg + i) * 68 + j]; LF[(8 * seg + i) * 68 + j] = run; }
        SEGT[seg * 64 + j] = run; }
      __syncthreads();
      const int segt = trow >> 3; float ai[8], ri[8], bi[8], ki[8];
#pragma unroll
      for (int h2 = 0; h2 < 2; ++h2) { f32x4 cum = *(const LAS f32x4*)(LF + trow * 68 + j0 + 4 * h2), ref = *(const LAS f32x4*)(LF + 31 * 68 + j0 + 4 * h2), g = *(const LAS f32x4*)(LF + 63 * 68 + j0 + 4 * h2);
#pragma unroll
          for (int sgi = 0; sgi < 7; ++sgi) { const f32x4 sv = *(const LAS f32x4*)(SEGT + sgi * 64 + j0 + 4 * h2); if (sgi < segt) cum = cum + sv; if (sgi < 3) ref = ref + sv; g = g + sv; }
#pragma unroll
          for (int e4 = 0; e4 < 4; ++e4) { const int e = 4 * h2 + e4; const float d = cum[e4] - ref[e4], ed = __expf(d), edi = __expf(-d); const float kkn = kn[e] * rn;
              ai[e] = -kkn * __expf(d - lw[e]); ri[e] = rr[e] * ed; bi[e] = kkn * al[e] * edi; ki[e] = kk[e] * (1.0f + (al[e] - 1.0f) * k_a[col + e]) * edi;
              if (trow == 0) { ER[j0 + e] = __expf(ref[e4]); EG[j0 + e] = __expf(g[e4]); EGR[j0 + e] = __expf(g[e4] - ref[e4]); } } }
      *(LAS v4u*)(Ai + trow * RST + j0) = pack8((f32x4){ai[0], ai[1], ai[2], ai[3]}, (f32x4){ai[4], ai[5], ai[6], ai[7]});
      *(LAS v4u*)(Ri + trow * RST + j0) = pack8((f32x4){ri[0], ri[1], ri[2], ri[3]}, (f32x4){ri[4], ri[5], ri[6], ri[7]});
      *(LAS v4u*)(Bi + trow * RST + j0) = pack8((f32x4){bi[0], bi[1], bi[2], bi[3]}, (f32x4){bi[4], bi[5], bi[6], bi[7]});
      *(LAS v4u*)(Ki + trow * RST + j0) = pack8((f32x4){ki[0], ki[1], ki[2], ki[3]}, (f32x4){ki[4], ki[5], ki[6], ki[7]});
      *(LAS v4u*)(Vi + trow * RST + j0) = pack8((f32x4){vv[0], vv[1], vv[2], vv[3]}, (f32x4){vv[4], vv[5], vv[6], vv[7]});
#undef RW_UNPK
    }
    __syncthreads();
    f32x4 Tacc[2];
#pragma unroll
    for (int i = 0; i < 2; ++i) { const int ct = ct0 + i; const f32x4 z = (f32x4){0.f, 0.f, 0.f, 0.f}; f32x4 ab = z, ak = z, rb = z, rk = z;
        if (ct <= rt) { ab = mm_xyt(Ai, Bi, rt, ct, z, lane); ak = mm_xyt(Ai, Ki, rt, ct, z, lane); rb = mm_xyt(Ri, Bi, rt, ct, z, lane); rk = mm_xyt(Ri, Ki, rt, ct, z, lane);
            const int t = 16 * rt + r;
#pragma unroll
            for (int j = 0; j < 4; ++j) { const int sj = 16 * ct + 4 * q + j; if (sj >= t) { ab[j] = 0.f; ak[j] = 0.f; } if (sj > t) { rb[j] = 0.f; rk[j] = 0.f; } } }
        tile_store(PA, rt, ct, ab, lane); tile_store(Aak, rt, ct, ak, lane); tile_store(Arb, rt, ct, rb, lane); tile_store(Ark, rt, ct, rk, lane);
        Tacc[i] = ab;
#pragma unroll
        for (int j = 0; j < 4; ++j) if (16 * ct + 4 * q + j == 16 * rt + r) Tacc[i][j] += 1.0f;
        tile_store(T0, rt, ct, Tacc[i], lane); }
    __syncthreads();
#pragma unroll
    for (int i = 0; i < 2; ++i) { const int ct = ct0 + i; f32x4 pz = (f32x4){0.f, 0.f, 0.f, 0.f}; if (ct <= rt) pz = mm_xy(PA, PA, rt, ct, pz, lane); tile_store(PB, rt, ct, pz, lane); }
    __syncthreads();
#pragma unroll
    for (int lv = 1; lv <= 5; ++lv) {
        LAS bf16* Pc = (lv & 1) ? PB : PA; LAS bf16* Pn = (lv & 1) ? PA : PB; LAS bf16* Tc = (lv & 1) ? T0 : T1; LAS bf16* Tn = (lv & 1) ? T1 : T0;
#pragma unroll
        for (int i = 0; i < 2; ++i) { const int ct = ct0 + i;
            if (ct <= rt) Tacc[i] = mm_xy(Pc, Tc, rt, ct, Tacc[i], lane);
            tile_store(Tn, rt, ct, Tacc[i], lane);
            if (lv < 5) { f32x4 pz = (f32x4){0.f, 0.f, 0.f, 0.f}; if (ct <= rt) pz = mm_xy(Pc, Pc, rt, ct, pz, lane); tile_store(Pn, rt, ct, pz, lane); } }
        __syncthreads();
    }
#pragma unroll
    for (int i = 0; i < 2; ++i) { const int ct = ct0 + i; const f32x4 z = (f32x4){0.f, 0.f, 0.f, 0.f};
        tile_store(PA, rt, ct, mm_xy(Aak, Vi, rt, ct, z, lane), lane); tile_store(PB, rt, ct, mm_xy(T1, Ai, rt, ct, z, lane), lane); }
    __syncthreads();
    const size_t ub = (size_t)unit * 4096;
#pragma unroll
    for (int i = 0; i < 2; ++i) { const int ct = ct0 + i; const f32x4 z = (f32x4){0.f, 0.f, 0.f, 0.f};
        tile_store(T0, rt, ct, mm_xy(T1, PA, rt, ct, z, lane), lane);
        f32x4 ra = mm_xy(Arb, PB, rt, ct, tile_load(Ri, rt, ct, lane), lane); const f32x4 er = *(const LAS f32x4*)(ER + 16 * ct + 4 * q);
        gtile_store(RAP + ub, rt, ct, ra * er, lane);
        f32x4 gph = mm_xty(Bi, PB, rt, ct, z, lane); const float egr = EGR[16 * rt + r], egj = EG[16 * rt + r];
#pragma unroll
        for (int j = 0; j < 4; ++j) { gph[j] = gph[j] * egr * er[j]; if (16 * ct + 4 * q + j == 16 * rt + r) gph[j] += egj; }
        gtile_store(PHI + ub, rt, ct, gph, lane); }
    __syncthreads();
#pragma unroll
    for (int i = 0; i < 2; ++i) { const int ct = ct0 + i; const f32x4 z = (f32x4){0.f, 0.f, 0.f, 0.f};
        gtile_store(YVB + ub, rt, ct, mm_xy(Ark, Vi, rt, ct, mm_xy(Arb, T0, rt, ct, z, lane), lane), lane);
        const f32x4 ps = mm_xty(Ki, Vi, rt, ct, mm_xty(Bi, T0, rt, ct, z, lane), lane);
        gtile_store(PSI + ub, rt, ct, ps * EGR[16 * rt + r], lane); }
    __syncthreads();
#undef RIMG
}

__device__ __forceinline__ void rwkv_chain(const Ctx& c, int task, const bf16* PHI, const bf16* RAP, const bf16* PSI, const bf16* YVB, float* YRAW) {
    const int head = task & 15, batch = task >> 4;
    const int lane = c.lane, w = c.wave, r = lane & 15, q = lane >> 4, trow = c.tid >> 3, part = c.tid & 7;
    const int it = w >> 1, x0 = 2 * (w & 1);
    { LAS bf16* H0 = (LAS bf16*)c.lds; for (int i = c.tid; i < 64 * RST / 2; i += 512) ((LAS unsigned*)H0)[i] = 0u; }
    const size_t u0 = (size_t)(batch * 16 + head) * 32;
    v4u pphi = *(const v4u*)(PHI + u0 * 4096 + trow * 64 + 8 * part), prap = *(const v4u*)(RAP + u0 * 4096 + trow * 64 + 8 * part);
    __syncthreads();
    for (int ch = 0; ch < 32; ++ch) {
        LAS unsigned char* base = launder_lds(c.lds);
        LAS bf16* Hc = (LAS bf16*)(base + (ch & 1) * 9216); LAS bf16* Hn = (LAS bf16*)(base + ((ch & 1) ^ 1) * 9216); LAS bf16* PHi = (LAS bf16*)(base + 2 * 9216); LAS bf16* RAi = (LAS bf16*)(base + 3 * 9216);
        const size_t ub = (u0 + ch) * 4096;
        *(LAS v4u*)(PHi + trow * RST + 8 * part) = pphi; *(LAS v4u*)(RAi + trow * RST + 8 * part) = prap;
        if (ch + 1 < 32) { pphi = *(const v4u*)(PHI + ub + 4096 + trow * 64 + 8 * part); prap = *(const v4u*)(RAP + ub + 4096 + trow * 64 + 8 * part); }
        f32x4 yv[2], ps[2];
#pragma unroll
        for (int i = 0; i < 2; ++i) { yv[i] = gtile_load(YVB + ub, x0 + i, it, lane); ps[i] = gtile_load(PSI + ub, x0 + i, it, lane); }
        __syncthreads();
#pragma unroll
        for (int i = 0; i < 2; ++i) { const int xt = x0 + i;
            const f32x4 y = mm_xy(RAi, Hc, xt, it, yv[i], lane);
            *(f32x4*)(YRAW + ((size_t)batch * SEQ + ch * 64 + 16 * xt + r) * 1024 + head * 64 + 16 * it + 4 * q) = y;
            const f32x4 hn = mm_xy(PHi, Hc, xt, it, ps[i], lane);
            tile_store(Hn, xt, it, hn, lane); }
        __syncthreads();
    }
}

#define UNPK8(dst, src) do { dst[0] = __uint_as_float((src).x << 16); dst[1] = __uint_as_float((src).x & 0xffff0000u); dst[2] = __uint_as_float((src).y << 16); dst[3] = __uint_as_float((src).y & 0xffff0000u); \
        dst[4] = __uint_as_float((src).z << 16); dst[5] = __uint_as_float((src).z & 0xffff0000u); dst[6] = __uint_as_float((src).w << 16); dst[7] = __uint_as_float((src).w & 0xffff0000u); } while (0)

__device__ __forceinline__ void mlstm_prep_unit(const Ctx& c, int unit, const bf16* U, const float* cw, const float* cbias, const float* i_b, const float* f_b,
                                                bf16* MLCB, bf16* MLCE, bf16* MLBB, float* MLCUM, float* MLW, float* MLWX, float* MLGT) {
    const int head = unit & 3, cb = unit >> 2, tl0 = (cb & 31) * 64, lane = c.lane; const size_t m0 = (size_t)cb * 64;
    LAS float* CUM = (LAS float*)launder_lds(c.lds);
    if (c.wave == 0) { const bf16* ug = U + (m0 + lane) * EVP; const float wgt = __expf(bf2f(ug[6592 + head]) + i_b[head]); float cum = -softplusf_(-(bf2f(ug[6596 + head]) + f_b[head]));
#pragma unroll
        for (int o = 1; o < 64; o <<= 1) { const float v_ = __shfl_up(cum, o); if (lane >= o) cum += v_; }
        const float gt = __shfl(cum, 63);
        CUM[lane] = cum; MLCUM[(m0 + lane) * 4 + head] = cum; MLW[(m0 + lane) * 4 + head] = wgt; MLWX[(m0 + lane) * 4 + head] = wgt * __expf(gt - cum);
        if (lane == 63) MLGT[cb * 4 + head] = cum; }
    __syncthreads();
    const int cg = c.tid & 31, tslot = c.tid >> 5;
    const int cch = cg < 16 ? head * 128 + 8 * cg : 512 + head * 128 + 8 * (cg - 16);
    float w[4][8], bb[8];
#pragma unroll
    for (int j = 0; j < 4; ++j) { const f32x4 a = *(const f32x4*)(cw + j * 1024 + cch), b = *(const f32x4*)(cw + j * 1024 + cch + 4);
#pragma unroll
        for (int e = 0; e < 4; ++e) { w[j][e] = a[e]; w[j][4 + e] = b[e]; } }
    { const f32x4 a = *(const f32x4*)(cbias + cch), b = *(const f32x4*)(cbias + cch + 4);
#pragma unroll
      for (int e = 0; e < 4; ++e) { bb[e] = a[e]; bb[4 + e] = b[e]; } }
#pragma unroll 2
    for (int i = 0; i < 4; ++i) { const int t = 4 * tslot + i, tl = tl0 + t; const size_t m = m0 + t; float acc[8];
#pragma unroll
        for (int e = 0; e < 8; ++e) acc[e] = bb[e];
#pragma unroll
        for (int j = 0; j < 4; ++j) if (tl - 3 + j >= 0) { const v4u raw = *(const v4u*)(U + (m - 3 + j) * EVP + 3520 + cch); float xv[8]; UNPK8(xv, raw);
#pragma unroll
            for (int e = 0; e < 8; ++e) acc[e] += w[j][e] * xv[e]; }
#pragma unroll
        for (int e = 0; e < 8; ++e) acc[e] = siluf_(acc[e]);
        const f32x4 x0 = (f32x4){acc[0], acc[1], acc[2], acc[3]}, x1 = (f32x4){acc[4], acc[5], acc[6], acc[7]};
        if (cg < 16) { const float sc = 0.08838834764831845f, se = sc * __expf(CUM[t]);
            *(v4u*)(MLCB + m * 512 + head * 128 + 8 * cg) = pack8(x0 * sc, x1 * sc); *(v4u*)(MLCE + m * 512 + head * 128 + 8 * cg) = pack8(x0 * se, x1 * se); }
        else *(v4u*)(MLBB + m * 512 + head * 128 + 8 * (cg - 16)) = pack8(x0, x1); }
    __syncthreads();
}
__device__ __forceinline__ void mlstm_chain(const Ctx& c, int task, const bf16* U, const bf16* MLCB, const bf16* MLCE, const bf16* MLBB, const float* MLCUM, const float* MLW, const float* MLWX, const float* MLGT, float* HRAW, float* DEN) {
    constexpr int NP = 5, SX = 88, S1 = 136, SM = 72;
    const int slice = task & 3, head = (task >> 2) & 3, batch = task >> 4;
    const int lane = c.lane, w = c.wave, r = lane & 15, q = lane >> 4, trow = c.tid >> 3, part = c.tid & 7;
    f32x4 Hacc[NP];
#pragma unroll
    for (int i = 0; i < NP; ++i) Hacc[i] = (f32x4){0.f, 0.f, 0.f, 0.f};
    v4u rc[2], rb[2], re[2], rv; float gcum, gw, gwx, gtot;
#define ML_LOAD(ch) do { const size_t m_ = (size_t)batch * SEQ + (ch) * 64 + trow; \
        rc[0] = *(const v4u*)(MLCB + m_ * 512 + head * 128 + 16 * part); rc[1] = *(const v4u*)(MLCB + m_ * 512 + head * 128 + 16 * part + 8); \
        rb[0] = *(const v4u*)(MLBB + m_ * 512 + head * 128 + 16 * part); rb[1] = *(const v4u*)(MLBB + m_ * 512 + head * 128 + 16 * part + 8); \
        re[0] = *(const v4u*)(MLCE + m_ * 512 + head * 128 + 16 * part); re[1] = *(const v4u*)(MLCE + m_ * 512 + head * 128 + 16 * part + 8); \
        rv = *(const v4u*)(U + m_ * EVP + 4544 + head * 256 + slice * 64 + 8 * part); gwx = MLWX[m_ * 4 + head]; \
        const size_t ml_ = (size_t)batch * SEQ + (ch) * 64 + lane; gcum = MLCUM[ml_ * 4 + head]; gw = MLW[ml_ * 4 + head]; gtot = MLGT[(batch * 32 + (ch)) * 4 + head]; } while (0)
    ML_LOAD(0);
    for (int ch = 0; ch < 32; ++ch) {
        LAS bf16* Cb = (LAS bf16*)launder_lds(c.lds); LAS bf16* Bb = Cb + 64 * S1; LAS bf16* Ce = Bb + 64 * S1; LAS bf16* Hb = Ce + 64 * S1; LAS bf16* Xs = Hb + 80 * S1; LAS bf16* Xw = Xs + 64 * SX; LAS bf16* Mm = Xw + 64 * SX;
        LAS float* cumL = (LAS float*)(Mm + 64 * SM); LAS float* wL = cumL + 64;
        *(LAS v4u*)(Cb + trow * S1 + 16 * part) = rc[0]; *(LAS v4u*)(Cb + trow * S1 + 16 * part + 8) = rc[1];
        *(LAS v4u*)(Bb + trow * S1 + 16 * part) = rb[0]; *(LAS v4u*)(Bb + trow * S1 + 16 * part + 8) = rb[1];
        *(LAS v4u*)(Ce + trow * S1 + 16 * part) = re[0]; *(LAS v4u*)(Ce + trow * S1 + 16 * part + 8) = re[1];
        { float xv[8]; UNPK8(xv, rv); const float wx = gwx;
          *(LAS v4u*)(Xs + trow * SX + 8 * part) = rv;
          *(LAS v4u*)(Xw + trow * SX + 8 * part) = pack8((f32x4){xv[0] * wx, xv[1] * wx, xv[2] * wx, xv[3] * wx}, (f32x4){xv[4] * wx, xv[5] * wx, xv[6] * wx, xv[7] * wx});
          if (part == 0) { const f32x4 z = (f32x4){0.f, 0.f, 0.f, 0.f};
              *(LAS v4u*)(Xs + trow * SX + 64) = pack8((f32x4){1.f, 0.f, 0.f, 0.f}, z); *(LAS v4u*)(Xs + trow * SX + 72) = pack8(z, z);
              *(LAS v4u*)(Xw + trow * SX + 64) = pack8((f32x4){wx, 0.f, 0.f, 0.f}, z); *(LAS v4u*)(Xw + trow * SX + 72) = pack8(z, z); } }
#pragma unroll
        for (int pt = 0; pt < NP; ++pt) { v2u hp; hp.x = cvt_pk_bf16(Hacc[pt][0], Hacc[pt][1]); hp.y = cvt_pk_bf16(Hacc[pt][2], Hacc[pt][3]); *(LAS v2u*)(Hb + (16 * pt + r) * S1 + 16 * w + 4 * q) = hp; }
        if (w == 0) { cumL[lane] = gcum; wL[lane] = gw; }
        const float eg = __expf(gtot);
        if (ch + 1 < 32) ML_LOAD(ch + 1);
        __syncthreads();
        { const int tt = w >> 1;
#pragma unroll
          for (int i = 0; i < 2; ++i) { const int ts = 2 * (w & 1) + i; f32x4 acc = (f32x4){0.f, 0.f, 0.f, 0.f};
              if (ts <= tt) {
#pragma unroll
                  for (int kk = 0; kk < 4; ++kk) acc = __builtin_amdgcn_mfma_f32_16x16x32_bf16(frag_row(Bb, S1, 16 * ts, 32 * kk, lane), frag_row(Cb, S1, 16 * tt, 32 * kk, lane), acc, 0, 0, 0);
                  const int t = 16 * tt + r; const float ct = cumL[t];
#pragma unroll
                  for (int j = 0; j < 4; ++j) { const int sj = 16 * ts + 4 * q + j; acc[j] = (sj <= t) ? acc[j] * __expf(ct - cumL[sj]) * wL[sj] : 0.f; } }
              v2u mp; mp.x = cvt_pk_bf16(acc[0], acc[1]); mp.y = cvt_pk_bf16(acc[2], acc[3]); *(LAS v2u*)(Mm + (16 * tt + r) * SM + 16 * ts + 4 * q) = mp; }
#pragma unroll
          for (int pt = 0; pt < NP; ++pt) Hacc[pt] = Hacc[pt] * eg;
#pragma unroll
          for (int ks = 0; ks < 2; ++ks) { const bf16x8 af = frag_tr(Bb, S1, 16 * w, 32 * ks, lane);
#pragma unroll
              for (int pt = 0; pt < NP; ++pt) Hacc[pt] = __builtin_amdgcn_mfma_f32_16x16x32_bf16(af, frag_tr(Xw, SX, 16 * pt, 32 * ks, lane), Hacc[pt], 0, 0, 0); } }
        __syncthreads();
        { const int tt = w >> 1, half = w & 1; const size_t mrow = (size_t)batch * SEQ + ch * 64 + 16 * tt + r;
#pragma unroll
          for (int i = 0; i < 3; ++i) { const int pt = half ? 2 + i : (i < 2 ? i : 4); if (half && i == 2) continue;
              f32x4 acc = (f32x4){0.f, 0.f, 0.f, 0.f};
#pragma unroll
              for (int ks = 0; ks < 2; ++ks) acc = __builtin_amdgcn_mfma_f32_16x16x32_bf16(frag_tr(Xs, SX, 16 * pt, 32 * ks, lane), frag_row(Mm, SM, 16 * tt, 32 * ks, lane), acc, 0, 0, 0);
#pragma unroll
              for (int kk = 0; kk < 4; ++kk) acc = __builtin_amdgcn_mfma_f32_16x16x32_bf16(frag_row(Hb, S1, 16 * pt, 32 * kk, lane), frag_row(Ce, S1, 16 * tt, 32 * kk, lane), acc, 0, 0, 0);
              if (pt < 4) *(f32x4*)(HRAW + mrow * 1024 + head * 256 + slice * 64 + 16 * pt + 4 * q) = acc; else if (q == 0 && slice == 0) DEN[mrow * 4 + head] = acc[0]; } }
        __syncthreads();
    }
#undef ML_LOAD
}

__device__ __forceinline__ void mamba_prep_unit(const Ctx& c, int unit, const bf16* U, const float* cw, const float* cbias, const float* dt_bias, const float* A_log,
                                                bf16* MXS, bf16* MXW, bf16* MB, bf16* MC, bf16* MCE, float* MCUM, float* MDT, float* MGT) {
    const int g = unit & 3, cb = unit >> 2, tl0 = (cb & 31) * 64, lane = c.lane; const size_t m0 = (size_t)cb * 64;
    LAS float* CUM = (LAS float*)launder_lds(c.lds); LAS float* DTL = CUM + 256; LAS float* GT = DTL + 256;
    if (c.wave < 4) { const int h = 4 * g + c.wave; const float dt = softplusf_(bf2f(U[(m0 + lane) * ODP + 7168 + h]) + dt_bias[h]); float cum = -__expf(A_log[h]) * dt;
#pragma unroll
        for (int o = 1; o < 64; o <<= 1) { const float v_ = __shfl_up(cum, o); if (lane >= o) cum += v_; }
        CUM[lane * 4 + c.wave] = cum; DTL[lane * 4 + c.wave] = dt; MCUM[(m0 + lane) * 16 + h] = cum; MDT[(m0 + lane) * 16 + h] = dt;
        if (lane == 63) { GT[c.wave] = cum; MGT[cb * 16 + h] = cum; } }
    __syncthreads();
    const int cg = c.tid & 63, tslot = c.tid >> 6;
    const int xch = cg < 32 ? g * 256 + 8 * cg : (cg < 48 ? 1024 + g * 128 + 8 * (cg - 32) : 1536 + g * 128 + 8 * (cg - 48));
    float w[4][8], bb[8];
#pragma unroll
    for (int j = 0; j < 4; ++j) { const f32x4 a = *(const f32x4*)(cw + j * 2048 + xch), b = *(const f32x4*)(cw + j * 2048 + xch + 4);
#pragma unroll
        for (int e = 0; e < 4; ++e) { w[j][e] = a[e]; w[j][4 + e] = b[e]; } }
    { const f32x4 a = *(const f32x4*)(cbias + xch), b = *(const f32x4*)(cbias + xch + 4);
#pragma unroll
      for (int e = 0; e < 4; ++e) { bb[e] = a[e]; bb[4 + e] = b[e]; } }
#pragma unroll 2
    for (int i = 0; i < 8; ++i) { const int t = 8 * tslot + i, tl = tl0 + t; const size_t m = m0 + t; float acc[8];
#pragma unroll
        for (int e = 0; e < 8; ++e) acc[e] = bb[e];
#pragma unroll
        for (int j = 0; j < 4; ++j) if (tl - 3 + j >= 0) { const v4u raw = *(const v4u*)(U + (m - 3 + j) * ODP + 5120 + xch); float xv[8]; UNPK8(xv, raw);
#pragma unroll
            for (int e = 0; e < 8; ++e) acc[e] += w[j][e] * xv[e]; }
#pragma unroll
        for (int e = 0; e < 8; ++e) acc[e] = siluf_(acc[e]);
        const f32x4 x0 = (f32x4){acc[0], acc[1], acc[2], acc[3]}, x1 = (f32x4){acc[4], acc[5], acc[6], acc[7]};
        if (cg < 32) { const int e = cg >> 3, h = 4 * g + e, p0 = (cg & 7) * 8; const float wx = DTL[t * 4 + e] * __expf(GT[e] - CUM[t * 4 + e]);
            *(v4u*)(MXS + m * 1024 + h * 64 + p0) = pack8(x0, x1); *(v4u*)(MXW + m * 1024 + h * 64 + p0) = pack8(x0 * wx, x1 * wx); }
        else if (cg < 48) { *(v4u*)(MB + m * 512 + g * 128 + 8 * (cg - 32)) = pack8(x0, x1); }
        else { const int n0 = 8 * (cg - 48); *(v4u*)(MC + m * 512 + g * 128 + n0) = pack8(x0, x1);
#pragma unroll
            for (int e = 0; e < 4; ++e) { const float ec = __expf(CUM[t * 4 + e]); *(v4u*)(MCE + m * 2048 + (4 * g + e) * 128 + n0) = pack8(x0 * ec, x1 * ec); } } }
    __syncthreads();
}
__device__ __forceinline__ void mamba_chain(const Ctx& c, int task, const bf16* MXS, const bf16* MXW, const bf16* MB, const bf16* MC, const bf16* MCE, const float* MCUM, const float* MDT, const float* MGT, const float* Dsk, float* YRAW) {
    constexpr int SX = 72, S1 = 136, SM = 72;
    const int head = task & 15, batch = task >> 4, g = head >> 2;
    const int lane = c.lane, w = c.wave, r = lane & 15, q = lane >> 4, trow = c.tid >> 3, part = c.tid & 7;
    const float Dh = Dsk[head];
    f32x4 Hacc[4];
#pragma unroll
    for (int i = 0; i < 4; ++i) Hacc[i] = (f32x4){0.f, 0.f, 0.f, 0.f};
    v4u rc[2], rb[2], re[2], rx, rw; float gcum, gdt, gtot;
#define MC_LOAD(ch) do { const size_t m_ = (size_t)batch * SEQ + (ch) * 64 + trow; \
        rc[0] = *(const v4u*)(MC + m_ * 512 + g * 128 + 16 * part); rc[1] = *(const v4u*)(MC + m_ * 512 + g * 128 + 16 * part + 8); \
        rb[0] = *(const v4u*)(MB + m_ * 512 + g * 128 + 16 * part); rb[1] = *(const v4u*)(MB + m_ * 512 + g * 128 + 16 * part + 8); \
        re[0] = *(const v4u*)(MCE + m_ * 2048 + head * 128 + 16 * part); re[1] = *(const v4u*)(MCE + m_ * 2048 + head * 128 + 16 * part + 8); \
        rx = *(const v4u*)(MXS + m_ * 1024 + head * 64 + 8 * part); rw = *(const v4u*)(MXW + m_ * 1024 + head * 64 + 8 * part); \
        const size_t ml_ = (size_t)batch * SEQ + (ch) * 64 + lane; gcum = MCUM[ml_ * 16 + head]; gdt = MDT[ml_ * 16 + head]; gtot = MGT[(batch * 32 + (ch)) * 16 + head]; } while (0)
    MC_LOAD(0);
    for (int ch = 0; ch < 32; ++ch) {
        LAS bf16* Cb = (LAS bf16*)launder_lds(c.lds); LAS bf16* Bb = Cb + 64 * S1; LAS bf16* Ce = Bb + 64 * S1; LAS bf16* Hb = Ce + 64 * S1; LAS bf16* Xs = Hb + 64 * S1; LAS bf16* Xw = Xs + 64 * SX; LAS bf16* Mm = Xw + 64 * SX;
        LAS float* cumL = (LAS float*)(Mm + 64 * SM); LAS float* wL = cumL + 64;
        *(LAS v4u*)(Cb + trow * S1 + 16 * part) = rc[0]; *(LAS v4u*)(Cb + trow * S1 + 16 * part + 8) = rc[1];
        *(LAS v4u*)(Bb + trow * S1 + 16 * part) = rb[0]; *(LAS v4u*)(Bb + trow * S1 + 16 * part + 8) = rb[1];
        *(LAS v4u*)(Ce + trow * S1 + 16 * part) = re[0]; *(LAS v4u*)(Ce + trow * S1 + 16 * part + 8) = re[1];
        *(LAS v4u*)(Xs + trow * SX + 8 * part) = rx; *(LAS v4u*)(Xw + trow * SX + 8 * part) = rw;
#pragma unroll
        for (int pt = 0; pt < 4; ++pt) { v2u hp; hp.x = cvt_pk_bf16(Hacc[pt][0], Hacc[pt][1]); hp.y = cvt_pk_bf16(Hacc[pt][2], Hacc[pt][3]); *(LAS v2u*)(Hb + (16 * pt + r) * S1 + 16 * w + 4 * q) = hp; }
        if (w == 0) { cumL[lane] = gcum; wL[lane] = gdt; }
        const float eg = __expf(gtot);
        if (ch + 1 < 32) MC_LOAD(ch + 1);
        __syncthreads();
        { const int tt = w >> 1;
#pragma unroll
          for (int i = 0; i < 2; ++i) { const int ts = 2 * (w & 1) + i; f32x4 acc = (f32x4){0.f, 0.f, 0.f, 0.f};
              if (ts <= tt) {
#pragma unroll
                  for (int kk = 0; kk < 4; ++kk) acc = __builtin_amdgcn_mfma_f32_16x16x32_bf16(frag_row(Bb, S1, 16 * ts, 32 * kk, lane), frag_row(Cb, S1, 16 * tt, 32 * kk, lane), acc, 0, 0, 0);
                  const int t = 16 * tt + r; const float ct = cumL[t];
#pragma unroll
                  for (int j = 0; j < 4; ++j) { const int sj = 16 * ts + 4 * q + j; acc[j] = (sj <= t) ? acc[j] * __expf(ct - cumL[sj]) * wL[sj] : 0.f; } }
              v2u mp; mp.x = cvt_pk_bf16(acc[0], acc[1]); mp.y = cvt_pk_bf16(acc[2], acc[3]); *(LAS v2u*)(Mm + (16 * tt + r) * SM + 16 * ts + 4 * q) = mp; }
#pragma unroll
          for (int pt = 0; pt < 4; ++pt) Hacc[pt] = Hacc[pt] * eg;
#pragma unroll
          for (int ks = 0; ks < 2; ++ks) { const bf16x8 af = frag_tr(Bb, S1, 16 * w, 32 * ks, lane);
#pragma unroll
              for (int pt = 0; pt < 4; ++pt) Hacc[pt] = __builtin_amdgcn_mfma_f32_16x16x32_bf16(af, frag_tr(Xw, SX, 16 * pt, 32 * ks, lane), Hacc[pt], 0, 0, 0); } }
        __syncthreads();
        { const int tt = w >> 1; const size_t mrow = (size_t)batch * SEQ + ch * 64 + 16 * tt + r;
#pragma unroll
          for (int i = 0; i < 2; ++i) { const int pt = 2 * (w & 1) + i; f32x4 acc = (f32x4){0.f, 0.f, 0.f, 0.f};
#pragma unroll
              for (int ks = 0; ks < 2; ++ks) acc = __builtin_amdgcn_mfma_f32_16x16x32_bf16(frag_tr(Xs, SX, 16 * pt, 32 * ks, lane), frag_row(Mm, SM, 16 * tt, 32 * ks, lane), acc, 0, 0, 0);
#pragma unroll
              for (int kk = 0; kk < 4; ++kk) acc = __builtin_amdgcn_mfma_f32_16x16x32_bf16(frag_row(Hb, S1, 16 * pt, 32 * kk, lane), frag_row(Ce, S1, 16 * tt, 32 * kk, lane), acc, 0, 0, 0);
              const v2u xv = *(const LAS v2u*)(Xs + (16 * tt + r) * SX + 16 * pt + 4 * q);
              acc[0] += Dh * __uint_as_float(xv.x << 16); acc[1] += Dh * __uint_as_float(xv.x & 0xffff0000u); acc[2] += Dh * __uint_as_float(xv.y << 16); acc[3] += Dh * __uint_as_float(xv.y & 0xffff0000u);
              *(f32x4*)(YRAW + mrow * 1024 + head * 64 + 16 * pt + 4 * q) = acc; } }
        __syncthreads();
    }
#undef MC_LOAD
}

__device__ __forceinline__ void hgrn_prep_unit(const Ctx& c, int unit, const bf16* U, const float* lbl, bf16* HQ, bf16* HK, float* HVEC) {
    constexpr int LFS = 132;
    const int head = unit & 7, cb = unit >> 3, trow = c.tid >> 3, part = c.tid & 7;
    LAS float* LF = (LAS float*)launder_lds(c.lds); LAS float* SEGT = LF + 64 * LFS; LAS float* LBL = SEGT + 512;
    const size_t m = (size_t)cb * 64 + trow; const bf16* ur = U + m * ODP;
    if (c.tid < 128) { const int a = head * 128 + c.tid; LBL[c.tid] = 1.0f / (1.0f + __expf(lbl[a] - lbl[1024 + a])); }
    v4u rq[2], rf[2];
    rq[0] = *(const v4u*)(ur + head * 128 + 16 * part); rq[1] = *(const v4u*)(ur + head * 128 + 16 * part + 8);
    rf[0] = *(const v4u*)(ur + 1024 + head * 128 + 16 * part); rf[1] = *(const v4u*)(ur + 1024 + head * 128 + 16 * part + 8);
    __syncthreads();
    float sg[16];
#pragma unroll
    for (int h2 = 0; h2 < 2; ++h2) { float fp[8]; UNPK8(fp, rf[h2]);
        const f32x4 b0 = *(const LAS f32x4*)(LBL + 16 * part + 8 * h2), b1 = *(const LAS f32x4*)(LBL + 16 * part + 8 * h2 + 4); float lf[8];
#pragma unroll
        for (int j = 0; j < 8; ++j) { const float lbv = j < 4 ? b0[j & 3] : b1[j & 3]; sg[8 * h2 + j] = sigmoidf_(fp[j]); lf[j] = __logf(lbv + (1.0f - lbv) * sg[8 * h2 + j]); }
        *(LAS f32x4*)(LF + trow * LFS + 16 * part + 8 * h2) = (f32x4){lf[0], lf[1], lf[2], lf[3]}; *(LAS f32x4*)(LF + trow * LFS + 16 * part + 8 * h2 + 4) = (f32x4){lf[4], lf[5], lf[6], lf[7]}; }
    __syncthreads();
    { const int k = c.tid & 127, seg = c.tid >> 7; float run = 0.f;
#pragma unroll
      for (int i = 0; i < 16; ++i) { run += LF[(16 * seg + i) * LFS + k]; LF[(16 * seg + i) * LFS + k] = run; }
      SEGT[seg * 128 + k] = run; }
    __syncthreads();
    { const int seg = trow >> 4;
#pragma unroll
      for (int h2 = 0; h2 < 2; ++h2) { float qr[8], qt[8], kt[8]; UNPK8(qr, rq[h2]);
#pragma unroll
          for (int j4 = 0; j4 < 2; ++j4) { const int kb = 16 * part + 8 * h2 + 4 * j4;
              const f32x4 l = *(const LAS f32x4*)(LF + trow * LFS + kb), l31 = *(const LAS f32x4*)(LF + 31 * LFS + kb), l63 = *(const LAS f32x4*)(LF + 63 * LFS + kb), bb = *(const LAS f32x4*)(LBL + kb);
              const f32x4 s0 = *(const LAS f32x4*)(SEGT + kb), s1 = *(const LAS f32x4*)(SEGT + 128 + kb), s2 = *(const LAS f32x4*)(SEGT + 256 + kb);
#pragma unroll
              for (int e = 0; e < 4; ++e) { float off = 0.f; if (seg > 0) off += s0[e]; if (seg > 1) off += s1[e]; if (seg > 2) off += s2[e];
                  const float rf_ = l31[e] + s0[e], d = (l[e] + off) - rf_; const int j = 4 * j4 + e;
                  qt[j] = siluf_(qr[j]) * __expf(d); kt[j] = (1.0f - bb[e]) * (1.0f - sg[8 * h2 + j]) * __expf(-d);
                  if (trow == 0) { const float g_ = l63[e] + s0[e] + s1[e] + s2[e]; float* hv = HVEC + (size_t)unit * 384 + kb + e; hv[0] = __expf(rf_); hv[128] = __expf(g_); hv[256] = __expf(g_ - rf_); } } }
          *(v4u*)(HQ + m * 1024 + head * 128 + 16 * part + 8 * h2) = pack8((f32x4){qt[0], qt[1], qt[2], qt[3]}, (f32x4){qt[4], qt[5], qt[6], qt[7]});
          *(v4u*)(HK + m * 1024 + head * 128 + 16 * part + 8 * h2) = pack8((f32x4){kt[0], kt[1], kt[2], kt[3]}, (f32x4){kt[4], kt[5], kt[6], kt[7]}); } }
    __syncthreads();
}
__device__ __forceinline__ void hgrn_chain(const Ctx& c, int task, const bf16* U, const bf16* HQ, const bf16* HK, const float* HVEC, float* ORAW) {
    constexpr int S1 = 136, SX = 72, SM = 72;
    const int slice = task & 1, head = (task >> 1) & 7, batch = task >> 4;
    const int lane = c.lane, w = c.wave, r = lane & 15, q = lane >> 4, trow = c.tid >> 3, part = c.tid & 7;
    f32x4 Hacc[4];
#pragma unroll
    for (int i = 0; i < 4; ++i) Hacc[i] = (f32x4){0.f, 0.f, 0.f, 0.f};
    v4u rq[2], rk[2], ri; f32x4 ver, veg, vegr;
#define HC_LOAD(ch) do { const size_t m_ = (size_t)batch * SEQ + (ch) * 64 + trow; \
        rq[0] = *(const v4u*)(HQ + m_ * 1024 + head * 128 + 16 * part); rq[1] = *(const v4u*)(HQ + m_ * 1024 + head * 128 + 16 * part + 8); \
        rk[0] = *(const v4u*)(HK + m_ * 1024 + head * 128 + 16 * part); rk[1] = *(const v4u*)(HK + m_ * 1024 + head * 128 + 16 * part + 8); \
        ri = *(const v4u*)(U + m_ * ODP + 2048 + head * 128 + slice * 64 + 8 * part); \
        const float* hv_ = HVEC + (size_t)((batch * 32 + (ch)) * 8 + head) * 384 + 16 * w + 4 * q; ver = *(const f32x4*)hv_; veg = *(const f32x4*)(hv_ + 128); vegr = *(const f32x4*)(hv_ + 256); } while (0)
    HC_LOAD(0);
    for (int ch = 0; ch < 32; ++ch) {
        LAS bf16* Qi = (LAS bf16*)launder_lds(c.lds); LAS bf16* Ki = Qi + 64 * S1; LAS bf16* Hb = Ki + 64 * S1; LAS bf16* Xs = Hb + 64 * S1; LAS bf16* Mm = Xs + 64 * SX;
        *(LAS v4u*)(Qi + trow * S1 + 16 * part) = rq[0]; *(LAS v4u*)(Qi + trow * S1 + 16 * part + 8) = rq[1];
        *(LAS v4u*)(Ki + trow * S1 + 16 * part) = rk[0]; *(LAS v4u*)(Ki + trow * S1 + 16 * part + 8) = rk[1];
        *(LAS v4u*)(Xs + trow * SX + 8 * part) = ri;
        const f32x4 eg = veg, egr = vegr;
#pragma unroll
        for (int pt = 0; pt < 4; ++pt) { v2u hp; hp.x = cvt_pk_bf16(Hacc[pt][0] * ver[0], Hacc[pt][1] * ver[1]); hp.y = cvt_pk_bf16(Hacc[pt][2] * ver[2], Hacc[pt][3] * ver[3]); *(LAS v2u*)(Hb + (16 * pt + r) * S1 + 16 * w + 4 * q) = hp; }
        if (ch + 1 < 32) HC_LOAD(ch + 1);
        __syncthreads();
        { const int tt = w >> 1;
#pragma unroll
          for (int i = 0; i < 2; ++i) { const int ts = 2 * (w & 1) + i; f32x4 acc = (f32x4){0.f, 0.f, 0.f, 0.f};
              if (ts <= tt) {
#pragma unroll
                  for (int k4 = 0; k4 < 4; ++k4) acc = __builtin_amdgcn_mfma_f32_16x16x32_bf16(frag_row(Ki, S1, 16 * ts, 32 * k4, lane), frag_row(Qi, S1, 16 * tt, 32 * k4, lane), acc, 0, 0, 0);
                  const int t = 16 * tt + r;
#pragma unroll
                  for (int j = 0; j < 4; ++j) { const int sj = 16 * ts + 4 * q + j; acc[j] = (sj <= t) ? acc[j] : 0.f; } }
              v2u mp; mp.x = cvt_pk_bf16(acc[0], acc[1]); mp.y = cvt_pk_bf16(acc[2], acc[3]); *(LAS v2u*)(Mm + (16 * tt + r) * SM + 16 * ts + 4 * q) = mp; }
          f32x4 tmp[4];
#pragma unroll
          for (int pt = 0; pt < 4; ++pt) tmp[pt] = (f32x4){0.f, 0.f, 0.f, 0.f};
#pragma unroll
          for (int ks = 0; ks < 2; ++ks) { const bf16x8 af = frag_tr(Ki, S1, 16 * w, 32 * ks, lane);
#pragma unroll
              for (int pt = 0; pt < 4; ++pt) tmp[pt] = __builtin_amdgcn_mfma_f32_16x16x32_bf16(af, frag_tr(Xs, SX, 16 * pt, 32 * ks, lane), tmp[pt], 0, 0, 0); }
#pragma unroll
          for (int pt = 0; pt < 4; ++pt)
#pragma unroll
              for (int j = 0; j < 4; ++j) Hacc[pt][j] = eg[j] * Hacc[pt][j] + egr[j] * tmp[pt][j]; }
        __syncthreads();
        { const int tt = w >> 1; const size_t mrow = (size_t)batch * SEQ + ch * 64 + 16 * tt + r;
#pragma unroll
          for (int i = 0; i < 2; ++i) { const int pt = 2 * (w & 1) + i; f32x4 acc = (f32x4){0.f, 0.f, 0.f, 0.f};
#pragma unroll
              for (int ks = 0; ks < 2; ++ks) acc = __builtin_amdgcn_mfma_f32_16x16x32_bf16(frag_tr(Xs, SX, 16 * pt, 32 * ks, lane), frag_row(Mm, SM, 16 * tt, 32 * ks, lane), acc, 0, 0, 0);
#pragma unroll
              for (int k4 = 0; k4 < 4; ++k4) acc = __builtin_amdgcn_mfma_f32_16x16x32_bf16(frag_row(Hb, S1, 16 * pt, 32 * k4, lane), frag_row(Qi, S1, 16 * tt, 32 * k4, lane), acc, 0, 0, 0);
              *(f32x4*)(ORAW + mrow * 1024 + head * 128 + slice * 64 + 16 * pt + 4 * q) = acc; } }
        __syncthreads();
    }
#undef HC_LOAD
}
struct Args { const float* in[41]; float* out; unsigned char* ws; int lo, hi; };

__global__ void __launch_bounds__(512, 2) fwd(Args args) {
    extern __shared__ __attribute__((aligned(16))) unsigned char lds_raw[];
    Ctx c; c.lds = (LAS unsigned char*)lds_raw; c.tid = threadIdx.x; c.lane = c.tid & 63; c.wave = __builtin_amdgcn_readfirstlane(c.tid >> 6); c.bid = blockIdx.x; c.G = gridDim.x;
    volatile LAS unsigned* MISC = (volatile LAS unsigned*)(c.lds + MISC_OFF);
    unsigned char* ws = args.ws;
    for (int u = c.tid; u < (LDS_BYTES - RING_BYTES) / 4; u += 512) ((LAS unsigned*)(c.lds + RING_BYTES))[u] = 0u;
    __syncthreads();
    const int lo = args.lo, hi = args.hi;
    XcdBarrier bar; bar.bar = (unsigned*)(ws + WS_CTL) + CW_BAR; bar.x = 0; bar.st = nullptr;
    if (hi - lo > 1) bar = xcd_barrier_post((unsigned*)(ws + WS_CTL) + CW_BAR, MISC + 8);
#define IN(k) (lo <= (k) && (k) < hi)
#define SEAM(k) do { if (IN(k) && IN((k) + 1)) xcd_barrier(bar); } while (0)

    const float* x = args.in[0]; const float* final_norm_w = args.in[1]; const float* hg_lb = args.in[2];
    const float* ev_norm1_w = args.in[3]; const float* ev_w_in = args.in[4]; const float* ev_w_out = args.in[5];
    const float* rw_mu = args.in[6]; const float* rw_w0 = args.in[7]; const float* rw_w2 = args.in[8]; const float* rw_a0 = args.in[9]; const float* rw_a2 = args.in[10]; const float* rw_g2 = args.in[11];
    const float* rw_k_k = args.in[12]; const float* rw_k_a = args.in[13]; const float* rw_r_k = args.in[14]; const float* rw_ln_w = args.in[15]; const float* rw_ln_b = args.in[16];
    const float* ml_conv_w = args.in[17]; const float* ml_conv_b = args.in[18]; const float* ml_i_b = args.in[19]; const float* ml_f_b = args.in[20]; const float* ml_norm_w = args.in[21];
    const float* ev_norm2_w = args.in[22]; const float* ffn_w_gate = args.in[23]; const float* ffn_w_up = args.in[24]; const float* ffn_w_down = args.in[25];
    const float* od_norm1_w = args.in[26]; const float* od_w_in = args.in[27]; const float* od_w_out = args.in[28]; const float* hg_norm_w = args.in[29];
    const float* mb_conv_w = args.in[30]; const float* mb_conv_b = args.in[31]; const float* mb_dt_bias = args.in[32]; const float* mb_A_log = args.in[33]; const float* mb_D = args.in[34]; const float* mb_norm_w = args.in[35];
    const float* od_norm2_w = args.in[36]; const float* moe_router = args.in[37]; const float* moe_w_gate = args.in[38]; const float* moe_w_up = args.in[39]; const float* moe_w_down = args.in[40];
    float* OUT = args.out;
    bf16* W_LORA = (bf16*)(ws + WS_WLORA); bf16* W_EVIN = (bf16*)(ws + WS_WEVIN); bf16* W_EVOUT = (bf16*)(ws + WS_WEVOUT); bf16* W_FGU = (bf16*)(ws + WS_WFGU); bf16* W_FD = (bf16*)(ws + WS_WFD);
    bf16* W_ODIN = (bf16*)(ws + WS_WODIN); bf16* W_ODOUT = (bf16*)(ws + WS_WODOUT); bf16* W_MGU = (bf16*)(ws + WS_WMGU); bf16* W_MD = (bf16*)(ws + WS_WMD);
    bf16* XN = (bf16*)(ws + WS_XN); bf16* Y = (bf16*)(ws + WS_Y); float* X1 = (float*)(ws + WS_X1);
    bf16* U = (bf16*)(ws + SC_U); float* LW = (float*)(ws + SC_LW); float* LA = (float*)(ws + SC_LA); float* LG = (float*)(ws + SC_LG); bf16* ALORA = (bf16*)(ws + SC_ALORA);
    bf16* RW_PHI = (bf16*)(ws + WS_X1); bf16* RW_RAP = RW_PHI + (size_t)2048 * 4096; bf16* RW_PSI = RW_RAP + (size_t)2048 * 4096; bf16* RW_YV = RW_PSI + (size_t)2048 * 4096;
    bf16* ML_CB = (bf16*)(ws + SC_MLQK); bf16* ML_CE = ML_CB + (size_t)8192 * 512; bf16* ML_BB = ML_CE + (size_t)8192 * 512; float* ML_CUM = (float*)(ML_BB + (size_t)8192 * 512); float* ML_W = ML_CUM + 8192 * 4; float* ML_WX = ML_W + 8192 * 4; float* ML_GT = ML_WX + 8192 * 4;
    float* YRAW_E = (float*)(ws + SC_YRAW_E); float* MLQK = (float*)(ws + SC_MLQK); float* HRAW = (float*)(ws + SC_HRAW); float* DEN = (float*)(ws + SC_DEN);
    bf16* ACT = (bf16*)(ws + SC_ACT);
    bf16* HG_Q = (bf16*)(ws + WS_SCR + 244 * MiB); bf16* HG_K = (bf16*)(ws + WS_SCR + 260 * MiB); float* HG_VEC = (float*)(ws + WS_SCR + 276 * MiB);
    bf16* MB_XS = (bf16*)(ws + WS_SCR + 116 * MiB); bf16* MB_XW = (bf16*)(ws + WS_SCR + 132 * MiB); bf16* MB_B = (bf16*)(ws + WS_SCR + 148 * MiB); bf16* MB_C = (bf16*)(ws + WS_SCR + 156 * MiB); bf16* MB_CE = (bf16*)(ws + WS_SCR + 278 * MiB);
    float* MB_CUM = (float*)(ws + WS_SCR + 164 * MiB); float* MB_DT = MB_CUM + 8192 * 16; float* MB_GT = MB_DT + 8192 * 16;
    float* XBC = (float*)(ws + SC_XBC); float* ORAW = (float*)(ws + SC_ORAW); float* YRAW_O = (float*)(ws + SC_YRAW_O);
    bf16* HS = (bf16*)(ws + SC_HS); bf16* ACTS = (bf16*)(ws + SC_ACTS); float* OUTS = (float*)(ws + SC_OUTS);
    int* TOPK = (int*)(ws + SC_TOPK); int* POS = (int*)(ws + SC_POS); int* CNT = (int*)(ws + SC_CNT); int* TILES = (int*)(ws + SC_TILES);
    float* X2 = OUT;

    const ConvKind kinds[10] = {
        ConvKind{ev_w_in, W_EVIN, DM, 6600, EVP, 0, 1, 0, 0}, ConvKind{ev_w_out, W_EVOUT, DM, DM, DM, 0, 1, 0, 0},
        ConvKind{ffn_w_gate, W_FGU, DM, FF, FF, 1, 1, 0, 0}, ConvKind{ffn_w_up, W_FGU, DM, FF, FF, 2, 1, 0, 0}, ConvKind{ffn_w_down, W_FD, FF, DM, DM, 0, 1, 0, 0},
        ConvKind{od_w_in, W_ODIN, DM, 7184, ODP, 0, 1, 0, 0}, ConvKind{od_w_out, W_ODOUT, DM, DM, DM, 0, 1, 0, 0},
        ConvKind{moe_w_gate, W_MGU, DM, FE, FE, 1, NEXP, (size_t)DM * FE, (size_t)2 * FE * DM}, ConvKind{moe_w_up, W_MGU, DM, FE, FE, 2, NEXP, (size_t)DM * FE, (size_t)2 * FE * DM},
        ConvKind{moe_w_down, W_MD, FE, DM, DM, 0, NEXP, (size_t)FE * DM, (size_t)DM * FE} };
    if (IN(0)) {
        conv_run(kinds, 0, c.G == 256 ? CV_P0 : CV_ALL, c.bid, c.G, (LAS float*)c.lds, c.tid);
        for (int idx = c.bid * 512 + c.tid; idx < 3072 * 512; idx += c.G * 512) {
            const int k = idx / 3072, n = idx % 3072; float v = 0.f;
            if (n < 1024) { if (k < 96) v = rw_w2[k * 1024 + n]; }
            else if (n < 2048) { if (k >= 96 && k < 192) v = rw_a2[(k - 96) * 1024 + (n - 1024)]; }
            else { if (k >= 192 && k < 448) v = rw_g2[(k - 192) * 1024 + (n - 2048)]; }
            W_LORA[(size_t)n * 512 + k] = (bf16)f2bf(v);
        }
        rmsnorm_phase(c, x, ev_norm1_w, XN);
    }
    SEAM(0);
    if (IN(1)) {
        pg8::Gemm g{XN, W_EVIN, M_TOK, EVP, DM}; pg8::StaticOrder S; S.init(M_TOK, EVP, c.G, c.bid);
        pg8::EpiBf16 E{U, EVP};
        pg8::gemm_phase<pg8::EpiBf16, pg8::StaticOrder, true, true>(c.lds, g, S, E);
        if (c.G == 256 && c.bid >= 64) conv_run(kinds, CV_P0, CV_P1, c.bid - 64, 192, (LAS float*)c.lds, c.tid);
    }
    SEAM(1);
    if (IN(2)) {
        for (int blk = c.bid; blk < 256; blk += c.G) {
            const int m0 = blk * 32;
            {
              const int idx0 = 8 * (c.tid & 63), col0 = 3072 + idx0; float mu8[8];
#pragma unroll
              for (int e = 0; e < 8; ++e) mu8[e] = idx0 < 448 ? rw_mu[col0 + e] : 0.f;
#pragma unroll 2
              for (int i = 0; i < 4; ++i) { const int m = m0 + (c.tid >> 6) + 8 * i, tl = m & (SEQ - 1); v4u o = (v4u){0u, 0u, 0u, 0u};
                  if (idx0 < 448) { const v4u cr = *(const v4u*)(U + (size_t)m * EVP + col0); v4u pr = (v4u){0u, 0u, 0u, 0u}; if (tl) pr = *(const v4u*)(U + (size_t)(m - 1) * EVP + col0);
                      float cv[8], pv[8], xv[8]; UNPK8(cv, cr); UNPK8(pv, pr);
#pragma unroll
                      for (int e = 0; e < 8; ++e) { const float x = cv[e] + (pv[e] - cv[e]) * mu8[e]; xv[e] = idx0 < 96 ? tanhf(x) : (idx0 < 192 ? x : sigmoidf_(x)); }
                      o = pack8((f32x4){xv[0], xv[1], xv[2], xv[3]}, (f32x4){xv[4], xv[5], xv[6], xv[7]}); }
                  *(v4u*)(ALORA + (size_t)m * 512 + idx0) = o; } }
        }
    }
    SEAM(2);
    if (IN(3)) {
        pg8::Gemm g{ALORA, W_LORA, M_TOK, 3072, 512}; pg8::StaticOrder S; S.init(M_TOK, 3072, c.G, c.bid);
        pg8::EpiLora E{LW, rw_w0, rw_a0};
        pg8::gemm_phase<pg8::EpiLora, pg8::StaticOrder, true, true>(c.lds, g, S, E);
    }
    SEAM(3);
    if (IN(4)) {
        for (int unit = c.bid; unit < 2560; unit += c.G) {
            if (unit < 2048) rwkv_prep_unit(c, unit, U, LW, LA, rw_mu, rw_k_k, rw_k_a, RW_PHI, RW_RAP, RW_PSI, RW_YV);
            else mlstm_prep_unit(c, unit - 2048, U, ml_conv_w, ml_conv_b, ml_i_b, ml_f_b, ML_CB, ML_CE, ML_BB, ML_CUM, ML_W, ML_WX, ML_GT);
        }
    }
    SEAM(4);
    if (IN(5)) {
        for (int task = c.bid; task < 128; task += c.G) {
            if (task < 64) rwkv_chain(c, task, RW_PHI, RW_RAP, RW_PSI, RW_YV, YRAW_E);
            else mlstm_chain(c, task - 64, U, ML_CB, ML_CE, ML_BB, ML_CUM, ML_W, ML_WX, ML_GT, HRAW, DEN);
        }
        if (c.G == 256 && c.bid >= 128) conv_run(kinds, CV_P1, CV_P5, c.bid - 128, 128, (LAS float*)c.lds, c.tid);
    }
    SEAM(5);
    if (IN(6)) {
        for (int blk = c.bid; blk < 256; blk += c.G) {
            const int m0 = blk * 32;
            for (int hh = 0; hh < 2; ++hh) { const int col = (2 * c.wave + hh) * 64 + 8 * (c.lane & 7);
                float mur[8], muk[8], muv[8], kac[8], rkc[8], lnw[8], lnb[8];
#pragma unroll
                for (int e = 0; e < 8; ++e) { mur[e] = rw_mu[col + e]; muk[e] = rw_mu[1024 + col + e]; muv[e] = rw_mu[2048 + col + e]; kac[e] = rw_k_a[col + e]; rkc[e] = rw_r_k[col + e]; lnw[e] = rw_ln_w[col + e]; lnb[e] = rw_ln_b[col + e]; }
#pragma unroll 2
                for (int i = 0; i < 4; ++i) { const int m = m0 + 8 * i + (c.lane >> 3), tl = m & (SEQ - 1); const bf16* ur = U + (size_t)m * EVP;
                    const v4u r8 = *(const v4u*)(ur + col), k8 = *(const v4u*)(ur + 1024 + col), v8 = *(const v4u*)(ur + 2048 + col);
                    v4u rp8 = (v4u){0u, 0u, 0u, 0u}, kp8 = rp8, vp8 = rp8;
                    if (tl) { rp8 = *(const v4u*)(ur - EVP + col); kp8 = *(const v4u*)(ur - EVP + 1024 + col); vp8 = *(const v4u*)(ur - EVP + 2048 + col); }
                    const f32x4 y0 = *(const f32x4*)(YRAW_E + (size_t)m * 1024 + col), y1 = *(const f32x4*)(YRAW_E + (size_t)m * 1024 + col + 4);
                    const f32x4 a0 = *(const f32x4*)(LA + (size_t)m * 1024 + col), a1 = *(const f32x4*)(LA + (size_t)m * 1024 + col + 4);
                    const f32x4 g0 = *(const f32x4*)(LG + (size_t)m * 1024 + col), g1 = *(const f32x4*)(LG + (size_t)m * 1024 + col + 4);
                    float rr[8], kk[8], vv[8], rq[8], kq[8], vq[8]; UNPK8(rr, r8); UNPK8(kk, k8); UNPK8(vv, v8); UNPK8(rq, rp8); UNPK8(kq, kp8); UNPK8(vq, vp8);
                    float yv[8], av[8], gv[8];
#pragma unroll
                    for (int e = 0; e < 4; ++e) { yv[e] = y0[e]; yv[4 + e] = y1[e]; av[e] = a0[e]; av[4 + e] = a1[e]; gv[e] = g0[e]; gv[4 + e] = g1[e]; }
                    float sy = 0.f, sb = 0.f;
#pragma unroll
                    for (int e = 0; e < 8; ++e) { rr[e] += (rq[e] - rr[e]) * mur[e]; kk[e] += (kq[e] - kk[e]) * muk[e]; vv[e] += (vq[e] - vv[e]) * muv[e];
                        sy += yv[e]; sb += rr[e] * kk[e] * (1.0f + (av[e] - 1.0f) * kac[e]) * rkc[e]; }
                    sy += __shfl_xor(sy, 1); sy += __shfl_xor(sy, 2); sy += __shfl_xor(sy, 4); sb += __shfl_xor(sb, 1); sb += __shfl_xor(sb, 2); sb += __shfl_xor(sb, 4);
                    const float mean = sy * (1.0f / 64.0f); float sq = 0.f;
#pragma unroll
                    for (int e = 0; e < 8; ++e) { yv[e] -= mean; sq += yv[e] * yv[e]; }
                    sq += __shfl_xor(sq, 1); sq += __shfl_xor(sq, 2); sq += __shfl_xor(sq, 4);
                    const float rstd = 1.0f / sqrtf(sq * (1.0f / 64.0f) + 64e-5f); float o[8];
#pragma unroll
                    for (int e = 0; e < 8; ++e) o[e] = (yv[e] * rstd * lnw[e] + lnb[e] + sb * vv[e]) * gv[e];
                    *(v4u*)(Y + (size_t)m * DM + col) = pack8((f32x4){o[0], o[1], o[2], o[3]}, (f32x4){o[4], o[5], o[6], o[7]}); } }
            { const int head = c.wave & 3, col = head * 256 + 4 * c.lane; const f32x4 nw = *(const f32x4*)(ml_norm_w + col);
#pragma unroll 4
              for (int i = 0; i < 16; ++i) { const int m = m0 + (c.wave >> 2) + 2 * i;
                  f32x4 hv = *(const f32x4*)(HRAW + (size_t)m * 1024 + col); hv = hv * (1.0f / fmaxf(fabsf(DEN[(size_t)m * 4 + head]), 1.0f));
                  const v2u ov = *(const v2u*)(U + (size_t)m * EVP + 5568 + col);
                  const float ss = wave_sum((hv.x * hv.x + hv.y * hv.y) + (hv.z * hv.z + hv.w * hv.w));
                  const float rs = 1.0f / sqrtf(ss * (1.0f / 256.0f) + 1e-6f);
                  const float o0 = hv.x * rs * nw.x * sigmoidf_(__uint_as_float(ov.x << 16)), o1 = hv.y * rs * nw.y * sigmoidf_(__uint_as_float(ov.x & 0xffff0000u));
                  const float o2 = hv.z * rs * nw.z * sigmoidf_(__uint_as_float(ov.y << 16)), o3 = hv.w * rs * nw.w * sigmoidf_(__uint_as_float(ov.y & 0xffff0000u));
                  v2u pk; pk.x = cvt_pk_bf16(o0, o1); pk.y = cvt_pk_bf16(o2, o3); *(v2u*)(Y + (size_t)m * DM + 1024 + col) = pk; } }
        }
    }
    SEAM(6);
    if (IN(7)) {
        pg8::Gemm g{Y, W_EVOUT, M_TOK, DM, DM}; pg8::StaticOrder S; S.init(M_TOK, DM, c.G, c.bid);
        pg8::EpiResF32 E{x, X1, DM};
        pg8::gemm_phase<pg8::EpiResF32, pg8::StaticOrder, false, true>(c.lds, g, S, E);
    }
    SEAM(7);
    if (IN(8)) rmsnorm_phase(c, X1, ev_norm2_w, XN);
    SEAM(8);
    if (IN(9)) {
        pg8::Gemm g{XN, W_FGU, M_TOK, 2 * FF, DM}; pg8::StaticOrder S; S.init(M_TOK, 2 * FF, c.G, c.bid);
        pg8::EpiSwiGLU E{ACT, FF};
        pg8::gemm_phase<pg8::EpiSwiGLU, pg8::StaticOrder, true, true>(c.lds, g, S, E);
        if (c.G == 256 && c.bid >= 128) conv_run(kinds, CV_P5, CV_P9, c.bid - 128, 128, (LAS float*)c.lds, c.tid);
    }
    SEAM(9);
    if (IN(10)) {
        pg8::Gemm g{ACT, W_FD, M_TOK, DM, FF}; pg8::StaticOrder S; S.init(M_TOK, DM, c.G, c.bid);
        pg8::EpiResF32 E{X1, X2, DM};
        pg8::gemm_phase<pg8::EpiResF32, pg8::StaticOrder, false, true>(c.lds, g, S, E);
    }
    SEAM(10);
    if (IN(11)) rmsnorm_phase(c, X2, od_norm1_w, XN);
    SEAM(11);
    if (IN(12)) {
        pg8::Gemm g{XN, W_ODIN, M_TOK, ODP, DM}; pg8::StaticOrder S; S.init(M_TOK, ODP, c.G, c.bid);
        pg8::EpiBf16 E{U, ODP};
        pg8::gemm_phase<pg8::EpiBf16, pg8::StaticOrder, true, true>(c.lds, g, S, E);
        if (c.G == 256 && c.bid >= 160) conv_run(kinds, CV_P9, CV_P12, c.bid - 160, 96, (LAS float*)c.lds, c.tid);
    }
    SEAM(12);
    if (IN(13)) {
        for (int unit = c.bid; unit < 1024; unit += c.G) hgrn_prep_unit(c, unit, U, hg_lb, HG_Q, HG_K, HG_VEC);
        for (int unit = c.bid; unit < 512; unit += c.G) mamba_prep_unit(c, unit, U, mb_conv_w, mb_conv_b, mb_dt_bias, mb_A_log, MB_XS, MB_XW, MB_B, MB_C, MB_CE, MB_CUM, MB_DT, MB_GT);
    }
    SEAM(13);
    if (IN(14)) {
        for (int task = c.bid; task < 256; task += c.G) {
            if (task < 64) hgrn_chain(c, task, U, HG_Q, HG_K, HG_VEC, ORAW);
            else if (task < 128) mamba_chain(c, task - 64, MB_XS, MB_XW, MB_B, MB_C, MB_CE, MB_CUM, MB_DT, MB_GT, mb_D, YRAW_O);
        }
        if (c.G == 256 && c.bid >= 128) conv_run(kinds, CV_P12, CV_ALL, c.bid - 128, 128, (LAS float*)c.lds, c.tid);
    }
    SEAM(14);
    if (IN(15)) {
        for (int blk = c.bid; blk < 256; blk += c.G) {
            const int m0 = blk * 32;
            {
              const int col = c.wave * 128 + 2 * c.lane; const float nw0 = hg_norm_w[col], nw1 = hg_norm_w[col + 1];
#pragma unroll 4
              for (int i = 0; i < 32; ++i) { const int m = m0 + i; const f32x2 ov = *(const f32x2*)(ORAW + (size_t)m * 1024 + col); const unsigned gz = *(const unsigned*)(U + (size_t)m * ODP + 3072 + col);
                  const float rs = 1.0f / sqrtf(wave_sum(ov.x * ov.x + ov.y * ov.y) * (1.0f / 128.0f) + 1e-6f);
                  *(unsigned*)(Y + (size_t)m * DM + col) = cvt_pk_bf16(ov.x * rs * nw0 * siluf_(__uint_as_float(gz << 16)), ov.y * rs * nw1 * siluf_(__uint_as_float(gz & 0xffff0000u))); } }
            {
              const int grp = c.wave & 3, col = grp * 256 + 4 * c.lane; const f32x4 nw = *(const f32x4*)(mb_norm_w + col);
#pragma unroll 4
              for (int i = 0; i < 16; ++i) { const int m = m0 + (c.wave >> 2) + 2 * i;
                  const f32x4 yv = *(const f32x4*)(YRAW_O + (size_t)m * 1024 + col); const v2u zv = *(const v2u*)(U + (size_t)m * ODP + 4096 + col);
                  const float t0 = yv.x * siluf_(__uint_as_float(zv.x << 16)), t1 = yv.y * siluf_(__uint_as_float(zv.x & 0xffff0000u)), t2 = yv.z * siluf_(__uint_as_float(zv.y << 16)), t3 = yv.w * siluf_(__uint_as_float(zv.y & 0xffff0000u));
                  const float rs = 1.0f / sqrtf(wave_sum((t0 * t0 + t1 * t1) + (t2 * t2 + t3 * t3)) * (1.0f / 256.0f) + 1e-6f);
                  v2u pk; pk.x = cvt_pk_bf16(t0 * rs * nw.x, t1 * rs * nw.y); pk.y = cvt_pk_bf16(t2 * rs * nw.z, t3 * rs * nw.w); *(v2u*)(Y + (size_t)m * DM + 1024 + col) = pk; } }
        }
    }
    SEAM(15);
    if (IN(16)) {
        pg8::Gemm g{Y, W_ODOUT, M_TOK, DM, DM}; pg8::StaticOrder S; S.init(M_TOK, DM, c.G, c.bid);
        pg8::EpiResF32 E{X2, X1, DM};
        pg8::gemm_phase<pg8::EpiResF32, pg8::StaticOrder, false, true>(c.lds, g, S, E);
    }
    SEAM(16);
    if (IN(17)) {
        LAS float* RT = (LAS float*)c.lds;
        LAS int* lcnt = (LAS int*)(c.lds + 65536);
        for (int i = c.tid; i < 2048 * 8 / 4; i += 512) *(LAS f32x4*)(RT + 4 * i) = *(const f32x4*)(moe_router + 4 * i);
        __syncthreads();
        for (int blk = c.bid; blk < 256; blk += c.G) {
            if (c.tid < 8) lcnt[c.tid] = 0;
            __syncthreads();
            for (int q = 0; q < 4; ++q) {
                const int m = blk * 32 + c.wave * 4 + q;
                const float* xr = X1 + (size_t)m * DM;
                f32x4 v[8]; float ss = 0.f;
#pragma unroll
                for (int j = 0; j < 8; ++j) { v[j] = *(const f32x4*)(xr + 4 * c.lane + 256 * j); ss += (v[j].x * v[j].x + v[j].y * v[j].y) + (v[j].z * v[j].z + v[j].w * v[j].w); }
                const float rs = 1.0f / sqrtf(wave_sum(ss) * (1.0f / 2048.0f) + 1e-6f);
                float lg[8];
#pragma unroll
                for (int e = 0; e < 8; ++e) lg[e] = 0.f;
#pragma unroll
                for (int j = 0; j < 8; ++j) { const f32x4 wv = *(const f32x4*)(od_norm2_w + 4 * c.lane + 256 * j); const f32x4 hn = v[j] * rs * wv;
                    v2u p; p.x = cvt_pk_bf16(hn.x, hn.y); p.y = cvt_pk_bf16(hn.z, hn.w); *(v2u*)(XN + (size_t)m * DM + 4 * c.lane + 256 * j) = p;
#pragma unroll
                    for (int i = 0; i < 4; ++i) { const int ch = 4 * c.lane + 256 * j + i; const f32x4 r0 = *(const LAS f32x4*)(RT + ch * 8), r1 = *(const LAS f32x4*)(RT + ch * 8 + 4);
                        lg[0] += hn[i] * r0[0]; lg[1] += hn[i] * r0[1]; lg[2] += hn[i] * r0[2]; lg[3] += hn[i] * r0[3]; lg[4] += hn[i] * r1[0]; lg[5] += hn[i] * r1[1]; lg[6] += hn[i] * r1[2]; lg[7] += hn[i] * r1[3]; } }
#pragma unroll
                for (int e = 0; e < 8; ++e) lg[e] = wave_sum(lg[e]);
                int e0 = 0; float v0 = lg[0];
#pragma unroll
                for (int e = 1; e < 8; ++e) if (lg[e] > v0) { v0 = lg[e]; e0 = e; }
                int e1 = -1; float v1 = -3.0e38f;
#pragma unroll
                for (int e = 0; e < 8; ++e) if (e != e0 && lg[e] > v1) { v1 = lg[e]; e1 = e; }
                const float p0 = 1.0f / (1.0f + __expf(v1 - v0)), p1 = 1.0f - p0;
                if (c.lane == 0) { TOPK[m * 4] = e0; TOPK[m * 4 + 1] = e1; TOPK[m * 4 + 2] = __float_as_int(p0); TOPK[m * 4 + 3] = __float_as_int(p1); atomicAdd((int*)&lcnt[e0], 1); atomicAdd((int*)&lcnt[e1], 1); }
            }
            __syncthreads();
            if (c.tid < 8) CNT[blk * 8 + c.tid] = lcnt[c.tid];
            __syncthreads();
        }
    }
    SEAM(17);
    if (IN(18)) {
        LAS int* C8 = (LAS int*)c.lds;
        LAS int* tot = C8 + 2048; LAS int* pre = tot + 8; LAS int* segst = pre + 8; LAS int* ntl = segst + 8; LAS int* basee = ntl + 8; LAS int* lpos = basee + 8;
        LAS int* ltop = lpos + 64; LAS int* part = ltop + 64;
        for (int blk = c.bid; blk < 256; blk += c.G) {
            for (int i = c.tid; i < 2048; i += 512) C8[i] = CNT[i];
            if (c.tid < 64) ltop[c.tid] = TOPK[(blk * 32 + (c.tid >> 1)) * 4 + (c.tid & 1)];
            __syncthreads();
            { const int e = c.tid & 7, bq = c.tid >> 3; int t = 0, pp = 0;
#pragma unroll
              for (int j = 0; j < 4; ++j) { const int b = 4 * bq + j, v = C8[b * 8 + e]; t += v; if (b < blk) pp += v; }
              part[bq * 8 + e] = t; part[512 + bq * 8 + e] = pp; }
            __syncthreads();
            if (c.tid < 8) { int t = 0, pp = 0; for (int b = 0; b < 64; ++b) { t += part[b * 8 + c.tid]; pp += part[512 + b * 8 + c.tid]; } tot[c.tid] = t; pre[c.tid] = pp; }
            __syncthreads();
            if (c.tid == 0) {
                int seg = 0;
                for (int e = 0; e < 8; ++e) { segst[e] = seg; ntl[e] = (tot[e] + 255) >> 8; seg += ntl[e] * 256; basee[e] = seg - ntl[e] * 256 + pre[e]; }
                for (int i = 0; i < 32; ++i) { const int e0 = ltop[2 * i], e1 = ltop[2 * i + 1];
                    const int p0 = basee[e0]; basee[e0] = p0 + 1; const int p1 = basee[e1]; basee[e1] = p1 + 1; lpos[2 * i] = p0; lpos[2 * i + 1] = p1; }
                if (blk == 0) { int t = 0; for (int e = 0; e < 8; ++e) for (int k = 0; k < ntl[e]; ++k) TILES[1 + t++] = e; TILES[0] = t; }
            }
            __syncthreads();
            if (c.tid < 64) POS[blk * 64 + c.tid] = lpos[c.tid];
            for (int pr = c.wave; pr < 64; pr += 8) {
                const int m = blk * 32 + (pr >> 1); const int pos = lpos[pr];
                const v4u* src = (const v4u*)(XN + (size_t)m * DM); v4u* dst = (v4u*)(HS + (size_t)pos * DM);
#pragma unroll
                for (int j = 0; j < 4; ++j) dst[c.lane + 64 * j] = src[c.lane + 64 * j];
            }
            for (int e = 0; e < 8; ++e) {
                const int npad = ntl[e] * 256 - tot[e], r0 = segst[e] + tot[e];
                for (int pq = blk; pq < npad; pq += 256) { v2u* dst = (v2u*)(HS + (size_t)(r0 + pq) * DM); dst[c.tid] = (v2u){0u, 0u}; }
            }
            __syncthreads();
        }
    }
    SEAM(18);
    if (IN(19)) {
        const int NT = __builtin_amdgcn_readfirstlane(TILES[0]);
        pg8::Gemm g{HS, W_MGU, 0, 0, DM}; pg8::GroupedOrder S{TILES + 1, NT, 22, c.G, c.bid};
        pg8::EpiSwiGLU E{ACTS, FE};
        pg8::gemm_phase<pg8::EpiSwiGLU, pg8::GroupedOrder, true, true>(c.lds, g, S, E);
    }
    SEAM(19);
    if (IN(20)) {
        const int NT = __builtin_amdgcn_readfirstlane(TILES[0]);
        pg8::Gemm g{ACTS, W_MD, 0, 0, FE}; pg8::GroupedOrder S{TILES + 1, NT, 8, c.G, c.bid};
        pg8::EpiResF32 E{nullptr, OUTS, DM};
        pg8::gemm_phase<pg8::EpiResF32, pg8::GroupedOrder, true, true>(c.lds, g, S, E);
    }
    SEAM(20);
    if (IN(21)) {
        const int gw = c.bid * 8 + c.wave, NGW = c.G * 8;
        for (int m = gw; m < M_TOK; m += NGW) {
            const float p0 = __int_as_float(TOPK[m * 4 + 2]), p1 = __int_as_float(TOPK[m * 4 + 3]); const int q0 = POS[m * 2], q1 = POS[m * 2 + 1];
            const float* xr = X1 + (size_t)m * DM; const float* o0 = OUTS + (size_t)q0 * DM; const float* o1 = OUTS + (size_t)q1 * DM;
            f32x4 v[8]; float ss = 0.f;
#pragma unroll
            for (int j = 0; j < 8; ++j) { const int o = 4 * c.lane + 256 * j; v[j] = *(const f32x4*)(xr + o) + p0 * *(const f32x4*)(o0 + o) + p1 * *(const f32x4*)(o1 + o);
                ss += (v[j].x * v[j].x + v[j].y * v[j].y) + (v[j].z * v[j].z + v[j].w * v[j].w); }
            const float rs = 1.0f / sqrtf(wave_sum(ss) * (1.0f / 2048.0f) + 1e-6f);
#pragma unroll
            for (int j = 0; j < 8; ++j) { const int o = 4 * c.lane + 256 * j; *(f32x4*)(OUT + (size_t)m * DM + o) = v[j] * rs * *(const f32x4*)(final_norm_w + o); }
        }
    }
#undef IN
#undef SEAM
}

extern "C" void kernel_launch(void* const* d_in, const int* in_sizes, int n_in, void* d_out, int out_size, void* d_ws, size_t ws_size, hipStream_t stream) {
    static int grid = 0;
    if (grid == 0) {
        if (n_in != 41 || out_size != M_TOK * DM || ws_size < WS_END) { fprintf(stderr, "kernel_launch: unexpected problem (n_in %d, out %d, ws %zu < %zu)\n", n_in, out_size, ws_size, (size_t)WS_END); grid = -1; return; }
        int dev = 0, cus = 0, per_cu = 0;
        if (hipGetDevice(&dev) != hipSuccess || hipDeviceGetAttribute(&cus, hipDeviceAttributeMultiprocessorCount, dev) != hipSuccess) { grid = -1; return; }
        if (hipFuncSetAttribute((const void*)fwd, hipFuncAttributeMaxDynamicSharedMemorySize, LDS_BYTES) != hipSuccess) { fprintf(stderr, "kernel_launch: hipFuncSetAttribute failed\n"); grid = -1; return; }
        if (hipOccupancyMaxActiveBlocksPerMultiprocessor(&per_cu, (const void*)fwd, 512, LDS_BYTES) != hipSuccess || per_cu < 1) fprintf(stderr, "kernel_launch: occupancy query says %d\n", per_cu);
        (void)hipGetLastError();
        grid = cus;
    }
    if (grid < 0) return;
    (void)hipMemsetAsync((char*)d_ws + WS_CTL, 0, CTL_ZERO_BYTES, stream);
    Args a{};
    for (int i = 0; i < 41; ++i) a.in[i] = (const float*)d_in[i];
    a.out = (float*)d_out; a.ws = (unsigned char*)d_ws;
    if (MK_N_LAUNCHES == 1) { a.lo = 0; a.hi = NPHASE; hipLaunchKernelGGL(fwd, dim3(grid), dim3(512), LDS_BYTES, stream, a); }
    else { for (int p = 0; p < NPHASE; ++p) { a.lo = p; a.hi = p + 1; const int n = ((PROBE_DUP >> p) & 1u) ? 1 + PROBE_EXTRA : 1;
            for (int r = 0; r < n; ++r) hipLaunchKernelGGL(fwd, dim3(grid), dim3(512), LDS_BYTES, stream, a); } }
}
```

```cpp
#include <hip/hip_runtime.h>
#include <cstdio>
#include <cstdint>

#ifndef MK_N_LAUNCHES
#define MK_N_LAUNCHES 1
#endif

#ifndef PROBE_DUP
#define PROBE_DUP 0u
#endif
#ifndef PROBE_EXTRA
#define PROBE_EXTRA 1
#endif
#define GAS __attribute__((address_space(1)))
#define LAS __attribute__((address_space(3)))
typedef unsigned short bf16;
typedef unsigned v4u __attribute__((ext_vector_type(4)));
typedef unsigned v2u __attribute__((ext_vector_type(2)));
typedef float f32x4 __attribute__((ext_vector_type(4)));
typedef float f32x2 __attribute__((ext_vector_type(2)));
typedef short bf16x8 __attribute__((ext_vector_type(8)));

constexpr int M_TOK = 8192, SEQ = 2048, DM = 2048;
constexpr int EVP = 6656, ODP = 7424;
constexpr int FF = 5632, FE = 2816, NEXP = 8;
constexpr int NPHASE = 22;

constexpr size_t MiB = 1u << 20;
constexpr size_t WS_CTL = 0, CTL_ZERO_BYTES = 1 * MiB;
constexpr size_t WS_WLORA = 1 * MiB, WS_WEVIN = 4 * MiB, WS_WEVOUT = 30 * MiB, WS_WFGU = 38 * MiB, WS_WFD = 82 * MiB;
constexpr size_t WS_WODIN = 104 * MiB, WS_WODOUT = 133 * MiB, WS_WMGU = 141 * MiB, WS_WMD = 317 * MiB;
constexpr size_t WS_XN = 405 * MiB, WS_Y = 437 * MiB, WS_X1 = 469 * MiB, WS_SCR = 533 * MiB;
constexpr size_t SC_U = WS_SCR, SC_LW = WS_SCR + 104 * MiB, SC_LA = WS_SCR + 136 * MiB, SC_LG = WS_SCR + 168 * MiB, SC_ALORA = WS_SCR + 200 * MiB;
constexpr size_t SC_YRAW_E = WS_SCR + 208 * MiB, SC_MLQK = WS_SCR + 240 * MiB, SC_HRAW = WS_SCR + 272 * MiB;
constexpr size_t SC_DEN = WS_SCR + 304 * MiB;
constexpr size_t SC_ACT = WS_SCR;
constexpr size_t SC_XBC = WS_SCR + 116 * MiB, SC_ORAW = WS_SCR + 180 * MiB, SC_YRAW_O = WS_SCR + 212 * MiB;
constexpr int MOE_MAXROWS = 18432;
constexpr size_t SC_HS = WS_SCR, SC_ACTS = WS_SCR + 72 * MiB, SC_OUTS = WS_SCR + 171 * MiB;
constexpr size_t SC_TOPK = WS_SCR + 316 * MiB, SC_POS = SC_TOPK + 131072, SC_CNT = SC_POS + 65536, SC_TILES = SC_CNT + 8192;
constexpr size_t WS_END = WS_SCR + 317 * MiB;
static_assert(SC_OUTS + (size_t)MOE_MAXROWS * DM * 4 <= SC_TOPK, "moe map");
static_assert(WS_END <= 907708384ull, "d_ws map exceeds the guaranteed workspace");
constexpr int CW_BAR = 4096;

constexpr int RING_BYTES = 131072, MISC_OFF = RING_BYTES + 320, LDS_BYTES = 147456;

__device__ __forceinline__ float bf2f(bf16 b) { return __uint_as_float(((unsigned)b) << 16); }
__device__ __forceinline__ unsigned f2bf(float f) { unsigned u = __float_as_uint(f); return (u + 0x7fffu + ((u >> 16) & 1u)) >> 16; }
typedef __bf16 bf16v2 __attribute__((ext_vector_type(2)));
__device__ __forceinline__ unsigned cvt_pk_bf16(float lo, float hi) { const bf16v2 v = {(__bf16)lo, (__bf16)hi}; return __builtin_bit_cast(unsigned, v); }
__device__ __forceinline__ float sigmoidf_(float x) { return 1.0f / (1.0f + __expf(-x)); }
__device__ __forceinline__ float siluf_(float x) { return x / (1.0f + __expf(-x)); }
__device__ __forceinline__ float wave_sum(float v) {
#pragma unroll
    for (int o = 1; o < 64; o <<= 1) v += __shfl_xor(v, o);
    return v;
}
template <int CTRL> __device__ __forceinline__ float dppf(float v) { return __builtin_bit_cast(float, __builtin_amdgcn_mov_dpp(__builtin_bit_cast(int, v), CTRL, 0xf, 0xf, false)); }
__device__ __forceinline__ float allred16(float v) { v += dppf<0x128>(v); v += dppf<0x124>(v); v += dppf<0x122>(v); v += dppf<0x121>(v); return v; }

namespace pg8 {
#define PG8_LAS __attribute__((address_space(3)))
typedef unsigned short bf16_t;
typedef unsigned u32x4 __attribute__((ext_vector_type(4)));
constexpr int BM = 256, BK = 64, HALF = 128, HTB = HALF * BK * 2, STAGE_BYTES = 8 * HTB, NXCD = 8, WGM = 8;
__host__ __device__ __forceinline__ int lds_byte(int r, int c) { const int st = (r >> 4) * 2 + (c >> 5), rr = r & 15, cc = c & 31, ob = rr * 64 + cc * 2; return st * 1024 + (ob ^ (((ob >> 9) & 1) << 5)); }
__host__ __device__ __forceinline__ void stage_rc(int b, int& R, int& C) { const int st = b / 1024, sb = b % 1024, swz = sb ^ (((sb >> 9) & 1) << 5); R = (st >> 1) * 16 + swz / 64; C = (st & 1) * 32 + (swz % 64) / 2; }
__host__ __device__ __forceinline__ int perm32(int rho) { const int n = rho >> 4, i = rho & 15; return 8 * (i >> 2) + 4 * n + (i & 3); }

struct Unit { int pm, pn, pc; };
struct Gemm { const bf16_t* A; const bf16_t* Bt; int M, N, K; };

struct StaticOrder {
    int nM, nN, nwg, G, c;
    __device__ void init(int M, int N, int G_, int c_) { nM = M / BM; nN = N / BM; nwg = nM * nN; G = G_; c = c_; }
    __device__ bool next(int i, Unit& u) const {
        const long L = (long)i * G + c; if (L >= nwg) return false;
        int wgid = (int)L; { const int q = nwg / NXCD, r = nwg % NXCD, xcd = wgid % NXCD, off = wgid / NXCD; wgid = (xcd < r ? xcd * (q + 1) : r * (q + 1) + (xcd - r) * q) + off; }
        const int nig = WGM * nN, gid = wgid / nig, fm = gid * WGM, gsz = (nM - fm) < WGM ? (nM - fm) : WGM;
        u.pm = fm + ((wgid % nig) % gsz); u.pn = (wgid % nig) / gsz; u.pc = u.pn; return true;
    }
    __device__ __forceinline__ void a_ready(const Unit&) const {}
    __device__ __forceinline__ void done(const Unit&) const {}
};
struct GroupedOrder {
    const int* tile_e; int NT, npn, G, c;
    __device__ bool next(int i, Unit& u) const {
        const long L = (long)i * G + c; if (L >= (long)NT * npn) return false;
        const int t = (int)(L % NT), pnl = (int)(L / NT);
        const int e = __builtin_amdgcn_readfirstlane(tile_e[t]);
        u.pm = t; u.pn = e * npn + pnl; u.pc = pnl; return true;
    }
    __device__ __forceinline__ void a_ready(const Unit&) const {}
    __device__ __forceinline__ void done(const Unit&) const {}
};

struct EpiBf16 {
    static constexpr bool PERM = true;
    bf16_t* O; int ldc;
    __device__ __forceinline__ void operator()(const f32x4 (&acc)[2][2][4][2], const Unit& u, int wr, int wc, int fr, int fq) const {
        const int row0 = u.pm * BM + wr * 64 + fr, col0 = u.pc * BM + wc * 32 + 8 * fq;
#pragma unroll
        for (int ai = 0; ai < 2; ++ai)
#pragma unroll
            for (int m = 0; m < 4; ++m) { bf16_t* rowp = O + (size_t)(row0 + ai * HALF + m * 16) * ldc + col0;
#pragma unroll
                for (int bj = 0; bj < 2; ++bj) { const f32x4 v0 = acc[ai][bj][m][0], v1 = acc[ai][bj][m][1];
                    u32x4 w; w.x = cvt_pk_bf16(v0[0], v0[1]); w.y = cvt_pk_bf16(v0[2], v0[3]); w.z = cvt_pk_bf16(v1[0], v1[1]); w.w = cvt_pk_bf16(v1[2], v1[3]);
                    *(u32x4*)(rowp + bj * HALF) = w; } }
    }
};
struct EpiSwiGLU {
    static constexpr bool PERM = true;
    bf16_t* O; int ldc;
    __device__ __forceinline__ void operator()(const f32x4 (&acc)[2][2][4][2], const Unit& u, int wr, int wc, int fr, int fq) const {
        const int row0 = u.pm * BM + wr * 64 + fr, col0 = u.pc * HALF + wc * 32 + 8 * fq;
#pragma unroll
        for (int ai = 0; ai < 2; ++ai)
#pragma unroll
            for (int m = 0; m < 4; ++m) { bf16_t* rowp = O + (size_t)(row0 + ai * HALF + m * 16) * ldc + col0;
                float r[8];
#pragma unroll
                for (int n = 0; n < 2; ++n)
#pragma unroll
                    for (int j = 0; j < 4; ++j) { const float g = acc[ai][0][m][n][j], up = acc[ai][1][m][n][j]; r[n * 4 + j] = g * __builtin_amdgcn_rcpf(1.0f + __expf(-g)) * up; }
                u32x4 w; w.x = cvt_pk_bf16(r[0], r[1]); w.y = cvt_pk_bf16(r[2], r[3]); w.z = cvt_pk_bf16(r[4], r[5]); w.w = cvt_pk_bf16(r[6], r[7]);
                *(u32x4*)rowp = w; }
    }
};
struct EpiResF32 {
    static constexpr bool PERM = false;
    const float* res; float* out; int ldc;
    __device__ __forceinline__ void operator()(const f32x4 (&acc)[2][2][4][2], const Unit& u, int wr, int wc, int fr, int fq) const {
        const int row0 = u.pm * BM + wr * 64 + fr, col0 = u.pc * BM + wc * 32 + 4 * fq;
#pragma unroll
        for (int ai = 0; ai < 2; ++ai)
#pragma unroll
            for (int m = 0; m < 4; ++m) { const size_t off = (size_t)(row0 + ai * HALF + m * 16) * ldc + col0;
#pragma unroll
                for (int bj = 0; bj < 2; ++bj)
#pragma unroll
                    for (int n = 0; n < 2; ++n) { f32x4 v = acc[ai][bj][m][n]; if (res) v = v + *(const f32x4*)(res + off + bj * HALF + n * 16); *(f32x4*)(out + off + bj * HALF + n * 16) = v; } }
    }
};
struct EpiLora {
    static constexpr bool PERM = false;
    float* LWp; bf16_t* LAp; bf16_t* LGp; const float* w0; const float* a0;
    __device__ __forceinline__ void operator()(const f32x4 (&acc)[2][2][4][2], const Unit& u, int wr, int wc, int fr, int fq) const {
        const int kind = u.pc >> 2; const int row0 = u.pm * BM + wr * 64 + fr, col0 = (u.pc & 3) * BM + wc * 32 + 4 * fq;
        const float* bias = kind == 0 ? w0 : a0; bf16_t* hdst = kind == 1 ? LAp : LGp;
#pragma unroll
        for (int bj = 0; bj < 2; ++bj)
#pragma unroll
            for (int n = 0; n < 2; ++n) { const int c = col0 + bj * HALF + n * 16; f32x4 bv = (f32x4){0.f, 0.f, 0.f, 0.f}; if (kind < 2) bv = *(const f32x4*)(bias + c);
#pragma unroll
                for (int ai = 0; ai < 2; ++ai)
#pragma unroll
                    for (int m = 0; m < 4; ++m) { f32x4 v = acc[ai][bj][m][n] + bv;
                        if (kind < 2) {
#pragma unroll
                            for (int j = 0; j < 4; ++j) { const float s = 1.0f / (1.0f + __expf(-v[j])); v[j] = kind == 0 ? (-0.6065306597126334f * s) : s; } }
                        const size_t off = (size_t)(row0 + ai * HALF + m * 16) * 1024 + c;
                        if (kind == 0) *(f32x4*)(LWp + off) = v;
                        else { v2u pk; pk.x = cvt_pk_bf16(v[0], v[1]); pk.y = cvt_pk_bf16(v[2], v[3]); *(v2u*)(hdst + off) = pk; } } }
    }
};

template <class Epi, class Sched, bool ALIGN_EPI, bool SP2>
__device__ __forceinline__ void gemm_phase(PG8_LAS unsigned char* lds, const Gemm g, const Sched& S, const Epi& E) {
    const int tid = threadIdx.x, wid = __builtin_amdgcn_readfirstlane(tid >> 6), lane = tid & 63, wr = wid >> 2, wc = wid & 3, fr = lane & 15, fq = lane >> 4;
    const int K = g.K, nt = K / BK;
    unsigned voffA[2], voffB[2];
#pragma unroll
    for (int i = 0; i < 2; ++i) { int R, C; stage_rc(tid * 16 + i * 8192, R, C); const int Rb = Epi::PERM ? ((R & ~31) + perm32(R & 31)) : R;
        voffA[i] = (unsigned)(R * K + C) * 2u; voffB[i] = (unsigned)(Rb * K + C) * 2u; }
    const size_t kstep = (size_t)(BK * 2);
    const size_t hstep = (size_t)HALF * K * 2;
    const size_t tstep = 2 * hstep;
    const unsigned ldsw = (unsigned)wid * 1024u;
    const int aoff = lds_byte(wr * 64 + fr, fq * 8), boff = lds_byte(wc * 32 + fr, fq * 8);
#define PG8_SA(b, h) (((b) * 2 + (h)) * HTB)
#define PG8_SB(b, h) ((4 + (b) * 2 + (h)) * HTB)
#define PG8_STAGE(bufoff, gbase, voff) do { _Pragma("unroll") for (int _i = 0; _i < 2; ++_i) \
        __builtin_amdgcn_global_load_lds((const unsigned*)((const char*)(gbase) + (voff)[_i]), (PG8_LAS unsigned*)(lds + (bufoff) + ldsw + _i * 8192), 16, 0, 0); } while (0)
#define PG8_LDA(dst, b, h) do { _Pragma("unroll") for (int m = 0; m < 4; ++m) _Pragma("unroll") for (int k = 0; k < 2; ++k) dst[m][k] = *(const PG8_LAS bf16x8*)(lds + PG8_SA(b, h) + aoff + m * 2048 + k * 1024); } while (0)
#define PG8_LDB(dst, b, h) do { _Pragma("unroll") for (int n = 0; n < 2; ++n) _Pragma("unroll") for (int k = 0; k < 2; ++k) dst[n][k] = *(const PG8_LAS bf16x8*)(lds + PG8_SB(b, h) + boff + n * 2048 + k * 1024); } while (0)
#define PG8_MMA(ai, bj, At, Bt) do { __builtin_amdgcn_s_setprio(1); _Pragma("unroll") for (int m = 0; m < 4; ++m) _Pragma("unroll") for (int n = 0; n < 2; ++n) _Pragma("unroll") for (int k = 0; k < 2; ++k) \
        acc[ai][bj][m][n] = __builtin_amdgcn_mfma_f32_16x16x32_bf16(Bt[n][k], At[m][k], acc[ai][bj][m][n], 0, 0, 0); __builtin_amdgcn_s_setprio(0); } while (0)
#define PG8_WAIT_V(n) asm volatile("s_waitcnt vmcnt(" #n ")" ::: "memory")
#define PG8_WAIT_L(n) asm volatile("s_waitcnt lgkmcnt(" #n ")" ::: "memory")
#define PG8_BAR __builtin_amdgcn_s_barrier()
#define PG8_SCHED __builtin_amdgcn_sched_barrier(0)
    Unit cur, nxt; int ui = 0;
    if (!S.next(0, cur)) return;
    f32x4 acc[2][2][4][2];
#pragma unroll
    for (int a = 0; a < 2; ++a)
#pragma unroll
        for (int b = 0; b < 2; ++b)
#pragma unroll
            for (int m = 0; m < 4; ++m)
#pragma unroll
                for (int n = 0; n < 2; ++n) acc[a][b][m][n] = (f32x4){0.f, 0.f, 0.f, 0.f};
    bf16x8 At[4][2], B0[2][2], B1[2][2];
    const char* cA = (const char*)g.A + (size_t)cur.pm * tstep; const char* cB = (const char*)g.Bt + (size_t)cur.pn * tstep;
    S.a_ready(cur);
    if constexpr (SP2) {
        PG8_STAGE(PG8_SB(0, 0), cB, voffB); PG8_STAGE(PG8_SB(0, 1), cB + hstep, voffB); PG8_STAGE(PG8_SA(0, 0), cA, voffA); PG8_STAGE(PG8_SA(0, 1), cA + hstep, voffA);
        if (wr == 1) PG8_BAR;
        PG8_WAIT_V(2); PG8_BAR;
        PG8_STAGE(PG8_SB(1, 0), cB + kstep, voffB); PG8_STAGE(PG8_SA(1, 0), cA + kstep, voffA); PG8_STAGE(PG8_SB(1, 1), cB + hstep + kstep, voffB);
        PG8_WAIT_V(6); PG8_BAR;
    } else {
        PG8_STAGE(PG8_SB(0, 0), cB, voffB); PG8_STAGE(PG8_SA(0, 0), cA, voffA); PG8_STAGE(PG8_SB(0, 1), cB + hstep, voffB); PG8_STAGE(PG8_SA(0, 1), cA + hstep, voffA);
        if (wr == 1) PG8_BAR;
        PG8_WAIT_V(4); PG8_BAR;
        PG8_STAGE(PG8_SB(1, 0), cB + kstep, voffB); PG8_STAGE(PG8_SA(1, 0), cA + kstep, voffA); PG8_STAGE(PG8_SB(1, 1), cB + hstep + kstep, voffB);
        PG8_WAIT_V(6); PG8_BAR;
    }
    for (;;) {
        const bool has_next = S.next(ui + 1, nxt);
        const char* nA = has_next ? (const char*)g.A + (size_t)nxt.pm * tstep : cA; const char* nB = has_next ? (const char*)g.Bt + (size_t)nxt.pn * tstep : cB;
        for (int t = 0; t < nt; t += 2) {
            const bool last = (t == nt - 2);
            const char* a1 = cA + (size_t)(t + 1) * kstep;
            const char* a2 = last ? nA : cA + (size_t)(t + 2) * kstep; const char* b2 = last ? nB : cB + (size_t)(t + 2) * kstep;
            const char* a3 = a2 + kstep; const char* b3 = b2 + kstep;
            if (last && has_next) S.a_ready(nxt);
            if constexpr (SP2) {
            PG8_LDB(B0, 0, 0); PG8_LDB(B1, 0, 1); PG8_SCHED; PG8_LDA(At, 0, 0); PG8_STAGE(PG8_SA(1, 1), a1 + hstep, voffA);
            PG8_WAIT_V(8); PG8_WAIT_L(0); PG8_BAR; PG8_MMA(0, 0, At, B0); PG8_MMA(0, 1, At, B1); PG8_BAR; PG8_SCHED;
            PG8_LDA(At, 0, 1); PG8_STAGE(PG8_SB(0, 0), b2, voffB); PG8_STAGE(PG8_SB(0, 1), b2 + hstep, voffB); PG8_STAGE(PG8_SA(0, 0), a2, voffA);
            PG8_WAIT_V(8); PG8_WAIT_L(0); PG8_BAR; PG8_MMA(1, 0, At, B0); PG8_MMA(1, 1, At, B1); PG8_BAR; PG8_SCHED;
            PG8_LDB(B0, 1, 0); PG8_LDB(B1, 1, 1); PG8_SCHED; PG8_LDA(At, 1, 0); PG8_STAGE(PG8_SA(0, 1), a2 + hstep, voffA);
            PG8_WAIT_V(8); PG8_WAIT_L(0); PG8_BAR; PG8_MMA(0, 0, At, B0); PG8_MMA(0, 1, At, B1); PG8_BAR; PG8_SCHED;
            PG8_LDA(At, 1, 1); PG8_STAGE(PG8_SB(1, 0), b3, voffB); PG8_STAGE(PG8_SB(1, 1), b3 + hstep, voffB); PG8_STAGE(PG8_SA(1, 0), a3, voffA);
            PG8_WAIT_V(8); PG8_WAIT_L(0); PG8_BAR; PG8_MMA(1, 0, At, B0); PG8_MMA(1, 1, At, B1); PG8_BAR; PG8_SCHED;
            } else {
            PG8_LDB(B0, 0, 0); PG8_SCHED; PG8_LDA(At, 0, 0); PG8_STAGE(PG8_SA(1, 1), a1 + hstep, voffA);
            PG8_WAIT_L(8); PG8_BAR; PG8_WAIT_L(0); PG8_MMA(0, 0, At, B0); PG8_BAR; PG8_SCHED;
            PG8_LDB(B1, 0, 1); PG8_STAGE(PG8_SB(0, 0), b2, voffB);
            PG8_BAR; PG8_WAIT_L(0); PG8_MMA(0, 1, At, B1); PG8_BAR;
            PG8_LDA(At, 0, 1); PG8_STAGE(PG8_SA(0, 0), a2, voffA);
            PG8_BAR; PG8_WAIT_L(0); PG8_MMA(1, 0, At, B0); PG8_BAR; PG8_SCHED;
            PG8_STAGE(PG8_SB(0, 1), b2 + hstep, voffB);
            PG8_WAIT_V(6); PG8_BAR; PG8_MMA(1, 1, At, B1); PG8_BAR;
            PG8_LDB(B0, 1, 0); PG8_SCHED; PG8_LDA(At, 1, 0); PG8_STAGE(PG8_SA(0, 1), a2 + hstep, voffA);
            PG8_WAIT_L(8); PG8_BAR; PG8_WAIT_L(0); PG8_MMA(0, 0, At, B0); PG8_BAR; PG8_SCHED;
            PG8_LDB(B1, 1, 1); PG8_STAGE(PG8_SB(1, 0), b3, voffB);
            PG8_BAR; PG8_WAIT_L(0); PG8_MMA(0, 1, At, B1); PG8_BAR;
            PG8_LDA(At, 1, 1); PG8_STAGE(PG8_SA(1, 0), a3, voffA);
            PG8_BAR; PG8_WAIT_L(0); PG8_MMA(1, 0, At, B0); PG8_BAR; PG8_SCHED;
            PG8_STAGE(PG8_SB(1, 1), b3 + hstep, voffB);
            PG8_WAIT_V(6); PG8_BAR; PG8_MMA(1, 1, At, B1); PG8_BAR;
            }
        }
        if constexpr (ALIGN_EPI) { if (wr == 0) PG8_BAR; }
        E(acc, cur, wr, wc, fr, fq); S.done(cur);
        if (!has_next) break;
#pragma unroll
        for (int a = 0; a < 2; ++a)
#pragma unroll
            for (int b = 0; b < 2; ++b)
#pragma unroll
                for (int m = 0; m < 4; ++m)
#pragma unroll
                    for (int n = 0; n < 2; ++n) acc[a][b][m][n] = (f32x4){0.f, 0.f, 0.f, 0.f};
        cur = nxt; cA = nA; cB = nB; ++ui;
        if constexpr (ALIGN_EPI) { if (wr == 1) PG8_BAR; }
    }
    PG8_WAIT_V(0);
    if constexpr (!ALIGN_EPI) { if (wr == 0) PG8_BAR; }
    PG8_BAR;
#undef PG8_SA
#undef PG8_SB
#undef PG8_STAGE
#undef PG8_LDA
#undef PG8_LDB
#undef PG8_MMA
#undef PG8_WAIT_V
#undef PG8_WAIT_L
#undef PG8_BAR
#undef PG8_SCHED
}
}

#define XB_TMO      128
#define XB_XCNT(j)  (256  + 64 * (j))
#define XB_XSUB(j)  (1280 + 64 * (j))
#define XB_XGEN(j)  (2304 + 64 * (j))
#define XB_TOP      3328
#define XB_TOPGEN   3392
#define XCD_BAR_WORDS 3456
#define XB_SPIN_CAP (1u << 18)
__device__ __forceinline__ unsigned xb_ld(unsigned* p)              { return __hip_atomic_load(p, __ATOMIC_RELAXED, __HIP_MEMORY_SCOPE_AGENT); }
__device__ __forceinline__ unsigned xb_add(unsigned* p, unsigned v) { return __hip_atomic_fetch_add(p, v, __ATOMIC_RELAXED, __HIP_MEMORY_SCOPE_AGENT); }
__device__ __forceinline__ unsigned xb_xcc_id() { return (unsigned)__builtin_amdgcn_s_getreg((3 << 11) | 20) & 0xFu; }
#define XB_SPIN(cond, bar) do { unsigned _sp = 0; while (cond) { __builtin_amdgcn_s_sleep(1); \
    if ((++_sp & 255u) == 0u) { if (xb_ld(&(bar)[XB_TMO])) break; if (_sp > XB_SPIN_CAP) { atomicAdd(&(bar)[XB_TMO], 1u); break; } } } } while (0)
struct XcdBarrier { unsigned* bar; unsigned x; volatile LAS unsigned* st; };
__device__ __forceinline__ XcdBarrier xcd_barrier_post(unsigned* bar, volatile LAS unsigned* st) {
    XcdBarrier b; b.bar = bar; b.x = xb_xcc_id(); b.st = st;
    if (threadIdx.x == 0) (void)xb_add(&bar[XB_XCNT(b.x)], 1u);
    return b;
}
__device__ __forceinline__ void xcd_barrier_complete(unsigned* bar, unsigned x, unsigned& nloc, unsigned& nx) {
    const unsigned G = gridDim.x * gridDim.y * gridDim.z;
    unsigned sum, cnt, mine, sp = 0u;
    for (;;) {
        sum = 0u; cnt = 0u; mine = 0u;
#pragma unroll
        for (unsigned j = 0; j < 16; ++j) { const unsigned c = xb_ld(&bar[XB_XCNT(j)]); sum += c; cnt += (c > 0u) ? 1u : 0u; mine = (j == x) ? c : mine; }
        if (sum == G) break;
        __builtin_amdgcn_s_sleep(1);
        if ((++sp & 255u) == 0u) { if (xb_ld(&bar[XB_TMO])) break; if (sp > XB_SPIN_CAP) { atomicAdd(&bar[XB_TMO], 1u); break; } }
    }
    nloc = mine > 0u ? mine : 1u; nx = cnt > 0u ? cnt : 1u;
}
__device__ __forceinline__ void xcd_barrier(const XcdBarrier& b) {
    asm volatile("s_waitcnt vmcnt(0)" ::: "memory");
    __syncthreads();
    if (threadIdx.x == 0) {
        unsigned* bar = b.bar;
        __builtin_amdgcn_s_waitcnt(0);
        unsigned nloc = b.st[0], nx = b.st[1];
        if (nloc == 0u) { xcd_barrier_complete(bar, b.x, nloc, nx); b.st[0] = nloc; b.st[1] = nx; }
        const unsigned old = xb_add(&bar[XB_XSUB(b.x)], 1u);
        const unsigned gen = old / nloc;
        if (old + 1u == (gen + 1u) * nloc) {
            __builtin_amdgcn_fence(__ATOMIC_RELEASE, "agent");
            asm volatile("s_waitcnt vmcnt(0)" ::: "memory");
            const unsigned og = xb_add(&bar[XB_TOP], 1u);
            const unsigned tg = og / nx;
            if (og + 1u == (tg + 1u) * nx) xb_add(&bar[XB_TOPGEN], 1u);
            else XB_SPIN(xb_ld(&bar[XB_TOPGEN]) == tg, bar);
            __builtin_amdgcn_fence(__ATOMIC_ACQUIRE, "agent");
            xb_add(&bar[XB_XGEN(b.x)], 1u);
            asm volatile("s_waitcnt vmcnt(0)" ::: "memory");
        } else {
            XB_SPIN(xb_ld(&bar[XB_XGEN(b.x)]) == gen, bar);
            __builtin_amdgcn_fence(__ATOMIC_ACQUIRE, "agent");
            asm volatile("s_waitcnt vmcnt(0)" ::: "memory");
        }
    }
    __syncthreads();
}

struct Ctx { LAS unsigned char* lds; int tid, lane, wave, bid, G; };

struct ConvTile { const float* W; bf16* WT; int K, N, mode, k0, n0; };
__device__ __forceinline__ void conv_load(const ConvTile& t, f32x4 (&rg)[4], int tid) {
    const int nc = (tid & 15) * 4, kr = tid >> 4;
#pragma unroll
    for (int i = 0; i < 4; ++i) rg[i] = (t.n0 + nc < t.N) ? *(const f32x4*)(t.W + (size_t)(t.k0 + kr + 32 * i) * t.N + t.n0 + nc) : (f32x4){0.f, 0.f, 0.f, 0.f};
}
__device__ __forceinline__ void conv_emit(const ConvTile& t, const f32x4 (&rg)[4], LAS float* scr, int tid) {
    { const int nc = (tid & 15) * 4, kr = tid >> 4;
#pragma unroll
      for (int i = 0; i < 4; ++i) { const int k = kr + 32 * i; *(LAS f32x4*)(scr + k * 64 + (nc ^ (((k >> 3) & 15) << 2))) = rg[i]; } }
    __syncthreads();
#pragma unroll
    for (int h = 0; h < 2; ++h) { const int id = tid + 512 * h, nn = id >> 4, kc = id & 15; float v[8];
#pragma unroll
        for (int j = 0; j < 8; ++j) v[j] = scr[(kc * 8 + j) * 64 + (nn ^ (kc << 2))];
        const int ns = t.n0 + nn; const int drow = t.mode == 0 ? ns : ((ns >> 7) * 256 + (ns & 127) + (t.mode == 2 ? 128 : 0));
        v4u o; o.x = cvt_pk_bf16(v[0], v[1]); o.y = cvt_pk_bf16(v[2], v[3]); o.z = cvt_pk_bf16(v[4], v[5]); o.w = cvt_pk_bf16(v[6], v[7]);
        *(v4u*)(t.WT + (size_t)drow * t.K + t.k0 + kc * 8) = o; }
    __syncthreads();
}
struct ConvKind { const float* W; bf16* WT; int K, N, Npad, mode, nmat; size_t sstr, dstr; };
__device__ __forceinline__ bool conv_item(const ConvKind (&kinds)[10], int item, ConvTile& t) {
    bool found = false;
#pragma unroll
    for (int q = 0; q < 10; ++q) { const int nkt = kinds[q].K / 128, nnt = kinds[q].Npad / 64, per = nkt * nnt, cnt = per * kinds[q].nmat;
        if (!found && item < cnt) { const int mat = item / per, r = item % per; t.W = kinds[q].W + (size_t)mat * kinds[q].sstr; t.WT = kinds[q].WT + (size_t)mat * kinds[q].dstr; t.K = kinds[q].K; t.N = kinds[q].N; t.mode = kinds[q].mode;
            t.k0 = (r / nnt) * 128; t.n0 = (r % nnt) * 64; found = true; }
        if (!found) item -= cnt; }
    return found;
}
__device__ __forceinline__ void conv_run(const ConvKind (&kinds)[10], int lo, int hi, int wk, int nw, LAS float* scr, int tid) {
    ConvTile cur, nxt; f32x4 ra[4], rb[4];
    int item = lo + wk; bool have = item < hi && conv_item(kinds, item, cur);
    if (have) conv_load(cur, ra, tid);
    while (have) {
        item += nw; const bool hn = item < hi && conv_item(kinds, item, nxt);
        if (hn) conv_load(nxt, rb, tid);
        conv_emit(cur, ra, scr, tid);
        have = hn; cur = nxt;
#pragma unroll
        for (int i = 0; i < 4; ++i) ra[i] = rb[i];
    }
}
constexpr int CV_P0 = 5564, CV_P1 = 10300, CV_P5 = 16950, CV_P9 = 20150, CV_P12 = 22550, CV_ALL = 25664;
__device__ __forceinline__ void rmsnorm_row_bf16(const float* xr, const float* w, bf16* orow, int lane) {
    f32x4 v[8]; float ss = 0.f;
#pragma unroll
    for (int j = 0; j < 8; ++j) { v[j] = *(const f32x4*)(xr + 4 * lane + 256 * j); ss += (v[j].x * v[j].x + v[j].y * v[j].y) + (v[j].z * v[j].z + v[j].w * v[j].w); }
    const float rs = 1.0f / sqrtf(wave_sum(ss) * (1.0f / 2048.0f) + 1e-6f);
#pragma unroll
    for (int j = 0; j < 8; ++j) { const f32x4 wv = *(const f32x4*)(w + 4 * lane + 256 * j); const f32x4 o = v[j] * rs * wv;
        v2u p; p.x = cvt_pk_bf16(o.x, o.y); p.y = cvt_pk_bf16(o.z, o.w); *(v2u*)(orow + 4 * lane + 256 * j) = p; }
}
__device__ __forceinline__ void rmsnorm_phase(const Ctx& c, const float* X, const float* w, bf16* XN) {
    const int gw = c.bid * 8 + c.wave, NGW = c.G * 8;
    f32x4 wv[8];
#pragma unroll
    for (int j = 0; j < 8; ++j) wv[j] = *(const f32x4*)(w + 4 * c.lane + 256 * j);
    f32x4 nx[8];
    if (gw < M_TOK) {
#pragma unroll
        for (int j = 0; j < 8; ++j) nx[j] = *(const f32x4*)(X + (size_t)gw * DM + 4 * c.lane + 256 * j); }
    for (int m = gw; m < M_TOK; m += NGW) {
        f32x4 v[8]; float ss = 0.f;
#pragma unroll
        for (int j = 0; j < 8; ++j) { v[j] = nx[j]; ss += (v[j].x * v[j].x + v[j].y * v[j].y) + (v[j].z * v[j].z + v[j].w * v[j].w); }
        if (m + NGW < M_TOK) {
#pragma unroll
            for (int j = 0; j < 8; ++j) nx[j] = *(const f32x4*)(X + (size_t)(m + NGW) * DM + 4 * c.lane + 256 * j); }
        const float rs = 1.0f / sqrtf(wave_sum(ss) * (1.0f / 2048.0f) + 1e-6f);
#pragma unroll
        for (int j = 0; j < 8; ++j) { const f32x4 o = v[j] * rs * wv[j]; v2u pk; pk.x = cvt_pk_bf16(o.x, o.y); pk.y = cvt_pk_bf16(o.z, o.w); *(v2u*)(XN + (size_t)m * DM + 4 * c.lane + 256 * j) = pk; }
    }
}

__device__ __forceinline__ LAS unsigned char* launder_lds(LAS unsigned char* p) {
#if defined(__HIP_DEVICE_COMPILE__)
    unsigned v = __builtin_bit_cast(unsigned, p); asm volatile("" : "+v"(v)); return __builtin_bit_cast(LAS unsigned char*, v);
#else
    return p;
#endif
}
__device__ __forceinline__ bf16x8 frag_row(const LAS bf16* img, int stride, int r0, int k0, int lane) { return *(const LAS bf16x8*)(img + (r0 + (lane & 15)) * stride + k0 + 8 * (lane >> 4)); }
typedef short s16x4 __attribute__((ext_vector_type(4)));
__device__ __forceinline__ bf16x8 frag_tr(const LAS bf16* img, int stride, int n0, int k0, int lane) {
    const int g = lane >> 4, qq = (lane & 15) >> 2, pp = lane & 3;
    const LAS bf16* p0 = img + (k0 + 8 * g + qq) * stride + n0 + 4 * pp;
#if defined(__HIP_DEVICE_COMPILE__)
    const s16x4 lo = __builtin_amdgcn_ds_read_tr16_b64_v4i16((LAS s16x4*)p0), hi = __builtin_amdgcn_ds_read_tr16_b64_v4i16((LAS s16x4*)(p0 + 4 * stride));
#else
    const s16x4 lo = (s16x4){0, 0, 0, 0}, hi = lo; (void)p0;
#endif
    return (bf16x8){lo.x, lo.y, lo.z, lo.w, hi.x, hi.y, hi.z, hi.w};
}
__device__ __forceinline__ v4u pack8(const f32x4 a, const f32x4 b) { v4u o; o.x = cvt_pk_bf16(a[0], a[1]); o.y = cvt_pk_bf16(a[2], a[3]); o.z = cvt_pk_bf16(b[0], b[1]); o.w = cvt_pk_bf16(b[2], b[3]); return o; }
__device__ __forceinline__ v2u pack4(const f32x4 a) { v2u o; o.x = cvt_pk_bf16(a[0], a[1]); o.y = cvt_pk_bf16(a[2], a[3]); return o; }
__device__ __forceinline__ f32x4 unpack4(const v2u p) { return (f32x4){__uint_as_float(p.x << 16), __uint_as_float(p.x & 0xffff0000u), __uint_as_float(p.y << 16), __uint_as_float(p.y & 0xffff0000u)}; }
__device__ __forceinline__ float softplusf_(float x) { return x > 20.0f ? x : log1pf(__expf(x)); }

constexpr int RST = 72;
__device__ __forceinline__ void tile_store(LAS bf16* img, int rt, int ct, const f32x4 a, int lane) { v2u p; p.x = cvt_pk_bf16(a[0], a[1]); p.y = cvt_pk_bf16(a[2], a[3]); *(LAS v2u*)(img + (16 * rt + (lane & 15)) * RST + 16 * ct + 4 * (lane >> 4)) = p; }
__device__ __forceinline__ f32x4 tile_load(const LAS bf16* img, int rt, int ct, int lane) { const v2u p = *(const LAS v2u*)(img + (16 * rt + (lane & 15)) * RST + 16 * ct + 4 * (lane >> 4));
    return (f32x4){__uint_as_float(p.x << 16), __uint_as_float(p.x & 0xffff0000u), __uint_as_float(p.y << 16), __uint_as_float(p.y & 0xffff0000u)}; }
__device__ __forceinline__ f32x4 mm_xy(const LAS bf16* X, const LAS bf16* Y, int rt, int ct, f32x4 acc, int lane) {
#pragma unroll
    for (int ks = 0; ks < 2; ++ks) acc = __builtin_amdgcn_mfma_f32_16x16x32_bf16(frag_tr(Y, RST, 16 * ct, 32 * ks, lane), frag_row(X, RST, 16 * rt, 32 * ks, lane), acc, 0, 0, 0);
    return acc; }
__device__ __forceinline__ f32x4 mm_xty(const LAS bf16* X, const LAS bf16* Y, int rt, int ct, f32x4 acc, int lane) {
#pragma unroll
    for (int ks = 0; ks < 2; ++ks) acc = __builtin_amdgcn_mfma_f32_16x16x32_bf16(frag_tr(Y, RST, 16 * ct, 32 * ks, lane), frag_tr(X, RST, 16 * rt, 32 * ks, lane), acc, 0, 0, 0);
    return acc; }
__device__ __forceinline__ f32x4 mm_xyt(const LAS bf16* X, const LAS bf16* Y, int rt, int ct, f32x4 acc, int lane) {
#pragma unroll
    for (int ks = 0; ks < 2; ++ks) acc = __builtin_amdgcn_mfma_f32_16x16x32_bf16(frag_row(Y, RST, 16 * ct, 32 * ks, lane), frag_row(X, RST, 16 * rt, 32 * ks, lane), acc, 0, 0, 0);
    return acc; }
__device__ __forceinline__ void gtile_store(bf16* g, int rt, int ct, const f32x4 a, int lane) { v2u p; p.x = cvt_pk_bf16(a[0], a[1]); p.y = cvt_pk_bf16(a[2], a[3]); *(v2u*)(g + (16 * rt + (lane & 15)) * 64 + 16 * ct + 4 * (lane >> 4)) = p; }
__device__ __forceinline__ f32x4 gtile_load(const bf16* g, int rt, int ct, int lane) { const v2u p = *(const v2u*)(g + (16 * rt + (lane & 15)) * 64 + 16 * ct + 4 * (lane >> 4));
    return (f32x4){__uint_as_float(p.x << 16), __uint_as_float(p.x & 0xffff0000u), __uint_as_float(p.y << 16), __uint_as_float(p.y & 0xffff0000u)}; }

__device__ __forceinline__ void rwkv_prep_unit(const Ctx& c, int unit, const bf16* U, const float* LW, const bf16* LA, const float* mu, const float* k_k, const float* k_a, bf16* PHI, bf16* RAP, bf16* PSI, bf16* YVB) {
    const int chunk = unit & 31, head = (unit >> 5) & 15, batch = unit >> 9;
    LAS unsigned char* base = launder_lds(c.lds);
#define RIMG(n) ((LAS bf16*)(base + (n) * 9216))
    LAS bf16* Ai = RIMG(0); LAS bf16* Ri = RIMG(1); LAS bf16* Bi = RIMG(2); LAS bf16* Ki = RIMG(3); LAS bf16* Vi = RIMG(4); LAS bf16* Aak = RIMG(5); LAS bf16* Arb = RIMG(6); LAS bf16* Ark = RIMG(7);
    LAS bf16* PA = RIMG(8); LAS bf16* PB = RIMG(9); LAS bf16* T0 = RIMG(10); LAS bf16* T1 = RIMG(11);
    LAS float* LF = (LAS float*)(base + 10 * 9216);
    LAS float* SEGT = (LAS float*)(base + 12 * 9216); LAS float* ER = SEGT + 512; LAS float* EG = ER + 64; LAS float* EGR = EG + 64;
    const int lane = c.lane, w = c.wave, r = lane & 15, q = lane >> 4, trow = c.tid >> 3, part = c.tid & 7;
    const int rt = w >> 1, ct0 = 2 * (w & 1);
    { const int j0 = 8 * part, col = head * 64 + j0, tl = chunk * 64 + trow; const size_t m = (size_t)batch * SEQ + tl; const bf16* ur = U + m * EVP;
      const v4u r8 = *(const v4u*)(ur + col), k8 = *(const v4u*)(ur + 1024 + col), v8 = *(const v4u*)(ur + 2048 + col);
      v4u rp = (v4u){0u, 0u, 0u, 0u}, kp = rp, vp = rp;
      if (tl > 0) { rp = *(const v4u*)(ur - EVP + col); kp = *(const v4u*)(ur - EVP + 1024 + col); vp = *(const v4u*)(ur - EVP + 2048 + col); }
      const f32x4 lw0 = *(const f32x4*)(LW + m * 1024 + col), lw1 = *(const f32x4*)(LW + m * 1024 + col + 4); const v4u al8 = *(const v4u*)(LA + m * 1024 + col);
      float rr[8], kk[8], vv[8], rq[8], kq[8], vq[8], lw[8], al[8];
#define RW_UNPK(dst, src) do { dst[0] = __uint_as_float((src).x << 16); dst[1] = __uint_as_float((src).x & 0xffff0000u); dst[2] = __uint_as_float((src).y << 16); dst[3] = __uint_as_float((src).y & 0xffff0000u); \
        dst[4] = __uint_as_float((src).z << 16); dst[5] = __uint_as_float((src).z & 0xffff0000u); dst[6] = __uint_as_float((src).w << 16); dst[7] = __uint_as_float((src).w & 0xffff0000u); } while (0)
      RW_UNPK(rr, r8); RW_UNPK(kk, k8); RW_UNPK(vv, v8); RW_UNPK(rq, rp); RW_UNPK(kq, kp); RW_UNPK(vq, vp);
#pragma unroll
      for (int e = 0; e < 4; ++e) { lw[e] = lw0[e]; lw[4 + e] = lw1[e]; }
      RW_UNPK(al, al8);
      float kn[8], ss = 0.f;
#pragma unroll
      for (int e = 0; e < 8; ++e) { rr[e] += (rq[e] - rr[e]) * mu[col + e]; kk[e] += (kq[e] - kk[e]) * mu[1024 + col + e]; vv[e] += (vq[e] - vv[e]) * mu[2048 + col + e]; kn[e] = kk[e] * k_k[col + e]; ss += kn[e] * kn[e]; }
      ss += __shfl_xor(ss, 1); ss += __shfl_xor(ss, 2); ss += __shfl_xor(ss, 4);
      const float rn = 1.0f / sqrtf(fmaxf(ss, 1e-12f));
      *(LAS f32x4*)(LF + trow * 68 + j0) = (f32x4){lw[0], lw[1], lw[2], lw[3]}; *(LAS f32x4*)(LF + trow * 68 + j0 + 4) = (f32x4){lw[4], lw[5], lw[6], lw[7]};
      __syncthreads();
      { const int j = c.tid & 63, seg = c.tid >> 6; float run = 0.f;
#pragma unroll
        for (int i = 0; i < 8; ++i) { run += LF[(8 * seg + i) * 68 + j]; LF[(8 * seg + i) * 68 + j] = run; }
        SEGT[seg * 64 + j] = run; }
      __syncthreads();
      const int segt = trow >> 3; float ai[8], ri[8], bi[8], ki[8];
#pragma unroll
      for (int h2 = 0; h2 < 2; ++h2) { f32x4 cum = *(const LAS f32x4*)(LF + trow * 68 + j0 + 4 * h2), ref = *(const LAS f32x4*)(LF + 31 * 68 + j0 + 4 * h2), g = *(const LAS f32x4*)(LF + 63 * 68 + j0 + 4 * h2);
#pragma unroll
          for (int sgi = 0; sgi < 7; ++sgi) { const f32x4 sv = *(const LAS f32x4*)(SEGT + sgi * 64 + j0 + 4 * h2); if (sgi < segt) cum = cum + sv; if (sgi < 3) ref = ref + sv; g = g + sv; }
#pragma unroll
          for (int e4 = 0; e4 < 4; ++e4) { const int e = 4 * h2 + e4; const float d = cum[e4] - ref[e4], ed = __expf(d), edi = __expf(-d); const float kkn = kn[e] * rn;
              ai[e] = -kkn * __expf(d - lw[e]); ri[e] = rr[e] * ed; bi[e] = kkn * al[e] * edi; ki[e] = kk[e] * (1.0f + (al[e] - 1.0f) * k_a[col + e]) * edi;
              if (trow == 0) { ER[j0 + e] = __expf(ref[e4]); EG[j0 + e] = __expf(g[e4]); EGR[j0 + e] = __expf(g[e4] - ref[e4]); } } }
      *(LAS v4u*)(Ai + trow * RST + j0) = pack8((f32x4){ai[0], ai[1], ai[2], ai[3]}, (f32x4){ai[4], ai[5], ai[6], ai[7]});
      *(LAS v4u*)(Ri + trow * RST + j0) = pack8((f32x4){ri[0], ri[1], ri[2], ri[3]}, (f32x4){ri[4], ri[5], ri[6], ri[7]});
      *(LAS v4u*)(Bi + trow * RST + j0) = pack8((f32x4){bi[0], bi[1], bi[2], bi[3]}, (f32x4){bi[4], bi[5], bi[6], bi[7]});
      *(LAS v4u*)(Ki + trow * RST + j0) = pack8((f32x4){ki[0], ki[1], ki[2], ki[3]}, (f32x4){ki[4], ki[5], ki[6], ki[7]});
      *(LAS v4u*)(Vi + trow * RST + j0) = pack8((f32x4){vv[0], vv[1], vv[2], vv[3]}, (f32x4){vv[4], vv[5], vv[6], vv[7]});
#undef RW_UNPK
    }
    __syncthreads();
    f32x4 Tacc[2];
#pragma unroll
    for (int i = 0; i < 2; ++i) { const int ct = ct0 + i; const f32x4 z = (f32x4){0.f, 0.f, 0.f, 0.f}; f32x4 ab = z, ak = z, rb = z, rk = z;
        if (ct <= rt) { ab = mm_xyt(Ai, Bi, rt, ct, z, lane); ak = mm_xyt(Ai, Ki, rt, ct, z, lane); rb = mm_xyt(Ri, Bi, rt, ct, z, lane); rk = mm_xyt(Ri, Ki, rt, ct, z, lane);
            const int t = 16 * rt + r;
#pragma unroll
            for (int j = 0; j < 4; ++j) { const int sj = 16 * ct + 4 * q + j; if (sj >= t) { ab[j] = 0.f; ak[j] = 0.f; } if (sj > t) { rb[j] = 0.f; rk[j] = 0.f; } } }
        tile_store(PA, rt, ct, ab, lane); tile_store(Aak, rt, ct, ak, lane); tile_store(Arb, rt, ct, rb, lane); tile_store(Ark, rt, ct, rk, lane);
        Tacc[i] = ab;
#pragma unroll
        for (int j = 0; j < 4; ++j) if (16 * ct + 4 * q + j == 16 * rt + r) Tacc[i][j] += 1.0f;
        tile_store(T0, rt, ct, Tacc[i], lane); }
    __syncthreads();
#pragma unroll
    for (int i = 0; i < 2; ++i) { const int ct = ct0 + i; f32x4 pz = (f32x4){0.f, 0.f, 0.f, 0.f}; if (ct <= rt) pz = mm_xy(PA, PA, rt, ct, pz, lane); tile_store(PB, rt, ct, pz, lane); }
    __syncthreads();
#pragma unroll
    for (int lv = 1; lv <= 5; ++lv) {
        LAS bf16* Pc = (lv & 1) ? PB : PA; LAS bf16* Pn = (lv & 1) ? PA : PB; LAS bf16* Tc = (lv & 1) ? T0 : T1; LAS bf16* Tn = (lv & 1) ? T1 : T0;
#pragma unroll
        for (int i = 0; i < 2; ++i) { const int ct = ct0 + i;
            if (ct <= rt) Tacc[i] = mm_xy(Pc, Tc, rt, ct, Tacc[i], lane);
            tile_store(Tn, rt, ct, Tacc[i], lane);
            if (lv < 5) { f32x4 pz = (f32x4){0.f, 0.f, 0.f, 0.f}; if (ct <= rt) pz = mm_xy(Pc, Pc, rt, ct, pz, lane); tile_store(Pn, rt, ct, pz, lane); } }
        __syncthreads();
    }
#pragma unroll
    for (int i = 0; i < 2; ++i) { const int ct = ct0 + i; const f32x4 z = (f32x4){0.f, 0.f, 0.f, 0.f};
        tile_store(PA, rt, ct, mm_xy(Aak, Vi, rt, ct, z, lane), lane); tile_store(PB, rt, ct, mm_xy(T1, Ai, rt, ct, z, lane), lane); }
    __syncthreads();
    const size_t ub = (size_t)unit * 4096;
#pragma unroll
    for (int i = 0; i < 2; ++i) { const int ct = ct0 + i; const f32x4 z = (f32x4){0.f, 0.f, 0.f, 0.f};
        tile_store(T0, rt, ct, mm_xy(T1, PA, rt, ct, z, lane), lane);
        f32x4 ra = mm_xy(Arb, PB, rt, ct, tile_load(Ri, rt, ct, lane), lane); const f32x4 er = *(const LAS f32x4*)(ER + 16 * ct + 4 * q);
        gtile_store(RAP + ub, rt, ct, ra * er, lane);
        f32x4 gph = mm_xty(Bi, PB, rt, ct, z, lane); const float egr = EGR[16 * rt + r], egj = EG[16 * rt + r];
#pragma unroll
        for (int j = 0; j < 4; ++j) { gph[j] = gph[j] * egr * er[j]; if (16 * ct + 4 * q + j == 16 * rt + r) gph[j] += egj; }
        gtile_store(PHI + ub, rt, ct, gph, lane); }
    __syncthreads();
#pragma unroll
    for (int i = 0; i < 2; ++i) { const int ct = ct0 + i; const f32x4 z = (f32x4){0.f, 0.f, 0.f, 0.f};
        gtile_store(YVB + ub, rt, ct, mm_xy(Ark, Vi, rt, ct, mm_xy(Arb, T0, rt, ct, z, lane), lane), lane);
        const f32x4 ps = mm_xty(Ki, Vi, rt, ct, mm_xty(Bi, T0, rt, ct, z, lane), lane);
        gtile_store(PSI + ub, rt, ct, ps * EGR[16 * rt + r], lane); }
    __syncthreads();
#undef RIMG
}

__device__ __forceinline__ void rwkv_chain(const Ctx& c, int task, const bf16* PHI, const bf16* RAP, const bf16* PSI, const bf16* YVB, bf16* YRAW) {
    const int head = task & 15, batch = task >> 4;
    const int lane = c.lane, w = c.wave, r = lane & 15, q = lane >> 4, trow = c.tid >> 3, part = c.tid & 7;
    const int it = w >> 1, x0 = 2 * (w & 1);
    { LAS bf16* H0 = (LAS bf16*)c.lds; for (int i = c.tid; i < 64 * RST / 2; i += 512) ((LAS unsigned*)H0)[i] = 0u; }
    const size_t u0 = (size_t)(batch * 16 + head) * 32;
    v4u pphi = *(const v4u*)(PHI + u0 * 4096 + trow * 64 + 8 * part), prap = *(const v4u*)(RAP + u0 * 4096 + trow * 64 + 8 * part);
    __syncthreads();
    for (int ch = 0; ch < 32; ++ch) {
        LAS unsigned char* base = launder_lds(c.lds);
        LAS bf16* Hc = (LAS bf16*)(base + (ch & 1) * 9216); LAS bf16* Hn = (LAS bf16*)(base + ((ch & 1) ^ 1) * 9216); LAS bf16* PHi = (LAS bf16*)(base + 2 * 9216); LAS bf16* RAi = (LAS bf16*)(base + 3 * 9216);
        const size_t ub = (u0 + ch) * 4096;
        *(LAS v4u*)(PHi + trow * RST + 8 * part) = pphi; *(LAS v4u*)(RAi + trow * RST + 8 * part) = prap;
        if (ch + 1 < 32) { pphi = *(const v4u*)(PHI + ub + 4096 + trow * 64 + 8 * part); prap = *(const v4u*)(RAP + ub + 4096 + trow * 64 + 8 * part); }
        f32x4 yv[2], ps[2];
#pragma unroll
        for (int i = 0; i < 2; ++i) { yv[i] = gtile_load(YVB + ub, x0 + i, it, lane); ps[i] = gtile_load(PSI + ub, x0 + i, it, lane); }
        __syncthreads();
#pragma unroll
        for (int i = 0; i < 2; ++i) { const int xt = x0 + i;
            const f32x4 y = mm_xy(RAi, Hc, xt, it, yv[i], lane);
            *(v2u*)(YRAW + ((size_t)batch * SEQ + ch * 64 + 16 * xt + r) * 1024 + head * 64 + 16 * it + 4 * q) = pack4(y);
            const f32x4 hn = mm_xy(PHi, Hc, xt, it, ps[i], lane);
            tile_store(Hn, xt, it, hn, lane); }
        __syncthreads();
    }
}

#define UNPK8(dst, src) do { dst[0] = __uint_as_float((src).x << 16); dst[1] = __uint_as_float((src).x & 0xffff0000u); dst[2] = __uint_as_float((src).y << 16); dst[3] = __uint_as_float((src).y & 0xffff0000u); \
        dst[4] = __uint_as_float((src).z << 16); dst[5] = __uint_as_float((src).z & 0xffff0000u); dst[6] = __uint_as_float((src).w << 16); dst[7] = __uint_as_float((src).w & 0xffff0000u); } while (0)

__device__ __forceinline__ void mlstm_prep_unit(const Ctx& c, int unit, const bf16* U, const float* cw, const float* cbias, const float* i_b, const float* f_b,
                                                bf16* MLCB, bf16* MLCE, bf16* MLBB, float* MLCUM, float* MLW, float* MLWX, float* MLGT) {
    const int head = unit & 3, cb = unit >> 2, tl0 = (cb & 31) * 64, lane = c.lane; const size_t m0 = (size_t)cb * 64;
    LAS float* CUM = (LAS float*)launder_lds(c.lds);
    if (c.wave == 0) { const bf16* ug = U + (m0 + lane) * EVP; const float wgt = __expf(bf2f(ug[6592 + head]) + i_b[head]); float cum = -softplusf_(-(bf2f(ug[6596 + head]) + f_b[head]));
#pragma unroll
        for (int o = 1; o < 64; o <<= 1) { const float v_ = __shfl_up(cum, o); if (lane >= o) cum += v_; }
        const float gt = __shfl(cum, 63);
        CUM[lane] = cum; MLCUM[(m0 + lane) * 4 + head] = cum; MLW[(m0 + lane) * 4 + head] = wgt; MLWX[(m0 + lane) * 4 + head] = wgt * __expf(gt - cum);
        if (lane == 63) MLGT[cb * 4 + head] = cum; }
    __syncthreads();
    const int cg = c.tid & 31, tslot = c.tid >> 5;
    const int cch = cg < 16 ? head * 128 + 8 * cg : 512 + head * 128 + 8 * (cg - 16);
    float w[4][8], bb[8];
#pragma unroll
    for (int j = 0; j < 4; ++j) { const f32x4 a = *(const f32x4*)(cw + j * 1024 + cch), b = *(const f32x4*)(cw + j * 1024 + cch + 4);
#pragma unroll
        for (int e = 0; e < 4; ++e) { w[j][e] = a[e]; w[j][4 + e] = b[e]; } }
    { const f32x4 a = *(const f32x4*)(cbias + cch), b = *(const f32x4*)(cbias + cch + 4);
#pragma unroll
      for (int e = 0; e < 4; ++e) { bb[e] = a[e]; bb[4 + e] = b[e]; } }
#pragma unroll 2
    for (int i = 0; i < 4; ++i) { const int t = 4 * tslot + i, tl = tl0 + t; const size_t m = m0 + t; float acc[8];
#pragma unroll
        for (int e = 0; e < 8; ++e) acc[e] = bb[e];
#pragma unroll
        for (int j = 0; j < 4; ++j) if (tl - 3 + j >= 0) { const v4u raw = *(const v4u*)(U + (m - 3 + j) * EVP + 3520 + cch); float xv[8]; UNPK8(xv, raw);
#pragma unroll
            for (int e = 0; e < 8; ++e) acc[e] += w[j][e] * xv[e]; }
#pragma unroll
        for (int e = 0; e < 8; ++e) acc[e] = siluf_(acc[e]);
        const f32x4 x0 = (f32x4){acc[0], acc[1], acc[2], acc[3]}, x1 = (f32x4){acc[4], acc[5], acc[6], acc[7]};
        if (cg < 16) { const float sc = 0.08838834764831845f, se = sc * __expf(CUM[t]);
            *(v4u*)(MLCB + m * 512 + head * 128 + 8 * cg) = pack8(x0 * sc, x1 * sc); *(v4u*)(MLCE + m * 512 + head * 128 + 8 * cg) = pack8(x0 * se, x1 * se); }
        else *(v4u*)(MLBB + m * 512 + head * 128 + 8 * (cg - 16)) = pack8(x0, x1); }
    __syncthreads();
}
__device__ __forceinline__ void mlstm_chain(const Ctx& c, int task, const bf16* U, const bf16* MLCB, const bf16* MLCE, const bf16* MLBB, const float* MLCUM, const float* MLW, const float* MLWX, const float* MLGT, bf16* HRAW, float* DEN) {
    constexpr int NP = 5, SX = 88, S1 = 136, SM = 72;
    const int slice = task & 3, head = (task >> 2) & 3, batch = task >> 4;
    const int lane = c.lane, w = c.wave, r = lane & 15, q = lane >> 4, trow = c.tid >> 3, part = c.tid & 7;
    f32x4 Hacc[NP];
#pragma unroll
    for (int i = 0; i < NP; ++i) Hacc[i] = (f32x4){0.f, 0.f, 0.f, 0.f};
    v4u rc[2], rb[2], re[2], rv; float gcum, gw, gwx, gtot;
#define ML_LOAD(ch) do { const size_t m_ = (size_t)batch * SEQ + (ch) * 64 + trow; \
        rc[0] = *(const v4u*)(MLCB + m_ * 512 + head * 128 + 16 * part); rc[1] = *(const v4u*)(MLCB + m_ * 512 + head * 128 + 16 * part + 8); \
        rb[0] = *(const v4u*)(MLBB + m_ * 512 + head * 128 + 16 * part); rb[1] = *(const v4u*)(MLBB + m_ * 512 + head * 128 + 16 * part + 8); \
        re[0] = *(const v4u*)(MLCE + m_ * 512 + head * 128 + 16 * part); re[1] = *(const v4u*)(MLCE + m_ * 512 + head * 128 + 16 * part + 8); \
        rv = *(const v4u*)(U + m_ * EVP + 4544 + head * 256 + slice * 64 + 8 * part); gwx = MLWX[m_ * 4 + head]; \
        const size_t ml_ = (size_t)batch * SEQ + (ch) * 64 + lane; gcum = MLCUM[ml_ * 4 + head]; gw = MLW[ml_ * 4 + head]; gtot = MLGT[(batch * 32 + (ch)) * 4 + head]; } while (0)
    ML_LOAD(0);
    for (int ch = 0; ch < 32; ++ch) {
        LAS bf16* Cb = (LAS bf16*)launder_lds(c.lds); LAS bf16* Bb = Cb + 64 * S1; LAS bf16* Ce = Bb + 64 * S1; LAS bf16* Hb = Ce + 64 * S1; LAS bf16* Xs = Hb + 80 * S1; LAS bf16* Xw = Xs + 64 * SX; LAS bf16* Mm = Xw + 64 * SX;
        LAS float* cumL = (LAS float*)(Mm + 64 * SM); LAS float* wL = cumL + 64;
        *(LAS v4u*)(Cb + trow * S1 + 16 * part) = rc[0]; *(LAS v4u*)(Cb + trow * S1 + 16 * part + 8) = rc[1];
        *(LAS v4u*)(Bb + trow * S1 + 16 * part) = rb[0]; *(LAS v4u*)(Bb + trow * S1 + 16 * part + 8) = rb[1];
        *(LAS v4u*)(Ce + trow * S1 + 16 * part) = re[0]; *(LAS v4u*)(Ce + trow * S1 + 16 * part + 8) = re[1];
        { float xv[8]; UNPK8(xv, rv); const float wx = gwx;
          *(LAS v4u*)(Xs + trow * SX + 8 * part) = rv;
          *(LAS v4u*)(Xw + trow * SX + 8 * part) = pack8((f32x4){xv[0] * wx, xv[1] * wx, xv[2] * wx, xv[3] * wx}, (f32x4){xv[4] * wx, xv[5] * wx, xv[6] * wx, xv[7] * wx});
          if (part == 0) { const f32x4 z = (f32x4){0.f, 0.f, 0.f, 0.f};
              *(LAS v4u*)(Xs + trow * SX + 64) = pack8((f32x4){1.f, 0.f, 0.f, 0.f}, z); *(LAS v4u*)(Xs + trow * SX + 72) = pack8(z, z);
              *(LAS v4u*)(Xw + trow * SX + 64) = pack8((f32x4){wx, 0.f, 0.f, 0.f}, z); *(LAS v4u*)(Xw + trow * SX + 72) = pack8(z, z); } }
#pragma unroll
        for (int pt = 0; pt < NP; ++pt) { v2u hp; hp.x = cvt_pk_bf16(Hacc[pt][0], Hacc[pt][1]); hp.y = cvt_pk_bf16(Hacc[pt][2], Hacc[pt][3]); *(LAS v2u*)(Hb + (16 * pt + r) * S1 + 16 * w + 4 * q) = hp; }
        if (w == 0) { cumL[lane] = gcum; wL[lane] = gw; }
        const float eg = __expf(gtot);
        if (ch + 1 < 32) ML_LOAD(ch + 1);
        __syncthreads();
        { const int tt = w >> 1;
#pragma unroll
          for (int i = 0; i < 2; ++i) { const int ts = 2 * (w & 1) + i; f32x4 acc = (f32x4){0.f, 0.f, 0.f, 0.f};
              if (ts <= tt) {
#pragma unroll
                  for (int kk = 0; kk < 4; ++kk) acc = __builtin_amdgcn_mfma_f32_16x16x32_bf16(frag_row(Bb, S1, 16 * ts, 32 * kk, lane), frag_row(Cb, S1, 16 * tt, 32 * kk, lane), acc, 0, 0, 0);
                  const int t = 16 * tt + r; const float ct = cumL[t];
#pragma unroll
                  for (int j = 0; j < 4; ++j) { const int sj = 16 * ts + 4 * q + j; acc[j] = (sj <= t) ? acc[j] * __expf(ct - cumL[sj]) * wL[sj] : 0.f; } }
              v2u mp; mp.x = cvt_pk_bf16(acc[0], acc[1]); mp.y = cvt_pk_bf16(acc[2], acc[3]); *(LAS v2u*)(Mm + (16 * tt + r) * SM + 16 * ts + 4 * q) = mp; }
#pragma unroll
          for (int pt = 0; pt < NP; ++pt) Hacc[pt] = Hacc[pt] * eg;
#pragma unroll
          for (int ks = 0; ks < 2; ++ks) { const bf16x8 af = frag_tr(Bb, S1, 16 * w, 32 * ks, lane);
#pragma unroll
              for (int pt = 0; pt < NP; ++pt) Hacc[pt] = __builtin_amdgcn_mfma_f32_16x16x32_bf16(af, frag_tr(Xw, SX, 16 * pt, 32 * ks, lane), Hacc[pt], 0, 0, 0); } }
        __syncthreads();
        { const int tt = w >> 1, half = w & 1; const size_t mrow = (size_t)batch * SEQ + ch * 64 + 16 * tt + r;
#pragma unroll
          for (int i = 0; i < 3; ++i) { const int pt = half ? 2 + i : (i < 2 ? i : 4); if (half && i == 2) continue;
              f32x4 acc = (f32x4){0.f, 0.f, 0.f, 0.f};
#pragma unroll
              for (int ks = 0; ks < 2; ++ks) acc = __builtin_amdgcn_mfma_f32_16x16x32_bf16(frag_tr(Xs, SX, 16 * pt, 32 * ks, lane), frag_row(Mm, SM, 16 * tt, 32 * ks, lane), acc, 0, 0, 0);
#pragma unroll
              for (int kk = 0; kk < 4; ++kk) acc = __builtin_amdgcn_mfma_f32_16x16x32_bf16(frag_row(Hb, S1, 16 * pt, 32 * kk, lane), frag_row(Ce, S1, 16 * tt, 32 * kk, lane), acc, 0, 0, 0);
              if (pt < 4) *(v2u*)(HRAW + mrow * 1024 + head * 256 + slice * 64 + 16 * pt + 4 * q) = pack4(acc); else if (q == 0 && slice == 0) DEN[mrow * 4 + head] = acc[0]; } }
        __syncthreads();
    }
#undef ML_LOAD
}

__device__ __forceinline__ void mamba_prep_unit(const Ctx& c, int unit, const bf16* U, const float* cw, const float* cbias, const float* dt_bias, const float* A_log,
                                                bf16* MXS, bf16* MXW, bf16* MB, bf16* MC, bf16* MCE, float* MCUM, float* MDT, float* MGT) {
    const int g = unit & 3, cb = unit >> 2, tl0 = (cb & 31) * 64, lane = c.lane; const size_t m0 = (size_t)cb * 64;
    LAS float* CUM = (LAS float*)launder_lds(c.lds); LAS float* DTL = CUM + 256; LAS float* GT = DTL + 256;
    if (c.wave < 4) { const int h = 4 * g + c.wave; const float dt = softplusf_(bf2f(U[(m0 + lane) * ODP + 7168 + h]) + dt_bias[h]); float cum = -__expf(A_log[h]) * dt;
#pragma unroll
        for (int o = 1; o < 64; o <<= 1) { const float v_ = __shfl_up(cum, o); if (lane >= o) cum += v_; }
        CUM[lane * 4 + c.wave] = cum; DTL[lane * 4 + c.wave] = dt; MCUM[(m0 + lane) * 16 + h] = cum; MDT[(m0 + lane) * 16 + h] = dt;
        if (lane == 63) { GT[c.wave] = cum; MGT[cb * 16 + h] = cum; } }
    __syncthreads();
    const int cg = c.tid & 63, tslot = c.tid >> 6;
    const int xch = cg < 32 ? g * 256 + 8 * cg : (cg < 48 ? 1024 + g * 128 + 8 * (cg - 32) : 1536 + g * 128 + 8 * (cg - 48));
    float w[4][8], bb[8];
#pragma unroll
    for (int j = 0; j < 4; ++j) { const f32x4 a = *(const f32x4*)(cw + j * 2048 + xch), b = *(const f32x4*)(cw + j * 2048 + xch + 4);
#pragma unroll
        for (int e = 0; e < 4; ++e) { w[j][e] = a[e]; w[j][4 + e] = b[e]; } }
    { const f32x4 a = *(const f32x4*)(cbias + xch), b = *(const f32x4*)(cbias + xch + 4);
#pragma unroll
      for (int e = 0; e < 4; ++e) { bb[e] = a[e]; bb[4 + e] = b[e]; } }
#pragma unroll 2
    for (int i = 0; i < 8; ++i) { const int t = 8 * tslot + i, tl = tl0 + t; const size_t m = m0 + t; float acc[8];
#pragma unroll
        for (int e = 0; e < 8; ++e) acc[e] = bb[e];
#pragma unroll
        for (int j = 0; j < 4; ++j) if (tl - 3 + j >= 0) { const v4u raw = *(const v4u*)(U + (m - 3 + j) * ODP + 5120 + xch); float xv[8]; UNPK8(xv, raw);
#pragma unroll
            for (int e = 0; e < 8; ++e) acc[e] += w[j][e] * xv[e]; }
#pragma unroll
        for (int e = 0; e < 8; ++e) acc[e] = siluf_(acc[e]);
        const f32x4 x0 = (f32x4){acc[0], acc[1], acc[2], acc[3]}, x1 = (f32x4){acc[4], acc[5], acc[6], acc[7]};
        if (cg < 32) { const int e = cg >> 3, h = 4 * g + e, p0 = (cg & 7) * 8; const float wx = DTL[t * 4 + e] * __expf(GT[e] - CUM[t * 4 + e]);
            *(v4u*)(MXS + m * 1024 + h * 64 + p0) = pack8(x0, x1); *(v4u*)(MXW + m * 1024 + h * 64 + p0) = pack8(x0 * wx, x1 * wx); }
        else if (cg < 48) { *(v4u*)(MB + m * 512 + g * 128 + 8 * (cg - 32)) = pack8(x0, x1); }
        else { const int n0 = 8 * (cg - 48); *(v4u*)(MC + m * 512 + g * 128 + n0) = pack8(x0, x1);
#pragma unroll
            for (int e = 0; e < 4; ++e) { const float ec = __expf(CUM[t * 4 + e]); *(v4u*)(MCE + m * 2048 + (4 * g + e) * 128 + n0) = pack8(x0 * ec, x1 * ec); } } }
    __syncthreads();
}
__device__ __forceinline__ void mamba_chain(const Ctx& c, int task, const bf16* MXS, const bf16* MXW, const bf16* MB, const bf16* MC, const bf16* MCE, const float* MCUM, const float* MDT, const float* MGT, const float* Dsk, bf16* YRAW) {
    constexpr int SX = 72, S1 = 136, SM = 72;
    const int head = task & 15, batch = task >> 4, g = head >> 2;
    const int lane = c.lane, w = c.wave, r = lane & 15, q = lane >> 4, trow = c.tid >> 3, part = c.tid & 7;
    const float Dh = Dsk[head];
    f32x4 Hacc[4];
#pragma unroll
    for (int i = 0; i < 4; ++i) Hacc[i] = (f32x4){0.f, 0.f, 0.f, 0.f};
    v4u rc[2], rb[2], re[2], rx, rw; float gcum, gdt, gtot;
#define MC_LOAD(ch) do { const size_t m_ = (size_t)batch * SEQ + (ch) * 64 + trow; \
        rc[0] = *(const v4u*)(MC + m_ * 512 + g * 128 + 16 * part); rc[1] = *(const v4u*)(MC + m_ * 512 + g * 128 + 16 * part + 8); \
        rb[0] = *(const v4u*)(MB + m_ * 512 + g * 128 + 16 * part); rb[1] = *(const v4u*)(MB + m_ * 512 + g * 128 + 16 * part + 8); \
        re[0] = *(const v4u*)(MCE + m_ * 2048 + head * 128 + 16 * part); re[1] = *(const v4u*)(MCE + m_ * 2048 + head * 128 + 16 * part + 8); \
        rx = *(const v4u*)(MXS + m_ * 1024 + head * 64 + 8 * part); rw = *(const v4u*)(MXW + m_ * 1024 + head * 64 + 8 * part); \
        const size_t ml_ = (size_t)batch * SEQ + (ch) * 64 + lane; gcum = MCUM[ml_ * 16 + head]; gdt = MDT[ml_ * 16 + head]; gtot = MGT[(batch * 32 + (ch)) * 16 + head]; } while (0)
    MC_LOAD(0);
    for (int ch = 0; ch < 32; ++ch) {
        LAS bf16* Cb = (LAS bf16*)launder_lds(c.lds); LAS bf16* Bb = Cb + 64 * S1; LAS bf16* Ce = Bb + 64 * S1; LAS bf16* Hb = Ce + 64 * S1; LAS bf16* Xs = Hb + 64 * S1; LAS bf16* Xw = Xs + 64 * SX; LAS bf16* Mm = Xw + 64 * SX;
        LAS float* cumL = (LAS float*)(Mm + 64 * SM); LAS float* wL = cumL + 64;
        *(LAS v4u*)(Cb + trow * S1 + 16 * part) = rc[0]; *(LAS v4u*)(Cb + trow * S1 + 16 * part + 8) = rc[1];
        *(LAS v4u*)(Bb + trow * S1 + 16 * part) = rb[0]; *(LAS v4u*)(Bb + trow * S1 + 16 * part + 8) = rb[1];
        *(LAS v4u*)(Ce + trow * S1 + 16 * part) = re[0]; *(LAS v4u*)(Ce + trow * S1 + 16 * part + 8) = re[1];
        *(LAS v4u*)(Xs + trow * SX + 8 * part) = rx; *(LAS v4u*)(Xw + trow * SX + 8 * part) = rw;
#pragma unroll
        for (int pt = 0; pt < 4; ++pt) { v2u hp; hp.x = cvt_pk_bf16(Hacc[pt][0], Hacc[pt][1]); hp.y = cvt_pk_bf16(Hacc[pt][2], Hacc[pt][3]); *(LAS v2u*)(Hb + (16 * pt + r) * S1 + 16 * w + 4 * q) = hp; }
        if (w == 0) { cumL[lane] = gcum; wL[lane] = gdt; }
        const float eg = __expf(gtot);
        if (ch + 1 < 32) MC_LOAD(ch + 1);
        __syncthreads();
        { const int tt = w >> 1;
#pragma unroll
          for (int i = 0; i < 2; ++i) { const int ts = 2 * (w & 1) + i; f32x4 acc = (f32x4){0.f, 0.f, 0.f, 0.f};
              if (ts <= tt) {
#pragma unroll
                  for (int kk = 0; kk < 4; ++kk) acc = __builtin_amdgcn_mfma_f32_16x16x32_bf16(frag_row(Bb, S1, 16 * ts, 32 * kk, lane), frag_row(Cb, S1, 16 * tt, 32 * kk, lane), acc, 0, 0, 0);
                  const int t = 16 * tt + r; const float ct = cumL[t];
#pragma unroll
                  for (int j = 0; j < 4; ++j) { const int sj = 16 * ts + 4 * q + j; acc[j] = (sj <= t) ? acc[j] * __expf(ct - cumL[sj]) * wL[sj] : 0.f; } }
              v2u mp; mp.x = cvt_pk_bf16(acc[0], acc[1]); mp.y = cvt_pk_bf16(acc[2], acc[3]); *(LAS v2u*)(Mm + (16 * tt + r) * SM + 16 * ts + 4 * q) = mp; }
#pragma unroll
          for (int pt = 0; pt < 4; ++pt) Hacc[pt] = Hacc[pt] * eg;
#pragma unroll
          for (int ks = 0; ks < 2; ++ks) { const bf16x8 af = frag_tr(Bb, S1, 16 * w, 32 * ks, lane);
#pragma unroll
              for (int pt = 0; pt < 4; ++pt) Hacc[pt] = __builtin_amdgcn_mfma_f32_16x16x32_bf16(af, frag_tr(Xw, SX, 16 * pt, 32 * ks, lane), Hacc[pt], 0, 0, 0); } }
        __syncthreads();
        { const int tt = w >> 1; const size_t mrow = (size_t)batch * SEQ + ch * 64 + 16 * tt + r;
#pragma unroll
          for (int i = 0; i < 2; ++i) { const int pt = 2 * (w & 1) + i; f32x4 acc = (f32x4){0.f, 0.f, 0.f, 0.f};
#pragma unroll
              for (int ks = 0; ks < 2; ++ks) acc = __builtin_amdgcn_mfma_f32_16x16x32_bf16(frag_tr(Xs, SX, 16 * pt, 32 * ks, lane), frag_row(Mm, SM, 16 * tt, 32 * ks, lane), acc, 0, 0, 0);
#pragma unroll
              for (int kk = 0; kk < 4; ++kk) acc = __builtin_amdgcn_mfma_f32_16x16x32_bf16(frag_row(Hb, S1, 16 * pt, 32 * kk, lane), frag_row(Ce, S1, 16 * tt, 32 * kk, lane), acc, 0, 0, 0);
              const v2u xv = *(const LAS v2u*)(Xs + (16 * tt + r) * SX + 16 * pt + 4 * q);
              acc[0] += Dh * __uint_as_float(xv.x << 16); acc[1] += Dh * __uint_as_float(xv.x & 0xffff0000u); acc[2] += Dh * __uint_as_float(xv.y << 16); acc[3] += Dh * __uint_as_float(xv.y & 0xffff0000u);
              *(v2u*)(YRAW + mrow * 1024 + head * 64 + 16 * pt + 4 * q) = pack4(acc); } }
        __syncthreads();
    }
#undef MC_LOAD
}

__device__ __forceinline__ void hgrn_prep_unit(const Ctx& c, int unit, const bf16* U, const float* lbl, bf16* HQ, bf16* HK, float* HVEC) {
    constexpr int LFS = 132;
    const int head = unit & 7, cb = unit >> 3, trow = c.tid >> 3, part = c.tid & 7;
    LAS float* LF = (LAS float*)launder_lds(c.lds); LAS float* SEGT = LF + 64 * LFS; LAS float* LBL = SEGT + 512;
    const size_t m = (size_t)cb * 64 + trow; const bf16* ur = U + m * ODP;
    if (c.tid < 128) { const int a = head * 128 + c.tid; LBL[c.tid] = 1.0f / (1.0f + __expf(lbl[a] - lbl[1024 + a])); }
    v4u rq[2], rf[2];
    rq[0] = *(const v4u*)(ur + head * 128 + 16 * part); rq[1] = *(const v4u*)(ur + head * 128 + 16 * part + 8);
    rf[0] = *(const v4u*)(ur + 1024 + head * 128 + 16 * part); rf[1] = *(const v4u*)(ur + 1024 + head * 128 + 16 * part + 8);
    __syncthreads();
    float sg[16];
#pragma unroll
    for (int h2 = 0; h2 < 2; ++h2) { float fp[8]; UNPK8(fp, rf[h2]);
        const f32x4 b0 = *(const LAS f32x4*)(LBL + 16 * part + 8 * h2), b1 = *(const LAS f32x4*)(LBL + 16 * part + 8 * h2 + 4); float lf[8];
#pragma unroll
        for (int j = 0; j < 8; ++j) { const float lbv = j < 4 ? b0[j & 3] : b1[j & 3]; sg[8 * h2 + j] = sigmoidf_(fp[j]); lf[j] = __logf(lbv + (1.0f - lbv) * sg[8 * h2 + j]); }
        *(LAS f32x4*)(LF + trow * LFS + 16 * part + 8 * h2) = (f32x4){lf[0], lf[1], lf[2], lf[3]}; *(LAS f32x4*)(LF + trow * LFS + 16 * part + 8 * h2 + 4) = (f32x4){lf[4], lf[5], lf[6], lf[7]}; }
    __syncthreads();
    { const int k = c.tid & 127, seg = c.tid >> 7; float run = 0.f;
#pragma unroll
      for (int i = 0; i < 16; ++i) { run += LF[(16 * seg + i) * LFS + k]; LF[(16 * seg + i) * LFS + k] = run; }
      SEGT[seg * 128 + k] = run; }
    __syncthreads();
    { const int seg = trow >> 4;
#pragma unroll
      for (int h2 = 0; h2 < 2; ++h2) { float qr[8], qt[8], kt[8]; UNPK8(qr, rq[h2]);
#pragma unroll
          for (int j4 = 0; j4 < 2; ++j4) { const int kb = 16 * part + 8 * h2 + 4 * j4;
              const f32x4 l = *(const LAS f32x4*)(LF + trow * LFS + kb), l31 = *(const LAS f32x4*)(LF + 31 * LFS + kb), l63 = *(const LAS f32x4*)(LF + 63 * LFS + kb), bb = *(const LAS f32x4*)(LBL + kb);
              const f32x4 s0 = *(const LAS f32x4*)(SEGT + kb), s1 = *(const LAS f32x4*)(SEGT + 128 + kb), s2 = *(const LAS f32x4*)(SEGT + 256 + kb);
#pragma unroll
              for (int e = 0; e < 4; ++e) { float off = 0.f; if (seg > 0) off += s0[e]; if (seg > 1) off += s1[e]; if (seg > 2) off += s2[e];
                  const float rf_ = l31[e] + s0[e], d = (l[e] + off) - rf_; const int j = 4 * j4 + e;
                  qt[j] = siluf_(qr[j]) * __expf(d); kt[j] = (1.0f - bb[e]) * (1.0f - sg[8 * h2 + j]) * __expf(-d);
                  if (trow == 0) { const float g_ = l63[e] + s0[e] + s1[e] + s2[e]; float* hv = HVEC + (size_t)unit * 384 + kb + e; hv[0] = __expf(rf_); hv[128] = __expf(g_); hv[256] = __expf(g_ - rf_); } } }
          *(v4u*)(HQ + m * 1024 + head * 128 + 16 * part + 8 * h2) = pack8((f32x4){qt[0], qt[1], qt[2], qt[3]}, (f32x4){qt[4], qt[5], qt[6], qt[7]});
          *(v4u*)(HK + m * 1024 + head * 128 + 16 * part + 8 * h2) = pack8((f32x4){kt[0], kt[1], kt[2], kt[3]}, (f32x4){kt[4], kt[5], kt[6], kt[7]}); } }
    __syncthreads();
}
__device__ __forceinline__ void hgrn_chain(const Ctx& c, int task, const bf16* U, const bf16* HQ, const bf16* HK, const float* HVEC, bf16* ORAW) {
    constexpr int S1 = 136, SX = 72, SM = 72;
    const int slice = task & 1, head = (task >> 1) & 7, batch = task >> 4;
    const int lane = c.lane, w = c.wave, r = lane & 15, q = lane >> 4, trow = c.tid >> 3, part = c.tid & 7;
    f32x4 Hacc[4];
#pragma unroll
    for (int i = 0; i < 4; ++i) Hacc[i] = (f32x4){0.f, 0.f, 0.f, 0.f};
    v4u rq[2], rk[2], ri; f32x4 ver, veg, vegr;
#define HC_LOAD(ch) do { const size_t m_ = (size_t)batch * SEQ + (ch) * 64 + trow; \
        rq[0] = *(const v4u*)(HQ + m_ * 1024 + head * 128 + 16 * part); rq[1] = *(const v4u*)(HQ + m_ * 1024 + head * 128 + 16 * part + 8); \
        rk[0] = *(const v4u*)(HK + m_ * 1024 + head * 128 + 16 * part); rk[1] = *(const v4u*)(HK + m_ * 1024 + head * 128 + 16 * part + 8); \
        ri = *(const v4u*)(U + m_ * ODP + 2048 + head * 128 + slice * 64 + 8 * part); \
        const float* hv_ = HVEC + (size_t)((batch * 32 + (ch)) * 8 + head) * 384 + 16 * w + 4 * q; ver = *(const f32x4*)hv_; veg = *(const f32x4*)(hv_ + 128); vegr = *(const f32x4*)(hv_ + 256); } while (0)
    HC_LOAD(0);
    for (int ch = 0; ch < 32; ++ch) {
        LAS bf16* Qi = (LAS bf16*)launder_lds(c.lds); LAS bf16* Ki = Qi + 64 * S1; LAS bf16* Hb = Ki + 64 * S1; LAS bf16* Xs = Hb + 64 * S1; LAS bf16* Mm = Xs + 64 * SX;
        *(LAS v4u*)(Qi + trow * S1 + 16 * part) = rq[0]; *(LAS v4u*)(Qi + trow * S1 + 16 * part + 8) = rq[1];
        *(LAS v4u*)(Ki + trow * S1 + 16 * part) = rk[0]; *(LAS v4u*)(Ki + trow * S1 + 16 * part + 8) = rk[1];
        *(LAS v4u*)(Xs + trow * SX + 8 * part) = ri;
        const f32x4 eg = veg, egr = vegr;
#pragma unroll
        for (int pt = 0; pt < 4; ++pt) { v2u hp; hp.x = cvt_pk_bf16(Hacc[pt][0] * ver[0], Hacc[pt][1] * ver[1]); hp.y = cvt_pk_bf16(Hacc[pt][2] * ver[2], Hacc[pt][3] * ver[3]); *(LAS v2u*)(Hb + (16 * pt + r) * S1 + 16 * w + 4 * q) = hp; }
        if (ch + 1 < 32) HC_LOAD(ch + 1);
        __syncthreads();
        { const int tt = w >> 1;
#pragma unroll
          for (int i = 0; i < 2; ++i) { const int ts = 2 * (w & 1) + i; f32x4 acc = (f32x4){0.f, 0.f, 0.f, 0.f};
              if (ts <= tt) {
#pragma unroll
                  for (int k4 = 0; k4 < 4; ++k4) acc = __builtin_amdgcn_mfma_f32_16x16x32_bf16(frag_row(Ki, S1, 16 * ts, 32 * k4, lane), frag_row(Qi, S1, 16 * tt, 32 * k4, lane), acc, 0, 0, 0);
                  const int t = 16 * tt + r;
#pragma unroll
                  for (int j = 0; j < 4; ++j) { const int sj = 16 * ts + 4 * q + j; acc[j] = (sj <= t) ? acc[j] : 0.f; } }
              v2u mp; mp.x = cvt_pk_bf16(acc[0], acc[1]); mp.y = cvt_pk_bf16(acc[2], acc[3]); *(LAS v2u*)(Mm + (16 * tt + r) * SM + 16 * ts + 4 * q) = mp; }
          f32x4 tmp[4];
#pragma unroll
          for (int pt = 0; pt < 4; ++pt) tmp[pt] = (f32x4){0.f, 0.f, 0.f, 0.f};
#pragma unroll
          for (int ks = 0; ks < 2; ++ks) { const bf16x8 af = frag_tr(Ki, S1, 16 * w, 32 * ks, lane);
#pragma unroll
              for (int pt = 0; pt < 4; ++pt) tmp[pt] = __builtin_amdgcn_mfma_f32_16x16x32_bf16(af, frag_tr(Xs, SX, 16 * pt, 32 * ks, lane), tmp[pt], 0, 0, 0); }
#pragma unroll
          for (int pt = 0; pt < 4; ++pt)
#pragma unroll
              for (int j = 0; j < 4; ++j) Hacc[pt][j] = eg[j] * Hacc[pt][j] + egr[j] * tmp[pt][j]; }
        __syncthreads();
        { const int tt = w >> 1; const size_t mrow = (size_t)batch * SEQ + ch * 64 + 16 * tt + r;
#pragma unroll
          for (int i = 0; i < 2; ++i) { const int pt = 2 * (w & 1) + i; f32x4 acc = (f32x4){0.f, 0.f, 0.f, 0.f};
#pragma unroll
              for (int ks = 0; ks < 2; ++ks) acc = __builtin_amdgcn_mfma_f32_16x16x32_bf16(frag_tr(Xs, SX, 16 * pt, 32 * ks, lane), frag_row(Mm, SM, 16 * tt, 32 * ks, lane), acc, 0, 0, 0);
#pragma unroll
              for (int k4 = 0; k4 < 4; ++k4) acc = __builtin_amdgcn_mfma_f32_16x16x32_bf16(frag_row(Hb, S1, 16 * pt, 32 * k4, lane), frag_row(Qi, S1, 16 * tt, 32 * k4, lane), acc, 0, 0, 0);
              *(v2u*)(ORAW + mrow * 1024 + head * 128 + slice * 64 + 16 * pt + 4 * q) = pack4(acc); } }
        __syncthreads();
    }
#undef HC_LOAD
}
struct Args { const float* in[41]; float* out; unsigned char* ws; int lo, hi; };

__global__ void __launch_bounds__(512, 2) fwd(Args args) {
    extern __shared__ __attribute__((aligned(16))) unsigned char lds_raw[];
    Ctx c; c.lds = (LAS unsigned char*)lds_raw; c.tid = threadIdx.x; c.lane = c.tid & 63; c.wave = __builtin_amdgcn_readfirstlane(c.tid >> 6); c.bid = blockIdx.x; c.G = gridDim.x;
    volatile LAS unsigned* MISC = (volatile LAS unsigned*)(c.lds + MISC_OFF);
    unsigned char* ws = args.ws;
    for (int u = c.tid; u < (LDS_BYTES - RING_BYTES) / 4; u += 512) ((LAS unsigned*)(c.lds + RING_BYTES))[u] = 0u;
    __syncthreads();
    const int lo = args.lo, hi = args.hi;
    XcdBarrier bar; bar.bar = (unsigned*)(ws + WS_CTL) + CW_BAR; bar.x = 0; bar.st = nullptr;
    if (hi - lo > 1) bar = xcd_barrier_post((unsigned*)(ws + WS_CTL) + CW_BAR, MISC + 8);
#define IN(k) (lo <= (k) && (k) < hi)
#define SEAM(k) do { if (IN(k) && IN((k) + 1)) xcd_barrier(bar); } while (0)

    const float* x = args.in[0]; const float* final_norm_w = args.in[1]; const float* hg_lb = args.in[2];
    const float* ev_norm1_w = args.in[3]; const float* ev_w_in = args.in[4]; const float* ev_w_out = args.in[5];
    const float* rw_mu = args.in[6]; const float* rw_w0 = args.in[7]; const float* rw_w2 = args.in[8]; const float* rw_a0 = args.in[9]; const float* rw_a2 = args.in[10]; const float* rw_g2 = args.in[11];
    const float* rw_k_k = args.in[12]; const float* rw_k_a = args.in[13]; const float* rw_r_k = args.in[14]; const float* rw_ln_w = args.in[15]; const float* rw_ln_b = args.in[16];
    const float* ml_conv_w = args.in[17]; const float* ml_conv_b = args.in[18]; const float* ml_i_b = args.in[19]; const float* ml_f_b = args.in[20]; const float* ml_norm_w = args.in[21];
    const float* ev_norm2_w = args.in[22]; const float* ffn_w_gate = args.in[23]; const float* ffn_w_up = args.in[24]; const float* ffn_w_down = args.in[25];
    const float* od_norm1_w = args.in[26]; const float* od_w_in = args.in[27]; const float* od_w_out = args.in[28]; const float* hg_norm_w = args.in[29];
    const float* mb_conv_w = args.in[30]; const float* mb_conv_b = args.in[31]; const float* mb_dt_bias = args.in[32]; const float* mb_A_log = args.in[33]; const float* mb_D = args.in[34]; const float* mb_norm_w = args.in[35];
    const float* od_norm2_w = args.in[36]; const float* moe_router = args.in[37]; const float* moe_w_gate = args.in[38]; const float* moe_w_up = args.in[39]; const float* moe_w_down = args.in[40];
    float* OUT = args.out;
    bf16* W_LORA = (bf16*)(ws + WS_WLORA); bf16* W_EVIN = (bf16*)(ws + WS_WEVIN); bf16* W_EVOUT = (bf16*)(ws + WS_WEVOUT); bf16* W_FGU = (bf16*)(ws + WS_WFGU); bf16* W_FD = (bf16*)(ws + WS_WFD);
    bf16* W_ODIN = (bf16*)(ws + WS_WODIN); bf16* W_ODOUT = (bf16*)(ws + WS_WODOUT); bf16* W_MGU = (bf16*)(ws + WS_WMGU); bf16* W_MD = (bf16*)(ws + WS_WMD);
    bf16* XN = (bf16*)(ws + WS_XN); bf16* Y = (bf16*)(ws + WS_Y); float* X1 = (float*)(ws + WS_X1);
    bf16* U = (bf16*)(ws + SC_U); float* LW = (float*)(ws + SC_LW); bf16* LA = (bf16*)(ws + SC_LA); bf16* LG = (bf16*)(ws + SC_LG); bf16* ALORA = (bf16*)(ws + SC_ALORA);
    bf16* RW_PHI = (bf16*)(ws + WS_X1); bf16* RW_RAP = RW_PHI + (size_t)2048 * 4096; bf16* RW_PSI = RW_RAP + (size_t)2048 * 4096; bf16* RW_YV = RW_PSI + (size_t)2048 * 4096;
    bf16* ML_CB = (bf16*)(ws + SC_MLQK); bf16* ML_CE = ML_CB + (size_t)8192 * 512; bf16* ML_BB = ML_CE + (size_t)8192 * 512; float* ML_CUM = (float*)(ML_BB + (size_t)8192 * 512); float* ML_W = ML_CUM + 8192 * 4; float* ML_WX = ML_W + 8192 * 4; float* ML_GT = ML_WX + 8192 * 4;
    bf16* YRAW_E = (bf16*)(ws + SC_YRAW_E); bf16* HRAW = (bf16*)(ws + SC_HRAW); float* DEN = (float*)(ws + SC_DEN);
    bf16* ACT = (bf16*)(ws + SC_ACT);
    bf16* HG_Q = (bf16*)(ws + WS_SCR + 244 * MiB); bf16* HG_K = (bf16*)(ws + WS_SCR + 260 * MiB); float* HG_VEC = (float*)(ws + WS_SCR + 276 * MiB);
    bf16* MB_XS = (bf16*)(ws + WS_SCR + 116 * MiB); bf16* MB_XW = (bf16*)(ws + WS_SCR + 132 * MiB); bf16* MB_B = (bf16*)(ws + WS_SCR + 148 * MiB); bf16* MB_C = (bf16*)(ws + WS_SCR + 156 * MiB); bf16* MB_CE = (bf16*)(ws + WS_SCR + 278 * MiB);
    float* MB_CUM = (float*)(ws + WS_SCR + 164 * MiB); float* MB_DT = MB_CUM + 8192 * 16; float* MB_GT = MB_DT + 8192 * 16;
    bf16* ORAW = (bf16*)(ws + SC_ORAW); bf16* YRAW_O = (bf16*)(ws + SC_YRAW_O);
    bf16* HS = (bf16*)(ws + SC_HS); bf16* ACTS = (bf16*)(ws + SC_ACTS); bf16* OUTS = (bf16*)(ws + SC_OUTS);
    int* TOPK = (int*)(ws + SC_TOPK); int* POS = (int*)(ws + SC_POS); int* CNT = (int*)(ws + SC_CNT); int* TILES = (int*)(ws + SC_TILES);
    float* X2 = OUT;

    const ConvKind kinds[10] = {
        ConvKind{ev_w_in, W_EVIN, DM, 6600, EVP, 0, 1, 0, 0}, ConvKind{ev_w_out, W_EVOUT, DM, DM, DM, 0, 1, 0, 0},
        ConvKind{ffn_w_gate, W_FGU, DM, FF, FF, 1, 1, 0, 0}, ConvKind{ffn_w_up, W_FGU, DM, FF, FF, 2, 1, 0, 0}, ConvKind{ffn_w_down, W_FD, FF, DM, DM, 0, 1, 0, 0},
        ConvKind{od_w_in, W_ODIN, DM, 7184, ODP, 0, 1, 0, 0}, ConvKind{od_w_out, W_ODOUT, DM, DM, DM, 0, 1, 0, 0},
        ConvKind{moe_w_gate, W_MGU, DM, FE, FE, 1, NEXP, (size_t)DM * FE, (size_t)2 * FE * DM}, ConvKind{moe_w_up, W_MGU, DM, FE, FE, 2, NEXP, (size_t)DM * FE, (size_t)2 * FE * DM},
        ConvKind{moe_w_down, W_MD, FE, DM, DM, 0, NEXP, (size_t)FE * DM, (size_t)DM * FE} };
    if (IN(0)) {
        conv_run(kinds, 0, c.G == 256 ? CV_P0 : CV_ALL, c.bid, c.G, (LAS float*)c.lds, c.tid);
        for (int idx = c.bid * 512 + c.tid; idx < 3072 * 512; idx += c.G * 512) {
            const int k = idx / 3072, n = idx % 3072; float v = 0.f;
            if (n < 1024) { if (k < 96) v = rw_w2[k * 1024 + n]; }
            else if (n < 2048) { if (k >= 96 && k < 192) v = rw_a2[(k - 96) * 1024 + (n - 1024)]; }
            else { if (k >= 192 && k < 448) v = rw_g2[(k - 192) * 1024 + (n - 2048)]; }
            W_LORA[(size_t)n * 512 + k] = (bf16)f2bf(v);
        }
        rmsnorm_phase(c, x, ev_norm1_w, XN);
    }
    SEAM(0);
    if (IN(1)) {
        pg8::Gemm g{XN, W_EVIN, M_TOK, EVP, DM}; pg8::StaticOrder S; S.init(M_TOK, EVP, c.G, c.bid);
        pg8::EpiBf16 E{U, EVP};
        pg8::gemm_phase<pg8::EpiBf16, pg8::StaticOrder, true, true>(c.lds, g, S, E);
        if (c.G == 256 && c.bid >= 64) conv_run(kinds, CV_P0, CV_P1, c.bid - 64, 192, (LAS float*)c.lds, c.tid);
    }
    SEAM(1);
    if (IN(2)) {
        for (int blk = c.bid; blk < 256; blk += c.G) {
            const int m0 = blk * 32;
            {
              const int idx0 = 8 * (c.tid & 63), col0 = 3072 + idx0; float mu8[8];
#pragma unroll
              for (int e = 0; e < 8; ++e) mu8[e] = idx0 < 448 ? rw_mu[col0 + e] : 0.f;
#pragma unroll 2
              for (int i = 0; i < 4; ++i) { const int m = m0 + (c.tid >> 6) + 8 * i, tl = m & (SEQ - 1); v4u o = (v4u){0u, 0u, 0u, 0u};
                  if (idx0 < 448) { const v4u cr = *(const v4u*)(U + (size_t)m * EVP + col0); v4u pr = (v4u){0u, 0u, 0u, 0u}; if (tl) pr = *(const v4u*)(U + (size_t)(m - 1) * EVP + col0);
                      float cv[8], pv[8], xv[8]; UNPK8(cv, cr); UNPK8(pv, pr);
#pragma unroll
                      for (int e = 0; e < 8; ++e) { const float x = cv[e] + (pv[e] - cv[e]) * mu8[e]; xv[e] = idx0 < 96 ? tanhf(x) : (idx0 < 192 ? x : sigmoidf_(x)); }
                      o = pack8((f32x4){xv[0], xv[1], xv[2], xv[3]}, (f32x4){xv[4], xv[5], xv[6], xv[7]}); }
                  *(v4u*)(ALORA + (size_t)m * 512 + idx0) = o; } }
        }
    }
    SEAM(2);
    if (IN(3)) {
        pg8::Gemm g{ALORA, W_LORA, M_TOK, 3072, 512}; pg8::StaticOrder S; S.init(M_TOK, 3072, c.G, c.bid);
        pg8::EpiLora E{LW, LA, LG, rw_w0, rw_a0};
        pg8::gemm_phase<pg8::EpiLora, pg8::StaticOrder, true, true>(c.lds, g, S, E);
    }
    SEAM(3);
    if (IN(4)) {
        for (int unit = c.bid; unit < 2560; unit += c.G) {
            if (unit < 2048) rwkv_prep_unit(c, unit, U, LW, LA, rw_mu, rw_k_k, rw_k_a, RW_PHI, RW_RAP, RW_PSI, RW_YV);
            else mlstm_prep_unit(c, unit - 2048, U, ml_conv_w, ml_conv_b, ml_i_b, ml_f_b, ML_CB, ML_CE, ML_BB, ML_CUM, ML_W, ML_WX, ML_GT);
        }
    }
    SEAM(4);
    if (IN(5)) {
        for (int task = c.bid; task < 128; task += c.G) {
            if (task < 64) rwkv_chain(c, task, RW_PHI, RW_RAP, RW_PSI, RW_YV, YRAW_E);
            else mlstm_chain(c, task - 64, U, ML_CB, ML_CE, ML_BB, ML_CUM, ML_W, ML_WX, ML_GT, HRAW, DEN);
        }
        if (c.G == 256 && c.bid >= 128) conv_run(kinds, CV_P1, CV_P5, c.bid - 128, 128, (LAS float*)c.lds, c.tid);
    }
    SEAM(5);
    if (IN(6)) {
        for (int blk = c.bid; blk < 256; blk += c.G) {
            const int m0 = blk * 32;
            for (int hh = 0; hh < 2; ++hh) { const int col = (2 * c.wave + hh) * 64 + 8 * (c.lane & 7);
                float mur[8], muk[8], muv[8], kac[8], rkc[8], lnw[8], lnb[8];
#pragma unroll
                for (int e = 0; e < 8; ++e) { mur[e] = rw_mu[col + e]; muk[e] = rw_mu[1024 + col + e]; muv[e] = rw_mu[2048 + col + e]; kac[e] = rw_k_a[col + e]; rkc[e] = rw_r_k[col + e]; lnw[e] = rw_ln_w[col + e]; lnb[e] = rw_ln_b[col + e]; }
#pragma unroll 2
                for (int i = 0; i < 4; ++i) { const int m = m0 + 8 * i + (c.lane >> 3), tl = m & (SEQ - 1); const bf16* ur = U + (size_t)m * EVP;
                    const v4u r8 = *(const v4u*)(ur + col), k8 = *(const v4u*)(ur + 1024 + col), v8 = *(const v4u*)(ur + 2048 + col);
                    v4u rp8 = (v4u){0u, 0u, 0u, 0u}, kp8 = rp8, vp8 = rp8;
                    if (tl) { rp8 = *(const v4u*)(ur - EVP + col); kp8 = *(const v4u*)(ur - EVP + 1024 + col); vp8 = *(const v4u*)(ur - EVP + 2048 + col); }
                    const v4u yraw8 = *(const v4u*)(YRAW_E + (size_t)m * 1024 + col);
                    const v4u la8 = *(const v4u*)(LA + (size_t)m * 1024 + col), lg8 = *(const v4u*)(LG + (size_t)m * 1024 + col);
                    float rr[8], kk[8], vv[8], rq[8], kq[8], vq[8]; UNPK8(rr, r8); UNPK8(kk, k8); UNPK8(vv, v8); UNPK8(rq, rp8); UNPK8(kq, kp8); UNPK8(vq, vp8);
                    float yv[8], av[8], gv[8];
#pragma unroll
                    UNPK8(yv, yraw8);
#pragma unroll
                    for (int e = 0; e < 1; ++e) {}
                    UNPK8(av, la8); UNPK8(gv, lg8);
                    float sy = 0.f, sb = 0.f;
#pragma unroll
                    for (int e = 0; e < 8; ++e) { rr[e] += (rq[e] - rr[e]) * mur[e]; kk[e] += (kq[e] - kk[e]) * muk[e]; vv[e] += (vq[e] - vv[e]) * muv[e];
                        sy += yv[e]; sb += rr[e] * kk[e] * (1.0f + (av[e] - 1.0f) * kac[e]) * rkc[e]; }
                    sy += __shfl_xor(sy, 1); sy += __shfl_xor(sy, 2); sy += __shfl_xor(sy, 4); sb += __shfl_xor(sb, 1); sb += __shfl_xor(sb, 2); sb += __shfl_xor(sb, 4);
                    const float mean = sy * (1.0f / 64.0f); float sq = 0.f;
#pragma unroll
                    for (int e = 0; e < 8; ++e) { yv[e] -= mean; sq += yv[e] * yv[e]; }
                    sq += __shfl_xor(sq, 1); sq += __shfl_xor(sq, 2); sq += __shfl_xor(sq, 4);
                    const float rstd = 1.0f / sqrtf(sq * (1.0f / 64.0f) + 64e-5f); float o[8];
#pragma unroll
                    for (int e = 0; e < 8; ++e) o[e] = (yv[e] * rstd * lnw[e] + lnb[e] + sb * vv[e]) * gv[e];
                    *(v4u*)(Y + (size_t)m * DM + col) = pack8((f32x4){o[0], o[1], o[2], o[3]}, (f32x4){o[4], o[5], o[6], o[7]}); } }
            { const int head = c.wave & 3, col = head * 256 + 8 * (c.lane & 31); float nw8[8];
#pragma unroll
              for (int e = 0; e < 8; ++e) nw8[e] = ml_norm_w[col + e];
#pragma unroll 2
              for (int i = 0; i < 8; ++i) { const int m = m0 + (c.wave >> 2) * 16 + 2 * i + (c.lane >> 5);
                  const v4u h8 = *(const v4u*)(HRAW + (size_t)m * 1024 + col), o8 = *(const v4u*)(U + (size_t)m * EVP + 5568 + col);
                  const float dn = 1.0f / fmaxf(fabsf(DEN[(size_t)m * 4 + head]), 1.0f);
                  float hv[8], ov[8]; UNPK8(hv, h8); UNPK8(ov, o8); float ss = 0.f;
#pragma unroll
                  for (int e = 0; e < 8; ++e) { hv[e] *= dn; ss += hv[e] * hv[e]; }
                  ss = allred16(ss); ss += __shfl_xor(ss, 16);
                  const float rs = 1.0f / sqrtf(ss * (1.0f / 256.0f) + 1e-6f); float o[8];
#pragma unroll
                  for (int e = 0; e < 8; ++e) o[e] = hv[e] * rs * nw8[e] * sigmoidf_(ov[e]);
                  *(v4u*)(Y + (size_t)m * DM + 1024 + col) = pack8((f32x4){o[0], o[1], o[2], o[3]}, (f32x4){o[4], o[5], o[6], o[7]}); } }
        }
    }
    SEAM(6);
    if (IN(7)) {
        pg8::Gemm g{Y, W_EVOUT, M_TOK, DM, DM}; pg8::StaticOrder S; S.init(M_TOK, DM, c.G, c.bid);
        pg8::EpiResF32 E{x, X1, DM};
        pg8::gemm_phase<pg8::EpiResF32, pg8::StaticOrder, false, true>(c.lds, g, S, E);
    }
    SEAM(7);
    if (IN(8)) rmsnorm_phase(c, X1, ev_norm2_w, XN);
    SEAM(8);
    if (IN(9)) {
        pg8::Gemm g{XN, W_FGU, M_TOK, 2 * FF, DM}; pg8::StaticOrder S; S.init(M_TOK, 2 * FF, c.G, c.bid);
        pg8::EpiSwiGLU E{ACT, FF};
        pg8::gemm_phase<pg8::EpiSwiGLU, pg8::StaticOrder, true, true>(c.lds, g, S, E);
        if (c.G == 256 && c.bid >= 128) conv_run(kinds, CV_P5, CV_P9, c.bid - 128, 128, (LAS float*)c.lds, c.tid);
    }
    SEAM(9);
    if (IN(10)) {
        pg8::Gemm g{ACT, W_FD, M_TOK, DM, FF}; pg8::StaticOrder S; S.init(M_TOK, DM, c.G, c.bid);
        pg8::EpiResF32 E{X1, X2, DM};
        pg8::gemm_phase<pg8::EpiResF32, pg8::StaticOrder, false, true>(c.lds, g, S, E);
    }
    SEAM(10);
    if (IN(11)) rmsnorm_phase(c, X2, od_norm1_w, XN);
    SEAM(11);
    if (IN(12)) {
        pg8::Gemm g{XN, W_ODIN, M_TOK, ODP, DM}; pg8::StaticOrder S; S.init(M_TOK, ODP, c.G, c.bid);
        pg8::EpiBf16 E{U, ODP};
        pg8::gemm_phase<pg8::EpiBf16, pg8::StaticOrder, true, true>(c.lds, g, S, E);
        if (c.G == 256 && c.bid >= 160) conv_run(kinds, CV_P9, CV_P12, c.bid - 160, 96, (LAS float*)c.lds, c.tid);
    }
    SEAM(12);
    if (IN(13)) {
        for (int unit = c.bid; unit < 1024; unit += c.G) hgrn_prep_unit(c, unit, U, hg_lb, HG_Q, HG_K, HG_VEC);
        for (int unit = c.bid; unit < 512; unit += c.G) mamba_prep_unit(c, unit, U, mb_conv_w, mb_conv_b, mb_dt_bias, mb_A_log, MB_XS, MB_XW, MB_B, MB_C, MB_CE, MB_CUM, MB_DT, MB_GT);
    }
    SEAM(13);
    if (IN(14)) {
        for (int task = c.bid; task < 256; task += c.G) {
            if (task < 64) hgrn_chain(c, task, U, HG_Q, HG_K, HG_VEC, ORAW);
            else if (task < 128) mamba_chain(c, task - 64, MB_XS, MB_XW, MB_B, MB_C, MB_CE, MB_CUM, MB_DT, MB_GT, mb_D, YRAW_O);
        }
        if (c.G == 256 && c.bid >= 128) conv_run(kinds, CV_P12, CV_ALL, c.bid - 128, 128, (LAS float*)c.lds, c.tid);
    }
    SEAM(14);
    if (IN(15)) {
        for (int blk = c.bid; blk < 256; blk += c.G) {
            const int m0 = blk * 32;
            {
              const int col = c.wave * 128 + 8 * (c.lane & 15); float nw8[8];
#pragma unroll
              for (int e = 0; e < 8; ++e) nw8[e] = hg_norm_w[col + e];
#pragma unroll 2
              for (int i = 0; i < 8; ++i) { const int m = m0 + 4 * i + (c.lane >> 4);
                  const v4u o8 = *(const v4u*)(ORAW + (size_t)m * 1024 + col), g8 = *(const v4u*)(U + (size_t)m * ODP + 3072 + col);
                  float ov[8], gv[8]; UNPK8(ov, o8); UNPK8(gv, g8); float ss = 0.f;
#pragma unroll
                  for (int e = 0; e < 8; ++e) ss += ov[e] * ov[e];
                  ss = allred16(ss);
                  const float rs = 1.0f / sqrtf(ss * (1.0f / 128.0f) + 1e-6f); float o[8];
#pragma unroll
                  for (int e = 0; e < 8; ++e) o[e] = ov[e] * rs * nw8[e] * siluf_(gv[e]);
                  *(v4u*)(Y + (size_t)m * DM + col) = pack8((f32x4){o[0], o[1], o[2], o[3]}, (f32x4){o[4], o[5], o[6], o[7]}); } }
            {
              const int grp = c.wave & 3, col = grp * 256 + 8 * (c.lane & 31); float nw8[8];
#pragma unroll
              for (int e = 0; e < 8; ++e) nw8[e] = mb_norm_w[col + e];
#pragma unroll 2
              for (int i = 0; i < 8; ++i) { const int m = m0 + (c.wave >> 2) * 16 + 2 * i + (c.lane >> 5);
                  const v4u y8 = *(const v4u*)(YRAW_O + (size_t)m * 1024 + col), z8 = *(const v4u*)(U + (size_t)m * ODP + 4096 + col);
                  float yv[8], zv[8]; UNPK8(yv, y8); UNPK8(zv, z8); float ss = 0.f;
#pragma unroll
                  for (int e = 0; e < 8; ++e) { yv[e] *= siluf_(zv[e]); ss += yv[e] * yv[e]; }
                  ss = allred16(ss); ss += __shfl_xor(ss, 16);
                  const float rs = 1.0f / sqrtf(ss * (1.0f / 256.0f) + 1e-6f);
                  *(v4u*)(Y + (size_t)m * DM + 1024 + col) = pack8((f32x4){yv[0] * rs * nw8[0], yv[1] * rs * nw8[1], yv[2] * rs * nw8[2], yv[3] * rs * nw8[3]}, (f32x4){yv[4] * rs * nw8[4], yv[5] * rs * nw8[5], yv[6] * rs * nw8[6], yv[7] * rs * nw8[7]}); } }
        }
    }
    SEAM(15);
    if (IN(16)) {
        pg8::Gemm g{Y, W_ODOUT, M_TOK, DM, DM}; pg8::StaticOrder S; S.init(M_TOK, DM, c.G, c.bid);
        pg8::EpiResF32 E{X2, X1, DM};
        pg8::gemm_phase<pg8::EpiResF32, pg8::StaticOrder, false, true>(c.lds, g, S, E);
    }
    SEAM(16);
    if (IN(17)) {
        LAS float* RT = (LAS float*)c.lds;
        LAS int* lcnt = (LAS int*)(c.lds + 65536);
        for (int i = c.tid; i < 2048 * 8 / 4; i += 512) *(LAS f32x4*)(RT + 4 * i) = *(const f32x4*)(moe_router + 4 * i);
        __syncthreads();
        for (int blk = c.bid; blk < 256; blk += c.G) {
            if (c.tid < 8) lcnt[c.tid] = 0;
            __syncthreads();
            f32x4 nx[8];
#pragma unroll
            for (int j = 0; j < 8; ++j) nx[j] = *(const f32x4*)(X1 + (size_t)(blk * 32 + c.wave * 4) * DM + 4 * c.lane + 256 * j);
            for (int q = 0; q < 4; ++q) {
                const int m = blk * 32 + c.wave * 4 + q;
                f32x4 v[8]; float ss = 0.f;
#pragma unroll
                for (int j = 0; j < 8; ++j) { v[j] = nx[j]; ss += (v[j].x * v[j].x + v[j].y * v[j].y) + (v[j].z * v[j].z + v[j].w * v[j].w); }
                if (q < 3) {
#pragma unroll
                    for (int j = 0; j < 8; ++j) nx[j] = *(const f32x4*)(X1 + (size_t)(m + 1) * DM + 4 * c.lane + 256 * j); }
                const float rs = 1.0f / sqrtf(wave_sum(ss) * (1.0f / 2048.0f) + 1e-6f);
                float lg[8];
#pragma unroll
                for (int e = 0; e < 8; ++e) lg[e] = 0.f;
#pragma unroll
                for (int j = 0; j < 8; ++j) { const f32x4 wv = *(const f32x4*)(od_norm2_w + 4 * c.lane + 256 * j); const f32x4 hn = v[j] * rs * wv;
                    v2u p; p.x = cvt_pk_bf16(hn.x, hn.y); p.y = cvt_pk_bf16(hn.z, hn.w); *(v2u*)(XN + (size_t)m * DM + 4 * c.lane + 256 * j) = p;
#pragma unroll
                    for (int i = 0; i < 4; ++i) { const int ch = 4 * c.lane + 256 * j + i; const f32x4 r0 = *(const LAS f32x4*)(RT + ch * 8), r1 = *(const LAS f32x4*)(RT + ch * 8 + 4);
                        lg[0] += hn[i] * r0[0]; lg[1] += hn[i] * r0[1]; lg[2] += hn[i] * r0[2]; lg[3] += hn[i] * r0[3]; lg[4] += hn[i] * r1[0]; lg[5] += hn[i] * r1[1]; lg[6] += hn[i] * r1[2]; lg[7] += hn[i] * r1[3]; } }
#pragma unroll
                for (int e = 0; e < 8; ++e) lg[e] = wave_sum(lg[e]);
                int e0 = 0; float v0 = lg[0];
#pragma unroll
                for (int e = 1; e < 8; ++e) if (lg[e] > v0) { v0 = lg[e]; e0 = e; }
                int e1 = -1; float v1 = -3.0e38f;
#pragma unroll
                for (int e = 0; e < 8; ++e) if (e != e0 && lg[e] > v1) { v1 = lg[e]; e1 = e; }
                const float p0 = 1.0f / (1.0f + __expf(v1 - v0)), p1 = 1.0f - p0;
                if (c.lane == 0) { TOPK[m * 4] = e0; TOPK[m * 4 + 1] = e1; TOPK[m * 4 + 2] = __float_as_int(p0); TOPK[m * 4 + 3] = __float_as_int(p1); atomicAdd((int*)&lcnt[e0], 1); atomicAdd((int*)&lcnt[e1], 1); }
            }
            __syncthreads();
            if (c.tid < 8) CNT[blk * 8 + c.tid] = lcnt[c.tid];
            __syncthreads();
        }
    }
    SEAM(17);
    if (IN(18)) {
        LAS int* C8 = (LAS int*)c.lds;
        LAS int* tot = C8 + 2048; LAS int* pre = tot + 8; LAS int* segst = pre + 8; LAS int* ntl = segst + 8; LAS int* basee = ntl + 8; LAS int* lpos = basee + 8;
        LAS int* ltop = lpos + 64; LAS int* part = ltop + 64;
        for (int blk = c.bid; blk < 256; blk += c.G) {
            for (int i = c.tid; i < 2048; i += 512) C8[i] = CNT[i];
            if (c.tid < 64) ltop[c.tid] = TOPK[(blk * 32 + (c.tid >> 1)) * 4 + (c.tid & 1)];
            __syncthreads();
            { const int e = c.tid & 7, bq = c.tid >> 3; int t = 0, pp = 0;
#pragma unroll
              for (int j = 0; j < 4; ++j) { const int b = 4 * bq + j, v = C8[b * 8 + e]; t += v; if (b < blk) pp += v; }
              part[bq * 8 + e] = t; part[512 + bq * 8 + e] = pp; }
            __syncthreads();
            if (c.tid < 8) { int t = 0, pp = 0; for (int b = 0; b < 64; ++b) { t += part[b * 8 + c.tid]; pp += part[512 + b * 8 + c.tid]; } tot[c.tid] = t; pre[c.tid] = pp; }
            __syncthreads();
            if (c.tid == 0) {
                int seg = 0;
                for (int e = 0; e < 8; ++e) { segst[e] = seg; ntl[e] = (tot[e] + 255) >> 8; seg += ntl[e] * 256; basee[e] = seg - ntl[e] * 256 + pre[e]; }
                for (int i = 0; i < 32; ++i) { const int e0 = ltop[2 * i], e1 = ltop[2 * i + 1];
                    const int p0 = basee[e0]; basee[e0] = p0 + 1; const int p1 = basee[e1]; basee[e1] = p1 + 1; lpos[2 * i] = p0; lpos[2 * i + 1] = p1; }
                if (blk == 0) { int t = 0; for (int e = 0; e < 8; ++e) for (int k = 0; k < ntl[e]; ++k) TILES[1 + t++] = e; TILES[0] = t; }
            }
            __syncthreads();
            if (c.tid < 64) POS[blk * 64 + c.tid] = lpos[c.tid];
            for (int pr = c.wave; pr < 64; pr += 8) {
                const int m = blk * 32 + (pr >> 1); const int pos = lpos[pr];
                const v4u* src = (const v4u*)(XN + (size_t)m * DM); v4u* dst = (v4u*)(HS + (size_t)pos * DM);
#pragma unroll
                for (int j = 0; j < 4; ++j) dst[c.lane + 64 * j] = src[c.lane + 64 * j];
            }
            for (int e = 0; e < 8; ++e) {
                const int npad = ntl[e] * 256 - tot[e], r0 = segst[e] + tot[e];
                for (int pq = blk; pq < npad; pq += 256) { v2u* dst = (v2u*)(HS + (size_t)(r0 + pq) * DM); dst[c.tid] = (v2u){0u, 0u}; }
            }
            __syncthreads();
        }
    }
    SEAM(18);
    if (IN(19)) {
        const int NT = __builtin_amdgcn_readfirstlane(TILES[0]);
        pg8::Gemm g{HS, W_MGU, 0, 0, DM}; pg8::GroupedOrder S{TILES + 1, NT, 22, c.G, c.bid};
        pg8::EpiSwiGLU E{ACTS, FE};
        pg8::gemm_phase<pg8::EpiSwiGLU, pg8::GroupedOrder, true, true>(c.lds, g, S, E);
    }
    SEAM(19);
    if (IN(20)) {
        const int NT = __builtin_amdgcn_readfirstlane(TILES[0]);
        pg8::Gemm g{ACTS, W_MD, 0, 0, FE}; pg8::GroupedOrder S{TILES + 1, NT, 8, c.G, c.bid};
        pg8::EpiBf16 E{OUTS, DM};
        pg8::gemm_phase<pg8::EpiBf16, pg8::GroupedOrder, true, true>(c.lds, g, S, E);
    }
    SEAM(20);
    if (IN(21)) {
        const int gw = c.bid * 8 + c.wave, NGW = c.G * 8;
        f32x4 fw[8];
#pragma unroll
        for (int j = 0; j < 8; ++j) fw[j] = *(const f32x4*)(final_norm_w + 4 * c.lane + 256 * j);
        float pc0 = 0.f, pc1 = 0.f, pn0 = 0.f, pn1 = 0.f; int qn0 = 0, qn1 = 0; f32x4 ax[8]; v2u a0[8], a1[8];
        if (gw < M_TOK) { pc0 = __int_as_float(TOPK[gw * 4 + 2]); pc1 = __int_as_float(TOPK[gw * 4 + 3]); const int q0 = POS[gw * 2], q1 = POS[gw * 2 + 1];
#pragma unroll
            for (int j = 0; j < 8; ++j) { const int o = 4 * c.lane + 256 * j; ax[j] = *(const f32x4*)(X1 + (size_t)gw * DM + o); a0[j] = *(const v2u*)(OUTS + (size_t)q0 * DM + o); a1[j] = *(const v2u*)(OUTS + (size_t)q1 * DM + o); } }
        if (gw + NGW < M_TOK) { const int mn = gw + NGW; pn0 = __int_as_float(TOPK[mn * 4 + 2]); pn1 = __int_as_float(TOPK[mn * 4 + 3]); qn0 = POS[mn * 2]; qn1 = POS[mn * 2 + 1]; }
        for (int m = gw; m < M_TOK; m += NGW) {
            f32x4 v[8]; float ss = 0.f;
#pragma unroll
            for (int j = 0; j < 8; ++j) { const f32x4 e0 = (f32x4){__uint_as_float(a0[j].x << 16), __uint_as_float(a0[j].x & 0xffff0000u), __uint_as_float(a0[j].y << 16), __uint_as_float(a0[j].y & 0xffff0000u)};
                const f32x4 e1 = (f32x4){__uint_as_float(a1[j].x << 16), __uint_as_float(a1[j].x & 0xffff0000u), __uint_as_float(a1[j].y << 16), __uint_as_float(a1[j].y & 0xffff0000u)};
                v[j] = ax[j] + pc0 * e0 + pc1 * e1; ss += (v[j].x * v[j].x + v[j].y * v[j].y) + (v[j].z * v[j].z + v[j].w * v[j].w); }
            if (m + NGW < M_TOK) { const int mn = m + NGW;
#pragma unroll
                for (int j = 0; j < 8; ++j) { const int o = 4 * c.lane + 256 * j; ax[j] = *(const f32x4*)(X1 + (size_t)mn * DM + o); a0[j] = *(const v2u*)(OUTS + (size_t)qn0 * DM + o); a1[j] = *(const v2u*)(OUTS + (size_t)qn1 * DM + o); }
                pc0 = pn0; pc1 = pn1;
                if (mn + NGW < M_TOK) { const int m2 = mn + NGW; pn0 = __int_as_float(TOPK[m2 * 4 + 2]); pn1 = __int_as_float(TOPK[m2 * 4 + 3]); qn0 = POS[m2 * 2]; qn1 = POS[m2 * 2 + 1]; } }
            const float rs = 1.0f / sqrtf(wave_sum(ss) * (1.0f / 2048.0f) + 1e-6f);
#pragma unroll
            for (int j = 0; j < 8; ++j) { const int o = 4 * c.lane + 256 * j; *(f32x4*)(OUT + (size_t)m * DM + o) = v[j] * rs * fw[j]; }
        }
    }
#undef IN
#undef SEAM
}

extern "C" void kernel_launch(void* const* d_in, const int* in_sizes, int n_in, void* d_out, int out_size, void* d_ws, size_t ws_size, hipStream_t stream) {
    static int grid = 0;
    if (grid == 0) {
        if (n_in != 41 || out_size != M_TOK * DM || ws_size < WS_END) { fprintf(stderr, "kernel_launch: unexpected problem (n_in %d, out %d, ws %zu < %zu)\n", n_in, out_size, ws_size, (size_t)WS_END); grid = -1; return; }
        int dev = 0, cus = 0, per_cu = 0;
        if (hipGetDevice(&dev) != hipSuccess || hipDeviceGetAttribute(&cus, hipDeviceAttributeMultiprocessorCount, dev) != hipSuccess) { grid = -1; return; }
        if (hipFuncSetAttribute((const void*)fwd, hipFuncAttributeMaxDynamicSharedMemorySize, LDS_BYTES) != hipSuccess) { fprintf(stderr, "kernel_launch: hipFuncSetAttribute failed\n"); grid = -1; return; }
        if (hipOccupancyMaxActiveBlocksPerMultiprocessor(&per_cu, (const void*)fwd, 512, LDS_BYTES) != hipSuccess || per_cu < 1) fprintf(stderr, "kernel_launch: occupancy query says %d\n", per_cu);
        (void)hipGetLastError();
        grid = cus;
    }
    if (grid < 0) return;
    (void)hipMemsetAsync((char*)d_ws + WS_CTL, 0, CTL_ZERO_BYTES, stream);
    Args a{};
    for (int i = 0; i < 41; ++i) a.in[i] = (const float*)d_in[i];
    a.out = (float*)d_out; a.ws = (unsigned char*)d_ws;
    if (MK_N_LAUNCHES == 1) { a.lo = 0; a.hi = NPHASE; hipLaunchKernelGGL(fwd, dim3(grid), dim3(512), LDS_BYTES, stream, a); }
    else { for (int p = 0; p < NPHASE; ++p) { a.lo = p; a.hi = p + 1; const int n = ((PROBE_DUP >> p) & 1u) ? 1 + PROBE_EXTRA : 1;
            for (int r = 0; r < n; ++r) hipLaunchKernelGGL(fwd, dim3(grid), dim3(512), LDS_BYTES, stream, a); } }
}
```
